# Optimizing an MI355X kernel written in HIP

```python
import jax, jax.numpy as jnp
from jax import lax
import numpy as np


D_MODEL = 1024
BATCH = 1
SEQ = 16384
DEPTH = 1

NORM_EPS = 1e-6
PLE_DIM = 256
RW_HEADS = 8
RW_HEAD_DIM = 64
RW_WIDTH = RW_HEADS * RW_HEAD_DIM
RW_DECAY_LORA = 64
RW_ICLR_LORA = 64
RW_GATE_LORA = 128
RW_GN_EPS = 64e-5
RW_COLS = 3 * RW_WIDTH + 2 * RW_DECAY_LORA + 2 * RW_ICLR_LORA + RW_GATE_LORA
MLA_HEADS = 8
MLA_NOPE_DIM = 64
MLA_ROPE_DIM = 32
MLA_V_DIM = 64
MLA_QK_DIM = MLA_NOPE_DIM + MLA_ROPE_DIM
MLA_Q_RANK = 256
MLA_KV_RANK = 128
MLA_COLS = MLA_Q_RANK + MLA_KV_RANK + MLA_ROPE_DIM
MLA_WIDTH = MLA_HEADS * MLA_V_DIM
ROPE_THETA = 10000.0
Q_BLOCK = 128
N_BRANCHES = 2
GATE_COLS = N_BRANCHES * D_MODEL
IN_COLS = RW_COLS + MLA_COLS + GATE_COLS
PEER_HEADS = 8
PEER_N_KEYS = 128
PEER_N_EXPERTS = PEER_N_KEYS * PEER_N_KEYS
PEER_TOPK = 16
PEER_QUERY_DIM = 256
PEER_HALF = PEER_QUERY_DIM // 2
TOKEN_BLOCK = 128

kernel_name = 'hybrid_rwkv7_mla_peer_block'


def rmsnorm(x, g):
    xf = x.astype(jnp.float32)
    y = xf * lax.rsqrt(jnp.mean(xf * xf, axis=-1, keepdims=True) + NORM_EPS)
    return (y * g).astype(x.dtype)


def centred_shift(u):
    prev = jnp.pad(u[:, :-1], ((0, 0), (1, 0), (0, 0)))
    nxt = jnp.pad(u[:, 1:], ((0, 0), (0, 1), (0, 0)))
    return 0.5 * (prev + nxt) - u


def _heads(t, n_heads, head_dim):
    return t.reshape(t.shape[:-1] + (n_heads, head_dim))


def rope_tables(positions):
    inv = ROPE_THETA ** (-jnp.arange(0, MLA_ROPE_DIM, 2, dtype=jnp.float32) / MLA_ROPE_DIM)
    ang = positions.astype(jnp.float32)[..., None] * inv
    return jnp.cos(ang), jnp.sin(ang)


def apply_rope(x, cos, sin):
    xf = x.astype(jnp.float32)
    half = xf.shape[-1] // 2
    x1, x2 = xf[..., :half], xf[..., half:]
    return jnp.concatenate([x1 * cos - x2 * sin, x2 * cos + x1 * sin], axis=-1).astype(x.dtype)


def rwkv7_scan(r, a_vec, b_vec, v, k, decay):
    def step(state, inp):
        r_t, a_t, b_t, v_t, k_t, w_t = inp
        sa = jnp.einsum('bdhvk,bdhk->bdhv', state, a_t)
        state = (state * w_t[..., None, :] + sa[..., :, None] * b_t[..., None, :]
                 + v_t[..., :, None] * k_t[..., None, :])
        return state, jnp.einsum('bdhvk,bdhk->bdhv', state, r_t)
    B = r.shape[1]
    init = jnp.zeros((B, 2, RW_HEADS, RW_HEAD_DIM, RW_HEAD_DIM), jnp.float32)
    _, out = lax.scan(step, init, (r, a_vec, b_vec, v, k, decay))
    return out


def rwkv7_time_mix(u, mu, w0, w2, a0, a2, g2, k_k, k_a, r_k, gn_w, gn_b):
    f32 = jnp.float32
    B, T, _ = u.shape
    H, N, W = RW_HEADS, RW_HEAD_DIM, RW_WIDTH
    u = u + mu * centred_shift(u)
    o0 = 3 * W
    o1 = o0 + 2 * RW_DECAY_LORA
    o2 = o1 + 2 * RW_ICLR_LORA
    r, k, v = u[..., :W], u[..., W:2 * W], u[..., 2 * W:o0]
    lw = u[..., o0:o1].reshape(B, T, 2, RW_DECAY_LORA)
    la = u[..., o1:o2].reshape(B, T, 2, RW_ICLR_LORA)
    lg = u[..., o2:]
    w_log = -jax.nn.softplus(-(w0 + jnp.einsum('btdl,dlc->btdc', jnp.tanh(lw), w2)).astype(f32)) - 0.5
    decay = jnp.exp(-jnp.exp(w_log))
    a = jax.nn.sigmoid((a0 + jnp.einsum('btdl,dlc->btdc', la, a2)).astype(f32))
    g = jax.nn.sigmoid(lg) @ g2
    kk = _heads((k * k_k).astype(f32), H, N)
    kk = kk / jnp.maximum(jnp.sqrt(jnp.sum(kk * kk, axis=-1, keepdims=True)), 1e-12)
    k_dir = k.astype(f32)[:, :, None, :] * (1.0 + (a - 1.0) * k_a.astype(f32))
    r_h = _heads(r.astype(f32), H, N)
    v_h = _heads(v.astype(f32), H, N)
    k_h = _heads(k_dir, H, N)
    a_h = _heads(a, H, N)
    both = lambda t: jnp.stack([t, t], axis=2)

    def time_major(t):
        t = jnp.concatenate([t[:, :, :1], jnp.flip(t[:, :, 1:], axis=1)], axis=2)
        return jnp.moveaxis(t, 1, 0)

    out = rwkv7_scan(time_major(both(r_h)), time_major(both(-kk)),
                     time_major(kk[:, :, None] * a_h), time_major(both(v_h)),
                     time_major(k_h), time_major(_heads(decay, H, N)))
    out = jnp.moveaxis(out, 0, 1)
    o = out[:, :, 0] + jnp.flip(out[:, :, 1], axis=1)
    m = jnp.mean(o, axis=-1, keepdims=True)
    var = jnp.mean(jnp.square(o - m), axis=-1, keepdims=True)
    o = ((o - m) * lax.rsqrt(var + RW_GN_EPS)).reshape(B, T, W) * gn_w + gn_b
    bonus = jnp.sum(jnp.sum(r_h[:, :, None] * k_h * _heads(r_k, H, N), axis=-1, keepdims=True), axis=2) * v_h
    o = o + bonus.reshape(B, T, W)
    return (o * g).astype(u.dtype)


def bidir_attention(q, k, v):
    B, T, H, Dq = q.shape
    scale = Dq ** -0.5
    qb = jnp.moveaxis(q.reshape(B, T // Q_BLOCK, Q_BLOCK, H, Dq), 1, 0)

    def block(qi):
        s = jnp.einsum('bqhd,bkhd->bhqk', qi, k).astype(jnp.float32) * scale
        p = jax.nn.softmax(s, axis=-1)
        return jnp.einsum('bhqk,bkhd->bqhd', p.astype(v.dtype), v)

    o = lax.map(block, qb)
    return jnp.moveaxis(o, 0, 1).reshape(B, T, H, v.shape[-1])


def mla_mix(u, positions, g_qa, w_qup, g_kva, w_kvup):
    B, T, _ = u.shape
    H = MLA_HEADS
    cq = u[..., :MLA_Q_RANK]
    ckv = u[..., MLA_Q_RANK:MLA_Q_RANK + MLA_KV_RANK]
    kr = u[..., MLA_Q_RANK + MLA_KV_RANK:]
    q = (rmsnorm(cq, g_qa) @ w_qup).reshape(B, T, H, MLA_QK_DIM)
    kv = (rmsnorm(ckv, g_kva) @ w_kvup).reshape(B, T, H, MLA_NOPE_DIM + MLA_V_DIM)
    cos, sin = rope_tables(positions)
    q_rope = apply_rope(q[..., MLA_NOPE_DIM:], cos[:, :, None], sin[:, :, None])
    k_rope = apply_rope(kr, cos, sin)
    qh = jnp.concatenate([q[..., :MLA_NOPE_DIM], q_rope], axis=-1)
    kh = jnp.concatenate([kv[..., :MLA_NOPE_DIM],
                          jnp.broadcast_to(k_rope[:, :, None, :], (B, T, H, MLA_ROPE_DIM))], axis=-1)
    o = bidir_attention(qh, kh, kv[..., MLA_NOPE_DIM:])
    return o.reshape(B, T, MLA_WIDTH)


def peer_ffn(h, w_q, sub_keys, expert_u, expert_v):
    B, T, D = h.shape
    hb_all = h.reshape(-1, TOKEN_BLOCK, D)

    def block(hb):
        n = hb.shape[0]
        q = (hb @ w_q).reshape(n, PEER_HEADS, 2, PEER_HALF)
        s = jnp.einsum('nhcd,hckd->nhck', q, sub_keys).astype(jnp.float32)
        sc, ix = lax.top_k(s, PEER_TOPK)
        cand = sc[:, :, 0, :, None] + sc[:, :, 1, None, :]
        cidx = ix[:, :, 0, :, None] * PEER_N_KEYS + ix[:, :, 1, None, :]
        top, pos = lax.top_k(cand.reshape(n, PEER_HEADS, PEER_TOPK * PEER_TOPK), PEER_TOPK)
        eidx = jnp.take_along_axis(cidx.reshape(n, PEER_HEADS, -1), pos, axis=-1)
        gate = jax.nn.softmax(top, axis=-1)
        act = jax.nn.gelu(jnp.einsum('nhed,nd->nhe', expert_u[eidx], hb), approximate=False)
        return jnp.einsum('nhe,nhed->nd', (gate * act).astype(hb.dtype), expert_v[eidx])

    return lax.map(block, hb_all).reshape(B, T, D)


def setup_inputs(seed: int = 0) -> dict:
    key = jax.random.key(seed)
    ks = jax.random.split(key, 32)
    nrm = lambda k, shape, s: jax.random.normal(k, shape, jnp.float32) * s
    gain = lambda k, shape: 1.0 + 0.05 * jax.random.normal(k, shape, jnp.float32)
    L, D, W = DEPTH, D_MODEL, RW_WIDTH
    return {
        'x': nrm(ks[0], (BATCH, SEQ, D), 1.0),
        'p': nrm(ks[1], (DEPTH, BATCH, SEQ, PLE_DIM), 1.0),
        'positions': jnp.broadcast_to(jnp.arange(SEQ, dtype=jnp.int32)[None, :], (BATCH, SEQ)),
        'g_mix': gain(ks[2], (L, D)),
        'w_in': nrm(ks[3], (L, D, IN_COLS), D ** -0.5),
        'rw_mu': jax.random.uniform(ks[4], (L, RW_COLS), jnp.float32),
        'rw_w0': jax.random.uniform(ks[5], (L, 2, W), jnp.float32, -6.0, -1.0),
        'rw_w2': nrm(ks[6], (L, 2, RW_DECAY_LORA, W), 0.1 * RW_DECAY_LORA ** -0.5),
        'rw_a0': nrm(ks[7], (L, 2, W), 0.1),
        'rw_a2': nrm(ks[8], (L, 2, RW_ICLR_LORA, W), 0.5 * RW_ICLR_LORA ** -0.5),
        'rw_g2': nrm(ks[9], (L, RW_GATE_LORA, W), RW_GATE_LORA ** -0.5),
        'rw_k_k': 0.85 + nrm(ks[10], (L, W), 0.05),
        'rw_k_a': gain(ks[11], (L, W)),
        'rw_r_k': nrm(ks[12], (L, W), 0.1),
        'rw_gn_w': gain(ks[13], (L, W)),
        'rw_gn_b': nrm(ks[14], (L, W), 0.01),
        'mla_g_qa': gain(ks[15], (L, MLA_Q_RANK)),
        'mla_w_qup': nrm(ks[16], (L, MLA_Q_RANK, MLA_HEADS * MLA_QK_DIM), MLA_Q_RANK ** -0.5),
        'mla_g_kva': gain(ks[17], (L, MLA_KV_RANK)),
        'mla_w_kvup': nrm(ks[18], (L, MLA_KV_RANK, MLA_HEADS * (MLA_NOPE_DIM + MLA_V_DIM)), MLA_KV_RANK ** -0.5),
        'w_br_rwkv': nrm(ks[19], (L, W, D), W ** -0.5),
        'w_br_mla': nrm(ks[20], (L, MLA_WIDTH, D), MLA_WIDTH ** -0.5),
        'w_out': nrm(ks[21], (L, D, D), D ** -0.5),
        'g_ffn': gain(ks[22], (L, D)),
        'peer_w_q': nrm(ks[23], (L, D, PEER_HEADS * PEER_QUERY_DIM), D ** -0.5),
        'peer_sub_keys': nrm(ks[24], (L, PEER_HEADS, 2, PEER_N_KEYS, PEER_HALF), PEER_HALF ** -0.5),
        'peer_u': nrm(ks[25], (L, PEER_N_EXPERTS, D), D ** -0.5),
        'peer_v': nrm(ks[26], (L, PEER_N_EXPERTS, D), PEER_HEADS ** -0.5),
        'g_ple': gain(ks[27], (L, D)),
        'w_ple_gate': nrm(ks[28], (L, D, D), D ** -0.5),
        'w_ple_proj': nrm(ks[29], (L, PLE_DIM, D), PLE_DIM ** -0.5),
        'g_final': gain(ks[30], (D,)),
    }


def reference(x, p, positions, g_mix, w_in, rw_mu, rw_w0, rw_w2, rw_a0, rw_a2, rw_g2,
              rw_k_k, rw_k_a, rw_r_k, rw_gn_w, rw_gn_b, mla_g_qa, mla_w_qup, mla_g_kva,
              mla_w_kvup, w_br_rwkv, w_br_mla, w_out, g_ffn, peer_w_q, peer_sub_keys,
              peer_u, peer_v, g_ple, w_ple_gate, w_ple_proj, g_final):
    B, T, D = x.shape
    for i in range(DEPTH):
        h = rmsnorm(x, g_mix[i])
        u = h @ w_in[i]
        u_rw = u[..., :RW_COLS]
        u_mla = u[..., RW_COLS:RW_COLS + MLA_COLS]
        gates = jax.nn.sigmoid(u[..., RW_COLS + MLA_COLS:]).reshape(B, T, N_BRANCHES, D)
        y_rw = rwkv7_time_mix(u_rw, rw_mu[i], rw_w0[i], rw_w2[i], rw_a0[i], rw_a2[i], rw_g2[i],
                              rw_k_k[i], rw_k_a[i], rw_r_k[i], rw_gn_w[i], rw_gn_b[i])
        y_mla = mla_mix(u_mla, positions, mla_g_qa[i], mla_w_qup[i], mla_g_kva[i], mla_w_kvup[i])
        merged = gates[:, :, 0] * (y_rw @ w_br_rwkv[i]) + gates[:, :, 1] * (y_mla @ w_br_mla[i])
        x = x + merged @ w_out[i]
        x = x + peer_ffn(rmsnorm(x, g_ffn[i]), peer_w_q[i], peer_sub_keys[i], peer_u[i], peer_v[i])
        x = x + (p[i] @ w_ple_proj[i]) * jax.nn.sigmoid(rmsnorm(x, g_ple[i]) @ w_ple_gate[i])
    return rmsnorm(x, g_final)
```

```cpp
#include <hip/hip_runtime.h>
#include <cstdio>
#include <cstdint>

#define DI __device__ __forceinline__
#define LAS __attribute__((address_space(3)))
#define GAS __attribute__((address_space(1)))
typedef unsigned short bf16_t;
typedef short bf16x8 __attribute__((ext_vector_type(8)));
typedef float f32x4 __attribute__((ext_vector_type(4)));
typedef float f32x2 __attribute__((ext_vector_type(2)));
typedef float f32x16 __attribute__((ext_vector_type(16)));
typedef unsigned u32x4 __attribute__((ext_vector_type(4)));
typedef unsigned u32x2 __attribute__((ext_vector_type(2)));

constexpr int T = 16384, D = 1024, PLE = 256;
constexpr int RW_W = 512, RW_COLS = 1920, MLA_COLS = 416, GATE_COLS = 2048, IN_COLS = 4384;
constexpr int NTHREADS = 512, NWAVES = 8;
constexpr float NORM_EPS = 1e-6f;

constexpr size_t MiB = 1u << 20;
constexpr size_t WS_CTL = 0;
constexpr size_t CTL_ZERO_BYTES = 64 * 1024;
constexpr size_t WS_WT = 1 * MiB;
constexpr size_t WS_ET = 25 * MiB;
constexpr size_t WS_H = 89 * MiB;
constexpr size_t WS_U = 121 * MiB;
constexpr size_t WS_YM = 197 * MiB;
constexpr size_t WS_RO = 213 * MiB;
constexpr size_t WS_LG = 245 * MiB;
constexpr size_t WS_BS = 249 * MiB;
constexpr size_t WS_END = 250 * MiB;
constexpr int UW = 2432;
constexpr size_t WT_IN = 0;
constexpr size_t WT_GATE = WT_IN + (size_t)2432 * 1024;
constexpr size_t WT_PQ = WT_GATE + (size_t)2048 * 1024;
constexpr size_t WT_OUT = WT_PQ + (size_t)2048 * 1024;
constexpr size_t WT_PG = WT_OUT + (size_t)1024 * 1024;
constexpr size_t WT_BRA = WT_PG + (size_t)1024 * 1024;
constexpr size_t WT_BRB = WT_BRA + (size_t)1024 * 512;
constexpr size_t WT_PP = WT_BRB + (size_t)1024 * 512;
constexpr size_t WT_QUP = WT_PP + (size_t)1024 * 256;
constexpr size_t WT_KVUP = WT_QUP + (size_t)768 * 256;
constexpr size_t WT_SK = WT_KVUP + (size_t)1024 * 128;
constexpr size_t WT_G2 = WT_SK + (size_t)16 * 128 * 128;
constexpr size_t WT_END = WT_G2 + (size_t)512 * 128;
static_assert(WT_END * 2 <= 24 * MiB, "weights fit");

DI unsigned f2bf(float f) { unsigned u = __builtin_bit_cast(unsigned, f); return (u + 0x7fffu + ((u >> 16) & 1u)) >> 16; }
DI unsigned pk2(float lo, float hi) { return f2bf(lo) | (f2bf(hi) << 16); }
DI float bf2f(unsigned short b) { return __builtin_bit_cast(float, (unsigned)b << 16); }
DI float wave_sum(float v) {
#pragma unroll
    for (int o = 1; o < 64; o <<= 1) v += __shfl_xor(v, o);
    return v;
}
DI int tid_fresh() { int t = threadIdx.x; asm volatile("" : "+v"(t)); return t; }
DI float sigmoidf_(float x) { return 1.f / (1.f + __expf(-x)); }

#define XB_TMO      128
#define XB_XCNT(j)  (256  + 64 * (j))
#define XB_XSUB(j)  (1280 + 64 * (j))
#define XB_XGEN(j)  (2304 + 64 * (j))
#define XB_TOP      3328
#define XB_TOPGEN   3392
#define XCD_BAR_WORDS 3456
#define XB_SPIN_CAP (1u << 18)
DI unsigned xb_ld(unsigned* p)              { return __hip_atomic_load(p, __ATOMIC_RELAXED, __HIP_MEMORY_SCOPE_AGENT); }
DI unsigned xb_add(unsigned* p, unsigned v) { return __hip_atomic_fetch_add(p, v, __ATOMIC_RELAXED, __HIP_MEMORY_SCOPE_AGENT); }
DI unsigned xb_xcc_id() { return (unsigned)__builtin_amdgcn_s_getreg((3 << 11) | 20) & 0xFu; }
#define XB_SPIN(cond, bar) do { unsigned _sp = 0; while (cond) { __builtin_amdgcn_s_sleep(1); \
    if ((++_sp & 255u) == 0u) { if (xb_ld(&(bar)[XB_TMO])) break; if (_sp > XB_SPIN_CAP) { atomicAdd(&(bar)[XB_TMO], 1u); break; } } } } while (0)
struct XcdBarrier { unsigned* bar; unsigned x; volatile LAS unsigned* st; };
DI XcdBarrier xcd_barrier_post(unsigned* bar, volatile LAS unsigned* st) {
    XcdBarrier b; b.bar = bar; b.x = xb_xcc_id(); b.st = st;
    if (threadIdx.x == 0) (void)xb_add(&bar[XB_XCNT(b.x)], 1u);
    return b;
}
DI void xcd_barrier_complete(unsigned* bar, unsigned x, unsigned& nloc, unsigned& nx) {
    const unsigned G = gridDim.x * gridDim.y * gridDim.z;
    unsigned sum, cnt, mine, sp = 0u;
    for (;;) {
        sum = 0u; cnt = 0u; mine = 0u;
#pragma unroll
        for (unsigned j = 0; j < 16; ++j) { const unsigned c = xb_ld(&bar[XB_XCNT(j)]); sum += c; cnt += (c > 0u) ? 1u : 0u; mine = (j == x) ? c : mine; }
        if (sum == G) break;
        __builtin_amdgcn_s_sleep(1);
        if ((++sp & 255u) == 0u) { if (xb_ld(&bar[XB_TMO])) break; if (sp > XB_SPIN_CAP) { atomicAdd(&bar[XB_TMO], 1u); break; } }
    }
    nloc = mine > 0u ? mine : 1u; nx = cnt > 0u ? cnt : 1u;
}
DI void xcd_barrier(const XcdBarrier& b) {
    asm volatile("s_waitcnt vmcnt(0)" ::: "memory");
    __syncthreads();
    if (threadIdx.x == 0) {
        unsigned* bar = b.bar;
        __builtin_amdgcn_s_waitcnt(0);
        unsigned nloc = b.st[0], nx = b.st[1];
        if (nloc == 0u) { xcd_barrier_complete(bar, b.x, nloc, nx); b.st[0] = nloc; b.st[1] = nx; }
        const unsigned old = xb_add(&bar[XB_XSUB(b.x)], 1u);
        const unsigned gen = old / nloc;
        if (old + 1u == (gen + 1u) * nloc) {
            __builtin_amdgcn_fence(__ATOMIC_RELEASE, "agent");
            asm volatile("s_waitcnt vmcnt(0)" ::: "memory");
            const unsigned og = xb_add(&bar[XB_TOP], 1u);
            const unsigned tg = og / nx;
            if (og + 1u == (tg + 1u) * nx) xb_add(&bar[XB_TOPGEN], 1u);
            else XB_SPIN(xb_ld(&bar[XB_TOPGEN]) == tg, bar);
            __builtin_amdgcn_fence(__ATOMIC_ACQUIRE, "agent");
            xb_add(&bar[XB_XGEN(b.x)], 1u);
            asm volatile("s_waitcnt vmcnt(0)" ::: "memory");
        } else {
            XB_SPIN(xb_ld(&bar[XB_XGEN(b.x)]) == gen, bar);
            __builtin_amdgcn_fence(__ATOMIC_ACQUIRE, "agent");
            asm volatile("s_waitcnt vmcnt(0)" ::: "memory");
        }
    }
    __syncthreads();
}

struct Params { const float* in[32]; float* out; unsigned char* ws; };

constexpr int LDS_MISC = 147456 - 256;
constexpr int LDS_BYTES = 147456;

DI void transpose_item(const float* W, int ldw, int col_off, int K, bf16_t* WT, int ncols, LAS float* scr, int item, int lane) {
    const int nblk = ncols / 32, kb = item / nblk, nb = item % nblk, k0 = 64 * kb, n0 = 32 * nb;
#pragma unroll 8
    for (int i = 0; i < 32; ++i) { const int kk = 2 * i + (lane >> 5); scr[kk * 33 + (lane & 31)] = W[(size_t)(k0 + kk) * ldw + col_off + n0 + (lane & 31)]; }
    asm volatile("s_waitcnt lgkmcnt(0)" ::: "memory");
    const int c = lane & 7;
#pragma unroll
    for (int j = 0; j < 4; ++j) { const int n = (lane >> 3) + 8 * j; const LAS float* s = scr + (8 * c) * 33 + n;
        u32x4 o; o.x = pk2(s[0 * 33], s[1 * 33]); o.y = pk2(s[2 * 33], s[3 * 33]); o.z = pk2(s[4 * 33], s[5 * 33]); o.w = pk2(s[6 * 33], s[7 * 33]);
        *(u32x4*)(WT + (size_t)(n0 + n) * K + k0 + 8 * c) = o; }
    asm volatile("s_waitcnt lgkmcnt(0)" ::: "memory");
}
struct TrJob { const float* W; int ldw, col_off, K, ncols; bf16_t* WT; };
DI int trjob_items(const TrJob& j) { return (j.K / 64) * (j.ncols / 32); }

DI void rms_row_to_bf16(const float* xrow, const float* g, bf16_t* orow, int lane) {
    const f32x4* xr = (const f32x4*)xrow + lane; const f32x4* gr = (const f32x4*)g + lane;
    f32x4 v[4]; float s = 0.f;
#pragma unroll
    for (int j = 0; j < 4; ++j) { v[j] = xr[64 * j]; s += (v[j].x * v[j].x + v[j].y * v[j].y) + (v[j].z * v[j].z + v[j].w * v[j].w); }
    const float r = 1.f / sqrtf(wave_sum(s) * (1.f / D) + NORM_EPS);
    unsigned long long* o8 = (unsigned long long*)orow + lane;
#pragma unroll
    for (int j = 0; j < 4; ++j) { const f32x4 gg = gr[64 * j];
        o8[64 * j] = (unsigned long long)pk2(v[j].x * r * gg.x, v[j].y * r * gg.y) | ((unsigned long long)pk2(v[j].z * r * gg.z, v[j].w * r * gg.w) << 32); }
}
DI void rms_row_to_f32(const float* xrow, const float* g, float* orow, int lane) {
    const f32x4* xr = (const f32x4*)xrow + lane; const f32x4* gr = (const f32x4*)g + lane;
    f32x4 v[4]; float s = 0.f;
#pragma unroll
    for (int j = 0; j < 4; ++j) { v[j] = xr[64 * j]; s += (v[j].x * v[j].x + v[j].y * v[j].y) + (v[j].z * v[j].z + v[j].w * v[j].w); }
    const float r = 1.f / sqrtf(wave_sum(s) * (1.f / D) + NORM_EPS);
    f32x4* o = (f32x4*)orow + lane;
#pragma unroll
    for (int j = 0; j < 4; ++j) { const f32x4 gg = gr[64 * j]; o[64 * j] = (f32x4){v[j].x * r * gg.x, v[j].y * r * gg.y, v[j].z * r * gg.z, v[j].w * r * gg.w}; }
}

struct GemmSrc { const bf16_t* A; int lda; const bf16_t* Bt; int ldb; int K; };
constexpr int G_BM = 256, G_BN = 128, G_BK = 64, G_STAGE = 49152;
template <bool SWAP = true>
DI void gemm_accum(f32x4 (&acc)[4][4], const GemmSrc s, int row0, int col0, LAS unsigned char* lds) {
    const int tid = tid_fresh(), lane = tid & 63, wid = tid >> 6, wr = wid >> 1, wc = wid & 1, fr = lane & 15, fq = lane >> 4;
    const int nt = s.K / G_BK;
    const int sr = tid >> 3, sc = tid & 7;
    const bf16_t* gA = s.A + (size_t)(row0 + sr) * s.lda + sc * 8;
    const bf16_t* gB = s.Bt + (size_t)(col0 + sr) * s.ldb + sc * 8;
    const int swoff = sr * 128 + ((sc ^ (sr & 7)) << 4);
    u32x4 ra[4], rb[2];
#pragma unroll
    for (int i = 0; i < 4; ++i) ra[i] = *(const u32x4*)(gA + (size_t)(64 * i) * s.lda);
#pragma unroll
    for (int i = 0; i < 2; ++i) rb[i] = *(const u32x4*)(gB + (size_t)(64 * i) * s.ldb);
#pragma unroll
    for (int i = 0; i < 4; ++i) *(LAS u32x4*)(lds + i * 8192 + swoff) = ra[i];
#pragma unroll
    for (int i = 0; i < 2; ++i) *(LAS u32x4*)(lds + 32768 + i * 8192 + swoff) = rb[i];
    __syncthreads();
    const int aoff = (wr * 64 + fr) * 128, boff = 32768 + (wc * 64 + fr) * 128;
    for (int t = 0; t < nt; ++t) {
        LAS unsigned char* cur = lds + (t & 1) * G_STAGE;
        LAS unsigned char* nxt = lds + ((t + 1) & 1) * G_STAGE;
        const bool more = (t + 1 < nt);
        if (more) {
#pragma unroll
            for (int i = 0; i < 4; ++i) ra[i] = *(const u32x4*)(gA + (size_t)(64 * i) * s.lda + (t + 1) * G_BK);
#pragma unroll
            for (int i = 0; i < 2; ++i) rb[i] = *(const u32x4*)(gB + (size_t)(64 * i) * s.ldb + (t + 1) * G_BK);
        }
#pragma unroll
        for (int kk = 0; kk < 2; ++kk) {
            const int ch = ((kk * 4 + fq) ^ (fr & 7)) << 4;
            bf16x8 a[4], b[4];
#pragma unroll
            for (int m = 0; m < 4; ++m) a[m] = *(const LAS bf16x8*)(cur + aoff + m * 2048 + ch);
#pragma unroll
            for (int n = 0; n < 4; ++n) b[n] = *(const LAS bf16x8*)(cur + boff + n * 2048 + ch);
#pragma unroll
            for (int m = 0; m < 4; ++m)
#pragma unroll
                for (int n = 0; n < 4; ++n) acc[m][n] = SWAP ? __builtin_amdgcn_mfma_f32_16x16x32_bf16(b[n], a[m], acc[m][n], 0, 0, 0)
                                                        : __builtin_amdgcn_mfma_f32_16x16x32_bf16(a[m], b[n], acc[m][n], 0, 0, 0);
        }
        if (more) {
#pragma unroll
            for (int i = 0; i < 4; ++i) *(LAS u32x4*)(nxt + i * 8192 + swoff) = ra[i];
#pragma unroll
            for (int i = 0; i < 2; ++i) *(LAS u32x4*)(nxt + 32768 + i * 8192 + swoff) = rb[i];
        }
        __syncthreads();
    }
}
DI void acc_zero(f32x4 (&acc)[4][4]) {
#pragma unroll
    for (int m = 0; m < 4; ++m)
#pragma unroll
        for (int n = 0; n < 4; ++n) acc[m][n] = (f32x4){0.f, 0.f, 0.f, 0.f};
}
#define EPI_LOOP(row0, col0) \
    const int _tid = tid_fresh(); const int _lane = _tid & 63, _wid = _tid >> 6, _wr = _wid >> 1, _wc = _wid & 1, _fr = _lane & 15, _fq = _lane >> 4; \
    _Pragma("unroll") for (int m = 0; m < 4; ++m) _Pragma("unroll") for (int n = 0; n < 4; ++n)
#define EPI_ROW(row0) ((row0) + _wr * 64 + m * 16 + _fr)
#define EPI_COL(col0) ((col0) + _wc * 64 + n * 16 + 4 * _fq)


constexpr int PEER_H = 8, PEER_K = 16;
struct ScEnt { float v; int i; };
DI float gelu_erf(float x) { return 0.5f * x * (1.f + erff(x * 0.70710678118654752f)); }

DI void peer_query_tile(const bf16_t* Hb, const bf16_t* WTpq, const bf16_t* SK, ScEnt* SC, int pm, int pn, LAS unsigned char* lds) {
    const int tid = tid_fresh(), lane = tid & 63, wid = tid >> 6, wr = wid >> 1, wc = wid & 1, fr = lane & 15, fq = lane >> 4;
    const int row0 = pm * G_BM, col0 = pn * G_BN;
    f32x4 acc[4][4]; acc_zero(acc);
    gemm_accum(acc, GemmSrc{Hb, D, WTpq, D, D}, row0, col0, lds);
#pragma unroll
    for (int m = 0; m < 4; ++m)
#pragma unroll
        for (int n = 0; n < 4; ++n) {
            const int r = wr * 64 + m * 16 + fr, c = wc * 64 + n * 16 + 4 * fq;
            const int kt = c >> 6, ch = (c & 63) >> 3;
            *(LAS u32x2*)(lds + kt * 32768 + r * 128 + ((ch ^ (r & 7)) << 4) + (c & 7) * 2) = (u32x2){pk2(acc[m][n][0], acc[m][n][1]), pk2(acc[m][n][2], acc[m][n][3])};
        }
    {
        const bf16_t* sk = SK + (size_t)pn * 128 * 128;
#pragma unroll
        for (int i = 0; i < 4; ++i) { const int id = tid + i * 512, r = id >> 4, c16 = id & 15, kt = c16 >> 3, ch = c16 & 7;
            *(LAS u32x4*)(lds + 65536 + kt * 16384 + r * 128 + ((ch ^ (r & 7)) << 4)) = *(const u32x4*)(sk + (size_t)r * 128 + c16 * 8); }
    }
    __syncthreads();
    acc_zero(acc);
#pragma unroll
    for (int kt = 0; kt < 2; ++kt)
#pragma unroll
        for (int kk = 0; kk < 2; ++kk) {
            const int ch = ((kk * 4 + fq) ^ (fr & 7)) << 4;
            bf16x8 a[4], b[4];
#pragma unroll
            for (int m = 0; m < 4; ++m) a[m] = *(const LAS bf16x8*)(lds + kt * 32768 + (wr * 64 + m * 16 + fr) * 128 + ch);
#pragma unroll
            for (int n = 0; n < 4; ++n) b[n] = *(const LAS bf16x8*)(lds + 65536 + kt * 16384 + (wc * 64 + n * 16 + fr) * 128 + ch);
#pragma unroll
            for (int m = 0; m < 4; ++m)
#pragma unroll
                for (int n = 0; n < 4; ++n) acc[m][n] = __builtin_amdgcn_mfma_f32_16x16x32_bf16(b[n], a[m], acc[m][n], 0, 0, 0);
        }
    __syncthreads();
    LAS float* SS = (LAS float*)lds;
#pragma unroll
    for (int m = 0; m < 4; ++m)
#pragma unroll
        for (int n = 0; n < 4; ++n) {
            const int r = wr * 64 + m * 16 + fr, c = wc * 64 + n * 16 + 4 * fq;
#pragma unroll
            for (int j = 0; j < 4; ++j) SS[r * 129 + c + j] = acc[m][n][j];
        }
    __syncthreads();
    const int trow = tid & 255, half = tid >> 8;
    float v[64];
#pragma unroll
    for (int i = 0; i < 64; ++i) v[i] = SS[trow * 129 + half * 64 + i];
    __syncthreads();
    LAS float* LV = (LAS float*)lds;
    LAS int* LI = (LAS int*)(lds + 32768);
    for (int r = 0; r < 16; ++r) {
        float best = v[0]; int bi = 0;
#pragma unroll
        for (int i = 1; i < 64; ++i) { const bool g = v[i] > best; best = g ? v[i] : best; bi = g ? i : bi; }
        LV[(trow * 2 + half) * 16 + r] = best; LI[(trow * 2 + half) * 16 + r] = bi + half * 64;
#pragma unroll
        for (int i = 0; i < 64; ++i) v[i] = (i == bi) ? -INFINITY : v[i];
    }
    __syncthreads();
    if (half == 0) {
        int i = 0, j = 0;
        ScEnt* dst = SC + ((size_t)(row0 + trow) * 16 + pn) * 16;
        for (int r = 0; r < 16; ++r) {
            const float av = LV[(trow * 2) * 16 + i], bv = LV[(trow * 2 + 1) * 16 + j];
            const int ai = LI[(trow * 2) * 16 + i], bi = LI[(trow * 2 + 1) * 16 + j];
            const bool ta = av >= bv;
            ScEnt e; e.v = ta ? av : bv; e.i = ta ? ai : bi;
            dst[r] = e; i += ta ? 1 : 0; j += ta ? 0 : 1;
        }
    }
    __syncthreads();
}

DI void peer_token(const float* x1row, float* x2row, bf16_t* hrow, const ScEnt* SCt, const bf16_t* EU, const bf16_t* EV, const float* g_ple, int lane) {
    float h[16];
    { const u32x4 a = *(const u32x4*)(hrow + lane * 16), b = *(const u32x4*)(hrow + lane * 16 + 8);
#pragma unroll
      for (int j = 0; j < 4; ++j) { h[2 * j] = __builtin_bit_cast(float, a[j] << 16); h[2 * j + 1] = __builtin_bit_cast(float, a[j] & 0xffff0000u);
                                    h[8 + 2 * j] = __builtin_bit_cast(float, b[j] << 16); h[8 + 2 * j + 1] = __builtin_bit_cast(float, b[j] & 0xffff0000u); } }
    float o[16];
#pragma unroll
    for (int j = 0; j < 16; ++j) o[j] = 0.f;
    for (int hd = 0; hd < PEER_H; ++hd) {
        const ScEnt* L0 = SCt + (hd * 2) * 16; const ScEnt* L1 = SCt + (hd * 2 + 1) * 16;
        const float s0 = L0[lane >> 2].v;
        float c0 = s0 + L1[(lane & 3) * 4 + 0].v, c1 = s0 + L1[(lane & 3) * 4 + 1].v, c2 = s0 + L1[(lane & 3) * 4 + 2].v, c3 = s0 + L1[(lane & 3) * 4 + 3].v;
        float myv = -INFINITY; int myp = 0;
        for (int r = 0; r < 16; ++r) {
            float bv = c0; int bp = lane * 4;
            if (c1 > bv) { bv = c1; bp = lane * 4 + 1; }
            if (c2 > bv) { bv = c2; bp = lane * 4 + 2; }
            if (c3 > bv) { bv = c3; bp = lane * 4 + 3; }
#pragma unroll
            for (int off = 32; off >= 1; off >>= 1) { const float ov = __shfl_xor(bv, off); const int op = __shfl_xor(bp, off);
                const bool t = (ov > bv) || (ov == bv && op < bp); bv = t ? ov : bv; bp = t ? op : bp; }
            if (lane == r) { myv = bv; myp = bp; }
            if ((bp >> 2) == lane) { const int q = bp & 3; c0 = (q == 0) ? -INFINITY : c0; c1 = (q == 1) ? -INFINITY : c1; c2 = (q == 2) ? -INFINITY : c2; c3 = (q == 3) ? -INFINITY : c3; }
        }
        const float mx = __shfl(myv, 0);
        const float e = (lane < 16) ? __expf(myv - mx) : 0.f;
        const float gate = e / wave_sum(e);
        int eidx = 0;
        if (lane < 16) eidx = L0[myp >> 4].i * 128 + L1[myp & 15].i;
        for (int ex = 0; ex < 16; ++ex) {
            const int id = __shfl(eidx, ex); const float gt = __shfl(gate, ex);
            const bf16_t* ur = EU + (size_t)id * D + lane * 16; const bf16_t* vr = EV + (size_t)id * D + lane * 16;
            const u32x4 ua = *(const u32x4*)ur, ub = *(const u32x4*)(ur + 8);
            const u32x4 va = *(const u32x4*)vr, vb = *(const u32x4*)(vr + 8);
            float d = 0.f;
#pragma unroll
            for (int j = 0; j < 4; ++j) { d += h[2 * j] * __builtin_bit_cast(float, ua[j] << 16) + h[2 * j + 1] * __builtin_bit_cast(float, ua[j] & 0xffff0000u);
                                          d += h[8 + 2 * j] * __builtin_bit_cast(float, ub[j] << 16) + h[8 + 2 * j + 1] * __builtin_bit_cast(float, ub[j] & 0xffff0000u); }
            d = wave_sum(d);
            const float cf = gt * gelu_erf(d);
#pragma unroll
            for (int j = 0; j < 4; ++j) { o[2 * j] += cf * __builtin_bit_cast(float, va[j] << 16); o[2 * j + 1] += cf * __builtin_bit_cast(float, va[j] & 0xffff0000u);
                                          o[8 + 2 * j] += cf * __builtin_bit_cast(float, vb[j] << 16); o[8 + 2 * j + 1] += cf * __builtin_bit_cast(float, vb[j] & 0xffff0000u); }
        }
    }
    float ss = 0.f;
#pragma unroll
    for (int j = 0; j < 4; ++j) { const f32x4 xv = *(const f32x4*)(x1row + lane * 16 + 4 * j);
        o[4 * j] += xv.x; o[4 * j + 1] += xv.y; o[4 * j + 2] += xv.z; o[4 * j + 3] += xv.w;
        *(f32x4*)(x2row + lane * 16 + 4 * j) = (f32x4){o[4 * j], o[4 * j + 1], o[4 * j + 2], o[4 * j + 3]};
        ss += o[4 * j] * o[4 * j] + o[4 * j + 1] * o[4 * j + 1] + o[4 * j + 2] * o[4 * j + 2] + o[4 * j + 3] * o[4 * j + 3]; }
    const float rr = 1.f / sqrtf(wave_sum(ss) * (1.f / D) + NORM_EPS);
    u32x4 w0, w1;
#pragma unroll
    for (int j = 0; j < 4; ++j) { const f32x4 g0 = *(const f32x4*)(g_ple + lane * 16 + 4 * j);
        const unsigned lo = pk2(o[4 * j] * rr * g0.x, o[4 * j + 1] * rr * g0.y), hi = pk2(o[4 * j + 2] * rr * g0.z, o[4 * j + 3] * rr * g0.w);
        if (j < 2) { w0[2 * j] = lo; w0[2 * j + 1] = hi; } else { w1[2 * (j - 2)] = lo; w1[2 * (j - 2) + 1] = hi; } }
    *(u32x4*)(hrow + lane * 16) = w0; *(u32x4*)(hrow + lane * 16 + 8) = w1;
}


DI float ushift(const bf16_t* U, int t, int col, float mu) {
    const float c = bf2f(U[(size_t)t * UW + col]);
    const float pv = t > 0 ? bf2f(U[(size_t)(t - 1) * UW + col]) : 0.f;
    const float nx = t < T - 1 ? bf2f(U[(size_t)(t + 1) * UW + col]) : 0.f;
    return c + mu * (0.5f * (pv + nx) - c);
}
DI void rwkv_scan_naive(const Params& P, const bf16_t* U, bf16_t* RO, float* BS, int d, int h, LAS unsigned char* lds) {
    const int tid = tid_fresh();
    LAS float* W2S = (LAS float*)lds;
    LAS float* A2S = W2S + 4096;
    LAS float* INB = A2S + 4096;
    LAS float* STP = INB + 5 * 2048;
    const float* mu = P.in[5];
    const float* w2 = P.in[7] + (size_t)d * 64 * 512;
    const float* a2 = P.in[9] + (size_t)d * 64 * 512;
    for (int i = tid; i < 4096; i += NTHREADS) { const int l = i >> 6, c = i & 63; W2S[i] = w2[l * 512 + h * 64 + c]; A2S[i] = a2[l * 512 + h * 64 + c]; }
    const int i2 = tid >> 4, c2 = (tid & 15) * 4;
    float w0c[4], a0c[4], kkc[4], kac[4], rkc[4];
#pragma unroll
    for (int j = 0; j < 4; ++j) { const int hc = h * 64 + c2 + j; w0c[j] = P.in[6][d * 512 + hc]; a0c[j] = P.in[8][d * 512 + hc]; kkc[j] = P.in[11][hc]; kac[j] = P.in[12][hc]; rkc[j] = P.in[13][hc]; }
    const int v3 = tid >> 3, q3 = tid & 7;
    float S[8];
#pragma unroll
    for (int j = 0; j < 8; ++j) S[j] = 0.f;
    __syncthreads();
    for (int ch = 0; ch < T / 32; ++ch) {
#pragma unroll 2
        for (int e = tid; e < 5 * 2048; e += NTHREADS) {
            const int grp = e >> 11, i = (e >> 6) & 31, c = e & 63;
            const int sidx = ch * 32 + i, t = d ? (T - 1 - sidx) : sidx;
            const int col = (grp < 3 ? grp * 512 + h * 64 : (grp == 3 ? 1536 : 1664) + d * 64) + c;
            float v = ushift(U, t, col, mu[col]);
            if (grp == 3) v = tanhf(v);
            INB[e] = v;
        }
        __syncthreads();
        {
            float wl[4], al[4];
#pragma unroll
            for (int j = 0; j < 4; ++j) { wl[j] = w0c[j]; al[j] = a0c[j]; }
#pragma unroll 4
            for (int l = 0; l < 64; ++l) {
                const float tw = INB[3 * 2048 + i2 * 64 + l], ta = INB[4 * 2048 + i2 * 64 + l];
                const f32x4 wv = *(const LAS f32x4*)(W2S + l * 64 + c2), av = *(const LAS f32x4*)(A2S + l * 64 + c2);
#pragma unroll
                for (int j = 0; j < 4; ++j) { wl[j] += tw * wv[j]; al[j] += ta * av[j]; }
            }
            float kk[4], ss = 0.f, bsum = 0.f, kd[4], alr[4], dec[4], rr[4];
#pragma unroll
            for (int j = 0; j < 4; ++j) {
                const float kv = INB[1 * 2048 + i2 * 64 + c2 + j]; rr[j] = INB[0 * 2048 + i2 * 64 + c2 + j];
                kk[j] = kv * kkc[j]; ss += kk[j] * kk[j];
                alr[j] = 1.f / (1.f + expf(-al[j]));
                const float wlog = -log1pf(expf(-wl[j])) - 0.5f;
                dec[j] = expf(-expf(wlog));
                kd[j] = kv * (1.f + (alr[j] - 1.f) * kac[j]);
                bsum += rr[j] * kd[j] * rkc[j];
            }
#pragma unroll
            for (int o = 1; o < 16; o <<= 1) { ss += __shfl_xor(ss, o); bsum += __shfl_xor(bsum, o); }
            const float inv = 1.f / fmaxf(sqrtf(ss), 1e-12f);
            const int sidx = ch * 32 + i2, t = d ? (T - 1 - sidx) : sidx;
            if ((tid & 15) == 0) BS[((size_t)d * T + t) * 8 + h] = bsum;
#pragma unroll
            for (int j = 0; j < 4; ++j) { const float k1 = kk[j] * inv;
                STP[(i2 * 5 + 0) * 64 + c2 + j] = -k1; STP[(i2 * 5 + 1) * 64 + c2 + j] = k1 * alr[j];
                STP[(i2 * 5 + 2) * 64 + c2 + j] = kd[j]; STP[(i2 * 5 + 3) * 64 + c2 + j] = dec[j]; STP[(i2 * 5 + 4) * 64 + c2 + j] = rr[j]; }
        }
        __syncthreads();
#pragma unroll 2
        for (int i = 0; i < 32; ++i) {
            const LAS float* sp = STP + i * 320 + q3 * 8;
            float av[8], bv[8], kv[8], wv[8], rv[8];
#pragma unroll
            for (int j = 0; j < 8; j += 4) {
                const f32x4 a4 = *(const LAS f32x4*)(sp + j), b4 = *(const LAS f32x4*)(sp + 64 + j), k4 = *(const LAS f32x4*)(sp + 128 + j), w4 = *(const LAS f32x4*)(sp + 192 + j), r4 = *(const LAS f32x4*)(sp + 256 + j);
#pragma unroll
                for (int u = 0; u < 4; ++u) { av[j + u] = a4[u]; bv[j + u] = b4[u]; kv[j + u] = k4[u]; wv[j + u] = w4[u]; rv[j + u] = r4[u]; }
            }
            const float vv = INB[2 * 2048 + i * 64 + v3];
            float sa = 0.f;
#pragma unroll
            for (int j = 0; j < 8; ++j) sa += S[j] * av[j];
            sa += __shfl_xor(sa, 1); sa += __shfl_xor(sa, 2); sa += __shfl_xor(sa, 4);
            float ov = 0.f;
#pragma unroll
            for (int j = 0; j < 8; ++j) { S[j] = S[j] * wv[j] + sa * bv[j] + vv * kv[j]; ov += S[j] * rv[j]; }
            ov += __shfl_xor(ov, 1); ov += __shfl_xor(ov, 2); ov += __shfl_xor(ov, 4);
            if (q3 == 0) { const int sidx = ch * 32 + i, t = d ? (T - 1 - sidx) : sidx; RO[((size_t)d * T + t) * 512 + h * 64 + v3] = (bf16_t)f2bf(ov); }
        }
        __syncthreads();
    }
}
DI void rwkv_merge_token(const Params& P, const bf16_t* U, const bf16_t* RO, const float* BS, const bf16_t* Gm, bf16_t* YRW, int t, int lane) {
    const int c0 = lane * 8, h = lane >> 3;
    const u32x4 o0 = *(const u32x4*)(RO + (size_t)t * 512 + c0), o1 = *(const u32x4*)(RO + ((size_t)T + t) * 512 + c0);
    float o[8]; float s = 0.f;
#pragma unroll
    for (int j = 0; j < 4; ++j) { o[2 * j] = __builtin_bit_cast(float, o0[j] << 16) + __builtin_bit_cast(float, o1[j] << 16);
        o[2 * j + 1] = __builtin_bit_cast(float, o0[j] & 0xffff0000u) + __builtin_bit_cast(float, o1[j] & 0xffff0000u); s += o[2 * j] + o[2 * j + 1]; }
    s += __shfl_xor(s, 1); s += __shfl_xor(s, 2); s += __shfl_xor(s, 4);
    const float mean = s * (1.f / 64.f); float q = 0.f;
#pragma unroll
    for (int j = 0; j < 8; ++j) { o[j] -= mean; q += o[j] * o[j]; }
    q += __shfl_xor(q, 1); q += __shfl_xor(q, 2); q += __shfl_xor(q, 4);
    const float rstd = 1.f / sqrtf(q * (1.f / 64.f) + 64e-5f);
    const float bonus = BS[(size_t)t * 8 + h] + BS[((size_t)T + t) * 8 + h];
    const u32x4 g4 = *(const u32x4*)(Gm + (size_t)t * 512 + c0);
    u32x4 w;
#pragma unroll
    for (int j = 0; j < 4; ++j) {
        float y[2];
#pragma unroll
        for (int u = 0; u < 2; ++u) { const int c = c0 + 2 * j + u;
            const float vs = ushift(U, t, 1024 + c, P.in[5][1024 + c]);
            const float gg = u ? __builtin_bit_cast(float, g4[j] & 0xffff0000u) : __builtin_bit_cast(float, g4[j] << 16);
            y[u] = (o[2 * j + u] * rstd * P.in[14][c] + P.in[15][c] + bonus * vs) * gg; }
        w[j] = pk2(y[0], y[1]);
    }
    *(u32x4*)(YRW + (size_t)t * 512 + c0) = w;
}


constexpr float QSCALE = 0.10206207261596575f * 1.4426950408889634f;
DI void mla_prep_token(const Params& P, const bf16_t* U, bf16_t* CQN, bf16_t* CKVN, bf16_t* Kb, int t, int lane) {
    const bf16_t* ur = U + (size_t)t * UW;
    { const u32x2 v = *(const u32x2*)(ur + 1920 + lane * 4);
      float x[4] = {__builtin_bit_cast(float, v.x << 16), __builtin_bit_cast(float, v.x & 0xffff0000u), __builtin_bit_cast(float, v.y << 16), __builtin_bit_cast(float, v.y & 0xffff0000u)};
      const float ss = wave_sum(x[0] * x[0] + x[1] * x[1] + x[2] * x[2] + x[3] * x[3]);
      const float rr = 1.f / sqrtf(ss * (1.f / 256.f) + NORM_EPS);
      const f32x4 g = *(const f32x4*)(P.in[16] + lane * 4);
      *(u32x2*)(CQN + (size_t)t * 256 + lane * 4) = (u32x2){pk2(x[0] * rr * g.x, x[1] * rr * g.y), pk2(x[2] * rr * g.z, x[3] * rr * g.w)}; }
    { const unsigned v = *(const unsigned*)(ur + 2176 + lane * 2);
      const float x0 = __builtin_bit_cast(float, v << 16), x1 = __builtin_bit_cast(float, v & 0xffff0000u);
      const float ss = wave_sum(x0 * x0 + x1 * x1);
      const float rr = 1.f / sqrtf(ss * (1.f / 128.f) + NORM_EPS);
      const f32x2 g = *(const f32x2*)(P.in[18] + lane * 2);
      *(unsigned*)(CKVN + (size_t)t * 128 + lane * 2) = pk2(x0 * rr * g.x, x1 * rr * g.y); }
    if (lane < 16) {
        const float x1 = bf2f(ur[2304 + lane]), x2 = bf2f(ur[2304 + 16 + lane]);
        const float pos = (float)((const int*)P.in[2])[t];
        const float inv = exp2f(-(float)lane * (13.287712379549449f / 16.f));
        const float ang = pos * inv; float sn, cs; sincosf(ang, &sn, &cs);
        const bf16_t o1 = (bf16_t)f2bf(x1 * cs - x2 * sn), o2 = (bf16_t)f2bf(x2 * cs + x1 * sn);
#pragma unroll
        for (int h = 0; h < 8; ++h) { bf16_t* kp = Kb + ((size_t)h * T + t) * 96; kp[64 + lane] = o1; kp[80 + lane] = o2; }
    }
}
constexpr int ATT_KB = 64 * 208, ATT_VB = 64 * 144, ATT_STAGE = ATT_KB + ATT_VB, ATT_SCR = 2 * ATT_STAGE;
DI int crow(int reg, int hh) { return (reg & 3) + 8 * (reg >> 2) + 4 * hh; }
DI void attn_unit(const bf16_t* Q, const bf16_t* Kb, const bf16_t* VT, bf16_t* YM, int h, int qb, LAS unsigned char* lds) {
    const int tid = tid_fresh(), lane = tid & 63, wid = tid >> 6, r = lane & 31, hh = lane >> 5;
    const int q0 = qb * 256 + wid * 32;
    bf16x8 qf[6];
    { const bf16_t* qp = Q + ((size_t)h * T + q0 + r) * 96 + 8 * hh;
#pragma unroll
      for (int ks = 0; ks < 6; ++ks) qf[ks] = *(const bf16x8*)(qp + 16 * ks); }
    f32x16 o0, o1;
#pragma unroll
    for (int i = 0; i < 16; ++i) { o0[i] = 0.f; o1[i] = 0.f; }
    float mrow = -1e30f, lrow = 0.f;
    LAS float* scr = (LAS float*)(lds + ATT_SCR + wid * 256);
    const bf16_t* kg = Kb + (size_t)h * T * 96;
    const bf16_t* vg = VT + (size_t)(h * 64 + (tid >> 3)) * T + (tid & 7) * 8;
    const int kl0 = (tid / 12) * 208 + (tid % 12) * 16, c1 = 512 + tid, kl1 = (c1 / 12) * 208 + (c1 % 12) * 16;
    const int vl = ATT_KB + (tid >> 3) * 144 + (tid & 7) * 16;
    u32x4 rk0, rk1, rv;
    rk0 = *(const u32x4*)(kg + (size_t)tid * 8); if (tid < 256) rk1 = *(const u32x4*)(kg + (size_t)c1 * 8);
    rv = *(const u32x4*)(vg);
    *(LAS u32x4*)(lds + kl0) = rk0; if (tid < 256) *(LAS u32x4*)(lds + kl1) = rk1; *(LAS u32x4*)(lds + vl) = rv;
    __syncthreads();
    constexpr int NT_ = T / 64;
    for (int t = 0; t < NT_; ++t) {
        LAS unsigned char* cur = lds + (t & 1) * ATT_STAGE;
        LAS unsigned char* nxt = lds + ((t + 1) & 1) * ATT_STAGE;
        const bool more = (t + 1 < NT_);
        if (more) { const size_t t1 = (size_t)(t + 1) * 64;
            rk0 = *(const u32x4*)(kg + t1 * 96 + (size_t)tid * 8); if (tid < 256) rk1 = *(const u32x4*)(kg + t1 * 96 + (size_t)c1 * 8);
            rv = *(const u32x4*)(vg + t1); }
        f32x16 p0, p1;
#pragma unroll
        for (int i = 0; i < 16; ++i) { p0[i] = 0.f; p1[i] = 0.f; }
#pragma unroll
        for (int ks = 0; ks < 6; ++ks) {
            const bf16x8 ka0 = *(const LAS bf16x8*)(cur + r * 208 + (16 * ks + 8 * hh) * 2);
            const bf16x8 ka1 = *(const LAS bf16x8*)(cur + (32 + r) * 208 + (16 * ks + 8 * hh) * 2);
            p0 = __builtin_amdgcn_mfma_f32_32x32x16_bf16(ka0, qf[ks], p0, 0, 0, 0);
            p1 = __builtin_amdgcn_mfma_f32_32x32x16_bf16(ka1, qf[ks], p1, 0, 0, 0);
        }
        float mx = p0[0];
#pragma unroll
        for (int i = 1; i < 16; ++i) mx = fmaxf(mx, p0[i]);
#pragma unroll
        for (int i = 0; i < 16; ++i) mx = fmaxf(mx, p1[i]);
        mx = fmaxf(mx, __shfl_xor(mx, 32));
        const float mnew = fmaxf(mrow, mx);
        if (__any(mnew > mrow)) {
            const float alpha = exp2f(mrow - mnew);
            lrow *= alpha; mrow = mnew;
            if (hh == 0) scr[r] = alpha;
            asm volatile("s_waitcnt lgkmcnt(0)" ::: "memory");
#pragma unroll
            for (int i = 0; i < 16; ++i) { const float a = scr[crow(i, hh)]; o0[i] *= a; o1[i] *= a; }
        }
        float ls = 0.f;
#pragma unroll
        for (int i = 0; i < 16; ++i) { p0[i] = exp2f(p0[i] - mrow); p1[i] = exp2f(p1[i] - mrow); ls += p0[i] + p1[i]; }
        lrow += ls;
        bf16x8 pa[4];
#pragma unroll
        for (int ks = 0; ks < 4; ++ks) {
            u32x4 w;
#pragma unroll
            for (int j = 0; j < 4; ++j) { const int i0 = 8 * (ks & 1) + 2 * j; w[j] = (ks < 2) ? pk2(p0[i0], p0[i0 + 1]) : pk2(p1[i0], p1[i0 + 1]); }
            pa[ks] = __builtin_bit_cast(bf16x8, w);
        }
#pragma unroll
        for (int ks = 0; ks < 4; ++ks) {
            const bf16x8 vb0 = *(const LAS bf16x8*)(cur + ATT_KB + r * 144 + (16 * ks + 8 * hh) * 2);
            const bf16x8 vb1 = *(const LAS bf16x8*)(cur + ATT_KB + (32 + r) * 144 + (16 * ks + 8 * hh) * 2);
            o0 = __builtin_amdgcn_mfma_f32_32x32x16_bf16(pa[ks], vb0, o0, 0, 0, 0);
            o1 = __builtin_amdgcn_mfma_f32_32x32x16_bf16(pa[ks], vb1, o1, 0, 0, 0);
        }
        if (more) { *(LAS u32x4*)(nxt + kl0) = rk0; if (tid < 256) *(LAS u32x4*)(nxt + kl1) = rk1; *(LAS u32x4*)(nxt + vl) = rv; }
        __syncthreads();
    }
    lrow += __shfl_xor(lrow, 32);
    if (hh == 0) scr[32 + r] = 1.f / lrow;
    asm volatile("s_waitcnt lgkmcnt(0)" ::: "memory");
#pragma unroll
    for (int i = 0; i < 16; ++i) { const int q = crow(i, hh); const float il = scr[32 + q];
        bf16_t* yp = YM + (size_t)(q0 + q) * 512 + h * 64;
        yp[r] = (bf16_t)f2bf(o0[i] * il); yp[32 + r] = (bf16_t)f2bf(o1[i] * il); }
    __syncthreads();
}

__global__ void __launch_bounds__(NTHREADS, 2) mega(Params P) {
    extern __shared__ __attribute__((aligned(16))) unsigned char lds_raw[];
    LAS unsigned char* lds = (LAS unsigned char*)lds_raw;
    const int G = gridDim.x, bid = blockIdx.x, NGW = G * NWAVES;
#define PHASE_IDS() const int tid = tid_fresh(); const int lane = tid & 63; const int wave = __builtin_amdgcn_readfirstlane(tid >> 6); const int gw = bid * NWAVES + wave; (void)lane; (void)gw; (void)wave;
    volatile LAS unsigned* MISC = (volatile LAS unsigned*)(lds + LDS_MISC);
    if (threadIdx.x < 64) MISC[threadIdx.x] = 0u;
    __syncthreads();
    unsigned char* ws = P.ws;
    XcdBarrier bar = xcd_barrier_post((unsigned*)(ws + WS_CTL) + 1024, MISC + 8);
#define GRID_BAR() xcd_barrier(bar)

    bf16_t* WT = (bf16_t*)(ws + WS_WT);
    bf16_t* Hb = (bf16_t*)(ws + WS_H);
    float* XB = (float*)(ws + WS_U);
    bf16_t* PB = (bf16_t*)(ws + WS_RO);

    bf16_t* EU = (bf16_t*)(ws + WS_ET);
    bf16_t* EV = (bf16_t*)(ws + WS_ET + 32 * MiB);
    ScEnt* SC = (ScEnt*)P.out;
    bf16_t* U = (bf16_t*)(ws + WS_U);
    bf16_t* YM = (bf16_t*)(ws + WS_YM);
    bf16_t* RO = (bf16_t*)(ws + WS_RO);
    bf16_t* LG = (bf16_t*)(ws + WS_LG);
    float* BS = (float*)(ws + WS_BS);
    bf16_t* Gm = (bf16_t*)(ws + WS_ET);
    bf16_t* YRW = (bf16_t*)(ws + WS_ET + 16 * MiB);
    bf16_t* MG = (bf16_t*)P.out;
    bf16_t* CQN = (bf16_t*)(ws + WS_ET + 32 * MiB);
    bf16_t* CKVN = (bf16_t*)(ws + WS_ET + 40 * MiB);
    bf16_t* Qb = (bf16_t*)P.out;
    bf16_t* Kb = Qb + (size_t)8 * T * 96;
    bf16_t* VT = Kb + (size_t)8 * T * 96;
#define gt ((size_t)(blockIdx.x * NTHREADS + tid))
#define GT ((size_t)(gridDim.x * NTHREADS))

    {
    PHASE_IDS();
    {
        LAS float* scr = (LAS float*)(lds + wave * 16384);
        const TrJob jobs[12] = {
            {P.in[4], IN_COLS, 0, 1024, 1920, WT + WT_IN},
            {P.in[4], IN_COLS, 1920, 1024, 416, WT + WT_IN + (size_t)1920 * 1024},
            {P.in[4], IN_COLS, 2336, 1024, 2048, WT + WT_GATE},
            {P.in[20], 1024, 0, 512, 1024, WT + WT_BRA},
            {P.in[21], 1024, 0, 512, 1024, WT + WT_BRB},
            {P.in[22], 1024, 0, 1024, 1024, WT + WT_OUT},
            {P.in[29], 1024, 0, 1024, 1024, WT + WT_PG},
            {P.in[30], 1024, 0, 256, 1024, WT + WT_PP},
            {P.in[24], 2048, 0, 1024, 2048, WT + WT_PQ},
            {P.in[10], 512, 0, 128, 512, WT + WT_G2},
            {P.in[17], 768, 0, 256, 768, WT + WT_QUP},
            {P.in[19], 1024, 0, 128, 1024, WT + WT_KVUP},
        };
#pragma unroll
        for (int j = 0; j < 12; ++j) {
            const int ni = trjob_items(jobs[j]);
            for (int it = gw; it < ni; it += NGW) transpose_item(jobs[j].W, jobs[j].ldw, jobs[j].col_off, jobs[j].K, jobs[j].WT, jobs[j].ncols, scr, it, lane);
        }
        for (size_t i = gt; i < (size_t)96 * 1024 / 8; i += GT) ((u32x4*)(WT + WT_IN + (size_t)2336 * 1024))[i] = (u32x4){0u, 0u, 0u, 0u};
        for (size_t i = gt; i < (size_t)16 * 128 * 128 / 4; i += GT) { const f32x4 v = ((const f32x4*)P.in[25])[i]; ((u32x2*)(WT + WT_SK))[i] = (u32x2){pk2(v.x, v.y), pk2(v.z, v.w)}; }
        for (int m = gw; m < T; m += NGW) rms_row_to_bf16(P.in[0] + (size_t)m * D, P.in[3], Hb + (size_t)m * D, lane);
    }
    }
    GRID_BAR();
    {
    PHASE_IDS();
    {
        const int ntn = UW / G_BN, ntile = (T / G_BM) * ntn;
        for (int tile = bid; tile < ntile; tile += G) {
            const int row0 = (tile / ntn) * G_BM, col0 = (tile % ntn) * G_BN;
            f32x4 acc[4][4]; acc_zero(acc);
            gemm_accum(acc, GemmSrc{Hb, D, WT + WT_IN, D, D}, row0, col0, lds);
            EPI_LOOP(row0, col0) { *(u32x2*)(U + (size_t)EPI_ROW(row0) * UW + EPI_COL(col0)) = (u32x2){pk2(acc[m][n][0], acc[m][n][1]), pk2(acc[m][n][2], acc[m][n][3])}; }
        }
    }
    }
    GRID_BAR();
    {
    PHASE_IDS();
    for (size_t i = gt; i < (size_t)T * 128; i += GT) { const int t = (int)(i >> 7), j = (int)(i & 127);
        LG[i] = (bf16_t)f2bf(sigmoidf_(ushift(U, t, 1792 + j, P.in[5][1792 + j]))); }
    for (int m = gw; m < T; m += NGW) mla_prep_token(P, U, CQN, CKVN, Kb, m, lane);
    }
    GRID_BAR();
    {
    PHASE_IDS();
    {
        const int nq = (T / G_BM) * 6, nkv = (T / G_BM) * 8, ng = (T / G_BM) * 4;
        for (int tile = bid; tile < nq + nkv + ng; tile += G) {
            f32x4 acc[4][4]; acc_zero(acc);
            if (tile < nq) {
                const int row0 = (tile / 6) * G_BM, col0 = (tile % 6) * G_BN;
                gemm_accum(acc, GemmSrc{CQN, 256, WT + WT_QUP, 256, 256}, row0, col0, lds);
                EPI_LOOP(row0, col0) { const int row = EPI_ROW(row0), col = EPI_COL(col0), hq = col / 96, dq = col % 96;
                    *(u32x2*)(Qb + ((size_t)hq * T + row) * 96 + dq) = (u32x2){pk2(acc[m][n][0] * QSCALE, acc[m][n][1] * QSCALE), pk2(acc[m][n][2] * QSCALE, acc[m][n][3] * QSCALE)}; }
            } else if (tile < nq + nkv) {
                const int tt = tile - nq, row0 = (tt / 8) * G_BM, hk = tt % 8, col0 = hk * G_BN;
                gemm_accum<false>(acc, GemmSrc{CKVN, 128, WT + WT_KVUP, 128, 128}, row0, col0, lds);
                const int lane_ = tid & 63, wid_ = tid >> 6, wr_ = wid_ >> 1, wc_ = wid_ & 1, fr_ = lane_ & 15, fq_ = lane_ >> 4;
#pragma unroll
                for (int m = 0; m < 4; ++m)
#pragma unroll
                    for (int n = 0; n < 4; ++n) {
                        const int rbase = row0 + wr_ * 64 + m * 16, cc = wc_ * 64 + n * 16 + fr_;
                        if (wc_ == 0) {
#pragma unroll
                            for (int j = 0; j < 4; ++j) Kb[((size_t)hk * T + rbase + 4 * fq_ + j) * 96 + cc] = (bf16_t)f2bf(acc[m][n][j]);
                        } else {
                            *(u32x2*)(VT + (size_t)(hk * 64 + cc - 64) * T + rbase + 8 * (fq_ & 1) + 4 * (fq_ >> 1)) = (u32x2){pk2(acc[m][n][0], acc[m][n][1]), pk2(acc[m][n][2], acc[m][n][3])};
                        }
                    }
            } else {
                const int tt = tile - nq - nkv, row0 = (tt / 4) * G_BM, col0 = (tt % 4) * G_BN;
                gemm_accum(acc, GemmSrc{LG, 128, WT + WT_G2, 128, 128}, row0, col0, lds);
                EPI_LOOP(row0, col0) { *(u32x2*)(Gm + (size_t)EPI_ROW(row0) * 512 + EPI_COL(col0)) = (u32x2){pk2(acc[m][n][0], acc[m][n][1]), pk2(acc[m][n][2], acc[m][n][3])}; }
            }
        }
    }
    }
    GRID_BAR();
    {
    PHASE_IDS();
    for (size_t i = gt; i < (size_t)T * 8 * 16; i += GT) {
        const int ii = (int)(i & 15), hq = (int)((i >> 4) & 7), t = (int)(i >> 7);
        bf16_t* qp = Qb + ((size_t)hq * T + t) * 96 + 64;
        const float x1 = bf2f(qp[ii]), x2 = bf2f(qp[16 + ii]);
        const float pos = (float)((const int*)P.in[2])[t];
        const float inv = exp2f(-(float)ii * (13.287712379549449f / 16.f));
        float sn, cs; sincosf(pos * inv, &sn, &cs);
        qp[ii] = (bf16_t)f2bf(x1 * cs - x2 * sn); qp[16 + ii] = (bf16_t)f2bf(x2 * cs + x1 * sn);
    }
    }
    GRID_BAR();
    {
    PHASE_IDS();
    if (bid < 16) rwkv_scan_naive(P, U, RO, BS, bid >> 3, bid & 7, lds);
    else for (int unit = bid - 16; unit < 8 * (T / 256); unit += G - 16) attn_unit(Qb, Kb, VT, YM, unit >> 6, unit & 63, lds);
    }
    GRID_BAR();
    {
    PHASE_IDS();
    for (int m = gw; m < T; m += NGW) rwkv_merge_token(P, U, RO, BS, Gm, YRW, m, lane);
    }
    GRID_BAR();
    {
    PHASE_IDS();
    {
        const int ntn = D / G_BN, ntile = (T / G_BM) * ntn;
        for (int tile = bid; tile < ntile; tile += G) {
            const int row0 = (tile / ntn) * G_BM, col0 = (tile % ntn) * G_BN;
            f32x4 acc1[4][4], acc2[4][4];
            acc_zero(acc1); acc_zero(acc2);
            gemm_accum(acc1, GemmSrc{Hb, D, WT + WT_GATE, D, D}, row0, col0, lds);
            gemm_accum(acc2, GemmSrc{YRW, 512, WT + WT_BRA, 512, 512}, row0, col0, lds);
            {
                EPI_LOOP(row0, col0) {
                    f32x4 o;
#pragma unroll
                    for (int j = 0; j < 4; ++j) o[j] = sigmoidf_(acc1[m][n][j]) * acc2[m][n][j];
                    *(u32x2*)(MG + (size_t)EPI_ROW(row0) * D + EPI_COL(col0)) = (u32x2){pk2(o[0], o[1]), pk2(o[2], o[3])};
                }
            }
            acc_zero(acc1); acc_zero(acc2);
            gemm_accum(acc1, GemmSrc{Hb, D, WT + WT_GATE + (size_t)1024 * 1024, D, D}, row0, col0, lds);
            gemm_accum(acc2, GemmSrc{YM, 512, WT + WT_BRB, 512, 512}, row0, col0, lds);
            {
                EPI_LOOP(row0, col0) {
                    bf16_t* mp = MG + (size_t)EPI_ROW(row0) * D + EPI_COL(col0);
                    const u32x2 pr = *(const u32x2*)mp;
                    f32x4 o;
                    o[0] = __builtin_bit_cast(float, pr.x << 16); o[1] = __builtin_bit_cast(float, pr.x & 0xffff0000u);
                    o[2] = __builtin_bit_cast(float, pr.y << 16); o[3] = __builtin_bit_cast(float, pr.y & 0xffff0000u);
#pragma unroll
                    for (int j = 0; j < 4; ++j) o[j] += sigmoidf_(acc1[m][n][j]) * acc2[m][n][j];
                    *(u32x2*)mp = (u32x2){pk2(o[0], o[1]), pk2(o[2], o[3])};
                }
            }
        }
    }
    }
    GRID_BAR();
    {
    PHASE_IDS();
    {
        const int ntn = D / G_BN, ntile = (T / G_BM) * ntn;
        for (int tile = bid; tile < ntile; tile += G) {
            const int row0 = (tile / ntn) * G_BM, col0 = (tile % ntn) * G_BN;
            f32x4 acc[4][4]; acc_zero(acc);
            gemm_accum(acc, GemmSrc{MG, D, WT + WT_OUT, D, D}, row0, col0, lds);
            EPI_LOOP(row0, col0) { const size_t off = (size_t)EPI_ROW(row0) * D + EPI_COL(col0);
                const f32x4 xv = *(const f32x4*)(P.in[0] + off); *(f32x4*)(XB + off) = xv + acc[m][n]; }
        }
        for (size_t i = gt; i < (size_t)T * PLE / 4; i += GT) { const f32x4 v = ((const f32x4*)P.in[1])[i]; ((u32x2*)PB)[i] = (u32x2){pk2(v.x, v.y), pk2(v.z, v.w)}; }
        for (size_t i = gt; i < (size_t)16384 * 1024 / 4; i += GT) {
            const f32x4 a = ((const f32x4*)P.in[26])[i]; ((u32x2*)EU)[i] = (u32x2){pk2(a.x, a.y), pk2(a.z, a.w)};
            const f32x4 b = ((const f32x4*)P.in[27])[i]; ((u32x2*)EV)[i] = (u32x2){pk2(b.x, b.y), pk2(b.z, b.w)}; }
    }
    }
    GRID_BAR();
    {
    PHASE_IDS();
    for (int m = gw; m < T; m += NGW) rms_row_to_bf16(XB + (size_t)m * D, P.in[23], Hb + (size_t)m * D, lane);
    }
    GRID_BAR();
    {
    PHASE_IDS();
    {
        const int ntile = (T / G_BM) * 16;
        for (int tile = bid; tile < ntile; tile += G) peer_query_tile(Hb, WT + WT_PQ, WT + WT_SK, SC, tile / 16, tile % 16, lds);
    }
    }
    GRID_BAR();
    {
    PHASE_IDS();
    for (int m = gw; m < T; m += NGW) peer_token(XB + (size_t)m * D, XB + (size_t)m * D, Hb + (size_t)m * D, SC + (size_t)m * 256, EU, EV, P.in[28], lane);
    }
    GRID_BAR();
    {
    PHASE_IDS();
    {
        const int ntile = (T / G_BM) * (D / G_BN);
        for (int tile = bid; tile < ntile; tile += G) {
            const int pm = tile / (D / G_BN), pn = tile % (D / G_BN);
            const int row0 = pm * G_BM, col0 = pn * G_BN;
            f32x4 acc1[4][4], acc2[4][4];
            acc_zero(acc1); acc_zero(acc2);
            gemm_accum(acc1, GemmSrc{PB, PLE, WT + WT_PP, PLE, PLE}, row0, col0, lds);
            gemm_accum(acc2, GemmSrc{Hb, D, WT + WT_PG, D, D}, row0, col0, lds);
            EPI_LOOP(row0, col0) {
                const size_t off = (size_t)EPI_ROW(row0) * D + EPI_COL(col0);
                const f32x4 xv = *(const f32x4*)(XB + off);
                f32x4 o;
#pragma unroll
                for (int j = 0; j < 4; ++j) o[j] = xv[j] + acc1[m][n][j] * sigmoidf_(acc2[m][n][j]);
                *(f32x4*)(XB + off) = o;
            }
        }
    }
    }
    GRID_BAR();
    {
    PHASE_IDS();
    for (int m = gw; m < T; m += NGW) rms_row_to_f32(XB + (size_t)m * D, P.in[31], P.out + (size_t)m * D, lane);
    }
}

extern "C" void kernel_launch(void* const* d_in, const int* in_sizes, int n_in, void* d_out, int out_size, void* d_ws, size_t ws_size, hipStream_t stream) {
    static int grid = 0;
    if (grid == 0) {
        if (n_in != 32 || out_size != T * D || ws_size < WS_END) { fprintf(stderr, "kernel_launch: unexpected shapes n_in %d out %d ws %zu\n", n_in, out_size, ws_size); grid = -1; return; }
        int dev = 0, cus = 0, per_cu = 0;
        if (hipGetDevice(&dev) != hipSuccess || hipDeviceGetAttribute(&cus, hipDeviceAttributeMultiprocessorCount, dev) != hipSuccess) { grid = -1; return; }
        if (hipFuncSetAttribute((const void*)mega, hipFuncAttributeMaxDynamicSharedMemorySize, LDS_BYTES) != hipSuccess) { fprintf(stderr, "kernel_launch: hipFuncSetAttribute failed\n"); grid = -1; return; }
        if (hipOccupancyMaxActiveBlocksPerMultiprocessor(&per_cu, (const void*)mega, NTHREADS, LDS_BYTES) != hipSuccess || per_cu < 1) { fprintf(stderr, "kernel_launch: occupancy query says %d blocks per CU\n", per_cu); (void)hipGetLastError(); grid = -1; return; }
        grid = cus;
    }
    if (grid < 0) return;
    (void)hipMemsetAsync((char*)d_ws + WS_CTL, 0, CTL_ZERO_BYTES, stream);
    Params p{};
    for (int i = 0; i < 32; ++i) p.in[i] = (const float*)d_in[i];
    p.out = (float*)d_out; p.ws = (unsigned char*)d_ws;
    hipLaunchKernelGGL(mega, dim3(grid), dim3(NTHREADS), LDS_BYTES, stream, p);
}
```

```cpp
#include <hip/hip_runtime.h>
#include <cstdio>
#include <cstdint>

#define DI __device__ __forceinline__
#define LAS __attribute__((address_space(3)))
#define GAS __attribute__((address_space(1)))
typedef unsigned short bf16_t;
typedef short bf16x8 __attribute__((ext_vector_type(8)));
typedef float f32x4 __attribute__((ext_vector_type(4)));
typedef float f32x2 __attribute__((ext_vector_type(2)));
typedef float f32x16 __attribute__((ext_vector_type(16)));
typedef unsigned u32x4 __attribute__((ext_vector_type(4)));
typedef unsigned u32x2 __attribute__((ext_vector_type(2)));

constexpr int T = 16384, D = 1024, PLE = 256;
constexpr int RW_W = 512, RW_COLS = 1920, MLA_COLS = 416, GATE_COLS = 2048, IN_COLS = 4384;
constexpr int NTHREADS = 512, NWAVES = 8;
constexpr float NORM_EPS = 1e-6f;

constexpr size_t MiB = 1u << 20;
constexpr size_t WS_CTL = 0;
constexpr size_t CTL_ZERO_BYTES = 64 * 1024;
constexpr size_t WS_WT = 1 * MiB;
constexpr size_t WS_CM = 25 * MiB;
constexpr size_t WS_U = 153 * MiB;
constexpr size_t WS_VS = 229 * MiB;
constexpr size_t WS_LG = 245 * MiB;
constexpr size_t WS_BS = 249 * MiB;
constexpr size_t WS_GC = 250 * MiB;
constexpr size_t WS_IR = 251 * MiB;
constexpr size_t WS_END = 252 * MiB;
constexpr int UW = 2432;
constexpr size_t WS_H = WS_CM;
constexpr size_t WS_GM = WS_CM;
constexpr size_t WS_YRW = WS_CM + 16 * MiB;
constexpr size_t WS_H2 = WS_CM + 32 * MiB;
constexpr size_t WS_XB = WS_CM + 64 * MiB;
constexpr size_t WS_RO = WS_U;
constexpr size_t WS_YM = WS_U + 32 * MiB;
constexpr size_t WS_ET = WS_U;
constexpr size_t WS_PB = WS_U + 64 * MiB;
constexpr size_t WT_IN = 0;
constexpr size_t WT_GATE = WT_IN + (size_t)2432 * 1024;
constexpr size_t WT_PQ = WT_GATE + (size_t)2048 * 1024;
constexpr size_t WT_OUT = WT_PQ + (size_t)2048 * 1024;
constexpr size_t WT_PG = WT_OUT + (size_t)1024 * 1024;
constexpr size_t WT_BRA = WT_PG + (size_t)1024 * 1024;
constexpr size_t WT_BRB = WT_BRA + (size_t)1024 * 512;
constexpr size_t WT_PP = WT_BRB + (size_t)1024 * 512;
constexpr size_t WT_QUP = WT_PP + (size_t)1024 * 256;
constexpr size_t WT_KVUP = WT_QUP + (size_t)768 * 256;
constexpr size_t WT_SK = WT_KVUP + (size_t)1024 * 128;
constexpr size_t WT_G2 = WT_SK + (size_t)16 * 128 * 128;
constexpr size_t WT_W2T = WT_G2 + (size_t)512 * 128;
constexpr size_t WT_A2T = WT_W2T + 65536;
constexpr size_t WT_END = WT_A2T + 65536;
static_assert(WT_END * 2 <= 24 * MiB, "weights fit");

DI unsigned f2bf(float f) { unsigned u = __builtin_bit_cast(unsigned, f); return (u + 0x7fffu + ((u >> 16) & 1u)) >> 16; }
DI unsigned pk2(float lo, float hi) { return f2bf(lo) | (f2bf(hi) << 16); }
DI float bf2f(unsigned short b) { return __builtin_bit_cast(float, (unsigned)b << 16); }
DI float wave_sum(float v) {
#pragma unroll
    for (int o = 1; o < 64; o <<= 1) v += __shfl_xor(v, o);
    return v;
}
DI int tid_fresh() { int t = threadIdx.x; asm volatile("" : "+v"(t)); return t; }
DI float sigmoidf_(float x) { return 1.f / (1.f + __expf(-x)); }

#define XB_TMO      128
#define XB_XCNT(j)  (256  + 64 * (j))
#define XB_XSUB(j)  (1280 + 64 * (j))
#define XB_XGEN(j)  (2304 + 64 * (j))
#define XB_TOP      3328
#define XB_TOPGEN   3392
#define XCD_BAR_WORDS 3456
#define XB_SPIN_CAP (1u << 18)
DI unsigned xb_ld(unsigned* p)              { return __hip_atomic_load(p, __ATOMIC_RELAXED, __HIP_MEMORY_SCOPE_AGENT); }
DI unsigned xb_add(unsigned* p, unsigned v) { return __hip_atomic_fetch_add(p, v, __ATOMIC_RELAXED, __HIP_MEMORY_SCOPE_AGENT); }
DI unsigned xb_xcc_id() { return (unsigned)__builtin_amdgcn_s_getreg((3 << 11) | 20) & 0xFu; }
#define XB_SPIN(cond, bar) do { unsigned _sp = 0; while (cond) { __builtin_amdgcn_s_sleep(1); \
    if ((++_sp & 255u) == 0u) { if (xb_ld(&(bar)[XB_TMO])) break; if (_sp > XB_SPIN_CAP) { atomicAdd(&(bar)[XB_TMO], 1u); break; } } } } while (0)
struct XcdBarrier { unsigned* bar; unsigned x; volatile LAS unsigned* st; };
DI XcdBarrier xcd_barrier_post(unsigned* bar, volatile LAS unsigned* st) {
    XcdBarrier b; b.bar = bar; b.x = xb_xcc_id(); b.st = st;
    if (threadIdx.x == 0) (void)xb_add(&bar[XB_XCNT(b.x)], 1u);
    return b;
}
DI void xcd_barrier_complete(unsigned* bar, unsigned x, unsigned& nloc, unsigned& nx) {
    const unsigned G = gridDim.x * gridDim.y * gridDim.z;
    unsigned sum, cnt, mine, sp = 0u;
    for (;;) {
        sum = 0u; cnt = 0u; mine = 0u;
#pragma unroll
        for (unsigned j = 0; j < 16; ++j) { const unsigned c = xb_ld(&bar[XB_XCNT(j)]); sum += c; cnt += (c > 0u) ? 1u : 0u; mine = (j == x) ? c : mine; }
        if (sum == G) break;
        __builtin_amdgcn_s_sleep(1);
        if ((++sp & 255u) == 0u) { if (xb_ld(&bar[XB_TMO])) break; if (sp > XB_SPIN_CAP) { atomicAdd(&bar[XB_TMO], 1u); break; } }
    }
    nloc = mine > 0u ? mine : 1u; nx = cnt > 0u ? cnt : 1u;
}
DI void xcd_barrier(const XcdBarrier& b) {
    asm volatile("s_waitcnt vmcnt(0)" ::: "memory");
    __syncthreads();
    if (threadIdx.x == 0) {
        unsigned* bar = b.bar;
        __builtin_amdgcn_s_waitcnt(0);
        unsigned nloc = b.st[0], nx = b.st[1];
        if (nloc == 0u) { xcd_barrier_complete(bar, b.x, nloc, nx); b.st[0] = nloc; b.st[1] = nx; }
        const unsigned old = xb_add(&bar[XB_XSUB(b.x)], 1u);
        const unsigned gen = old / nloc;
        if (old + 1u == (gen + 1u) * nloc) {
            __builtin_amdgcn_fence(__ATOMIC_RELEASE, "agent");
            asm volatile("s_waitcnt vmcnt(0)" ::: "memory");
            const unsigned og = xb_add(&bar[XB_TOP], 1u);
            const unsigned tg = og / nx;
            if (og + 1u == (tg + 1u) * nx) xb_add(&bar[XB_TOPGEN], 1u);
            else XB_SPIN(xb_ld(&bar[XB_TOPGEN]) == tg, bar);
            __builtin_amdgcn_fence(__ATOMIC_ACQUIRE, "agent");
            xb_add(&bar[XB_XGEN(b.x)], 1u);
            asm volatile("s_waitcnt vmcnt(0)" ::: "memory");
        } else {
            XB_SPIN(xb_ld(&bar[XB_XGEN(b.x)]) == gen, bar);
            __builtin_amdgcn_fence(__ATOMIC_ACQUIRE, "agent");
            asm volatile("s_waitcnt vmcnt(0)" ::: "memory");
        }
    }
    __syncthreads();
}

struct Params { const float* in[32]; float* out; unsigned char* ws; };

constexpr int LDS_MISC = 157952;
constexpr int LDS_BYTES = 158208;

DI void transpose_item(const float* W, int ldw, int col_off, int K, bf16_t* WT, int ncols, LAS float* scr, int item, int lane, const float* ks = nullptr) {
    const int nblk = ncols / 32, kb = item / nblk, nb = item % nblk, k0 = 64 * kb, n0 = 32 * nb;
#pragma unroll 8
    for (int i = 0; i < 32; ++i) { const int kk = 2 * i + (lane >> 5); scr[kk * 33 + (lane & 31)] = W[(size_t)(k0 + kk) * ldw + col_off + n0 + (lane & 31)] * (ks ? ks[k0 + kk] : 1.f); }
    asm volatile("s_waitcnt lgkmcnt(0)" ::: "memory");
    const int c = lane & 7;
#pragma unroll
    for (int j = 0; j < 4; ++j) { const int n = (lane >> 3) + 8 * j; const LAS float* s = scr + (8 * c) * 33 + n;
        u32x4 o; o.x = pk2(s[0 * 33], s[1 * 33]); o.y = pk2(s[2 * 33], s[3 * 33]); o.z = pk2(s[4 * 33], s[5 * 33]); o.w = pk2(s[6 * 33], s[7 * 33]);
        *(u32x4*)(WT + (size_t)(n0 + n) * K + k0 + 8 * c) = o; }
    asm volatile("s_waitcnt lgkmcnt(0)" ::: "memory");
}
struct TrJob { const float* W; int ldw, col_off, K, ncols; bf16_t* WT; const float* ks; };
DI int trjob_items(const TrJob& j) { return (j.K / 64) * (j.ncols / 32); }

DI void rms_row_to_bf16(const float* xrow, const float* g, bf16_t* orow, int lane) {
    const f32x4* xr = (const f32x4*)xrow + lane; const f32x4* gr = (const f32x4*)g + lane;
    f32x4 v[4]; float s = 0.f;
#pragma unroll
    for (int j = 0; j < 4; ++j) { v[j] = xr[64 * j]; s += (v[j].x * v[j].x + v[j].y * v[j].y) + (v[j].z * v[j].z + v[j].w * v[j].w); }
    const float r = 1.f / sqrtf(wave_sum(s) * (1.f / D) + NORM_EPS);
    unsigned long long* o8 = (unsigned long long*)orow + lane;
#pragma unroll
    for (int j = 0; j < 4; ++j) { const f32x4 gg = gr[64 * j];
        o8[64 * j] = (unsigned long long)pk2(v[j].x * r * gg.x, v[j].y * r * gg.y) | ((unsigned long long)pk2(v[j].z * r * gg.z, v[j].w * r * gg.w) << 32); }
}
DI void rms_row_to_f32(const float* xrow, const float* g, float* orow, int lane) {
    const f32x4* xr = (const f32x4*)xrow + lane; const f32x4* gr = (const f32x4*)g + lane;
    f32x4 v[4]; float s = 0.f;
#pragma unroll
    for (int j = 0; j < 4; ++j) { v[j] = xr[64 * j]; s += (v[j].x * v[j].x + v[j].y * v[j].y) + (v[j].z * v[j].z + v[j].w * v[j].w); }
    const float r = 1.f / sqrtf(wave_sum(s) * (1.f / D) + NORM_EPS);
    f32x4* o = (f32x4*)orow + lane;
#pragma unroll
    for (int j = 0; j < 4; ++j) { const f32x4 gg = gr[64 * j]; o[64 * j] = (f32x4){v[j].x * r * gg.x, v[j].y * r * gg.y, v[j].z * r * gg.z, v[j].w * r * gg.w}; }
}

struct GemmSrc { const bf16_t* A; int lda; const bf16_t* Bt; int ldb; int K; };
constexpr int G_BM = 256, G_BN = 128, G_BK = 64, G_STAGE = 49152;
template <bool SWAP = true>
DI void gemm_accum(f32x4 (&acc)[4][4], const GemmSrc s, int row0, int col0, LAS unsigned char* lds) {
    const int tid = tid_fresh(), lane = tid & 63, wid = tid >> 6, wr = wid >> 1, wc = wid & 1, fr = lane & 15, fq = lane >> 4;
    const int nt = s.K / G_BK;
    const int sr = tid >> 3, sc = tid & 7;
    const bf16_t* gA = s.A + (size_t)(row0 + sr) * s.lda + sc * 8;
    const bf16_t* gB = s.Bt + (size_t)(col0 + sr) * s.ldb + sc * 8;
    const int swoff = sr * 128 + ((sc ^ (sr & 7)) << 4);
    u32x4 ra[4], rb[2];
#pragma unroll
    for (int i = 0; i < 4; ++i) ra[i] = *(const u32x4*)(gA + (size_t)(64 * i) * s.lda);
#pragma unroll
    for (int i = 0; i < 2; ++i) rb[i] = *(const u32x4*)(gB + (size_t)(64 * i) * s.ldb);
#pragma unroll
    for (int i = 0; i < 4; ++i) *(LAS u32x4*)(lds + i * 8192 + swoff) = ra[i];
#pragma unroll
    for (int i = 0; i < 2; ++i) *(LAS u32x4*)(lds + 32768 + i * 8192 + swoff) = rb[i];
    __syncthreads();
    const int aoff = (wr * 64 + fr) * 128, boff = 32768 + (wc * 64 + fr) * 128;
    for (int t = 0; t < nt; ++t) {
        LAS unsigned char* cur = lds + (t & 1) * G_STAGE;
        LAS unsigned char* nxt = lds + ((t + 1) & 1) * G_STAGE;
        const bool more = (t + 1 < nt);
        if (more) {
#pragma unroll
            for (int i = 0; i < 4; ++i) ra[i] = *(const u32x4*)(gA + (size_t)(64 * i) * s.lda + (t + 1) * G_BK);
#pragma unroll
            for (int i = 0; i < 2; ++i) rb[i] = *(const u32x4*)(gB + (size_t)(64 * i) * s.ldb + (t + 1) * G_BK);
        }
#pragma unroll
        for (int kk = 0; kk < 2; ++kk) {
            const int ch = ((kk * 4 + fq) ^ (fr & 7)) << 4;
            bf16x8 a[4], b[4];
#pragma unroll
            for (int m = 0; m < 4; ++m) a[m] = *(const LAS bf16x8*)(cur + aoff + m * 2048 + ch);
#pragma unroll
            for (int n = 0; n < 4; ++n) b[n] = *(const LAS bf16x8*)(cur + boff + n * 2048 + ch);
#pragma unroll
            for (int m = 0; m < 4; ++m)
#pragma unroll
                for (int n = 0; n < 4; ++n) acc[m][n] = SWAP ? __builtin_amdgcn_mfma_f32_16x16x32_bf16(b[n], a[m], acc[m][n], 0, 0, 0)
                                                        : __builtin_amdgcn_mfma_f32_16x16x32_bf16(a[m], b[n], acc[m][n], 0, 0, 0);
        }
        if (more) {
#pragma unroll
            for (int i = 0; i < 4; ++i) *(LAS u32x4*)(nxt + i * 8192 + swoff) = ra[i];
#pragma unroll
            for (int i = 0; i < 2; ++i) *(LAS u32x4*)(nxt + 32768 + i * 8192 + swoff) = rb[i];
        }
        __syncthreads();
    }
}
DI void acc_zero(f32x4 (&acc)[4][4]) {
#pragma unroll
    for (int m = 0; m < 4; ++m)
#pragma unroll
        for (int n = 0; n < 4; ++n) acc[m][n] = (f32x4){0.f, 0.f, 0.f, 0.f};
}
#define EPI_LOOP(row0, col0) \
    const int _tid = tid_fresh(); const int _lane = _tid & 63, _wid = _tid >> 6, _wr = _wid >> 1, _wc = _wid & 1, _fr = _lane & 15, _fq = _lane >> 4; \
    _Pragma("unroll") for (int m = 0; m < 4; ++m) _Pragma("unroll") for (int n = 0; n < 4; ++n)
#define EPI_ROW(row0) ((row0) + _wr * 64 + m * 16 + _fr)
#define EPI_COL(col0) ((col0) + _wc * 64 + n * 16 + 4 * _fq)


constexpr int PEER_H = 8, PEER_K = 16;
struct ScEnt { float v; int i; };
DI float gelu_erf(float x) { return 0.5f * x * (1.f + erff(x * 0.70710678118654752f)); }

DI void peer_query_tile(const bf16_t* Hb, const bf16_t* WTpq, const bf16_t* SK, ScEnt* SC, int pm, int pn, LAS unsigned char* lds) {
    const int tid = tid_fresh(), lane = tid & 63, wid = tid >> 6, wr = wid >> 1, wc = wid & 1, fr = lane & 15, fq = lane >> 4;
    const int row0 = pm * G_BM, col0 = pn * G_BN;
    f32x4 acc[4][4]; acc_zero(acc);
    gemm_accum(acc, GemmSrc{Hb, D, WTpq, D, D}, row0, col0, lds);
#pragma unroll
    for (int m = 0; m < 4; ++m)
#pragma unroll
        for (int n = 0; n < 4; ++n) {
            const int r = wr * 64 + m * 16 + fr, c = wc * 64 + n * 16 + 4 * fq;
            const int kt = c >> 6, ch = (c & 63) >> 3;
            *(LAS u32x2*)(lds + kt * 32768 + r * 128 + ((ch ^ (r & 7)) << 4) + (c & 7) * 2) = (u32x2){pk2(acc[m][n][0], acc[m][n][1]), pk2(acc[m][n][2], acc[m][n][3])};
        }
    {
        const bf16_t* sk = SK + (size_t)pn * 128 * 128;
#pragma unroll
        for (int i = 0; i < 4; ++i) { const int id = tid + i * 512, r = id >> 4, c16 = id & 15, kt = c16 >> 3, ch = c16 & 7;
            *(LAS u32x4*)(lds + 65536 + kt * 16384 + r * 128 + ((ch ^ (r & 7)) << 4)) = *(const u32x4*)(sk + (size_t)r * 128 + c16 * 8); }
    }
    __syncthreads();
    acc_zero(acc);
#pragma unroll
    for (int kt = 0; kt < 2; ++kt)
#pragma unroll
        for (int kk = 0; kk < 2; ++kk) {
            const int ch = ((kk * 4 + fq) ^ (fr & 7)) << 4;
            bf16x8 a[4], b[4];
#pragma unroll
            for (int m = 0; m < 4; ++m) a[m] = *(const LAS bf16x8*)(lds + kt * 32768 + (wr * 64 + m * 16 + fr) * 128 + ch);
#pragma unroll
            for (int n = 0; n < 4; ++n) b[n] = *(const LAS bf16x8*)(lds + 65536 + kt * 16384 + (wc * 64 + n * 16 + fr) * 128 + ch);
#pragma unroll
            for (int m = 0; m < 4; ++m)
#pragma unroll
                for (int n = 0; n < 4; ++n) acc[m][n] = __builtin_amdgcn_mfma_f32_16x16x32_bf16(b[n], a[m], acc[m][n], 0, 0, 0);
        }
    __syncthreads();
    LAS float* SS = (LAS float*)lds;
#pragma unroll
    for (int m = 0; m < 4; ++m)
#pragma unroll
        for (int n = 0; n < 4; ++n) {
            const int r = wr * 64 + m * 16 + fr, c = wc * 64 + n * 16 + 4 * fq;
#pragma unroll
            for (int j = 0; j < 4; ++j) SS[r * 129 + c + j] = acc[m][n][j];
        }
    __syncthreads();
    const int trow = tid & 255, half = tid >> 8;
    float v[64];
#pragma unroll
    for (int i = 0; i < 64; ++i) v[i] = SS[trow * 129 + half * 64 + i];
    __syncthreads();
    LAS float* LV = (LAS float*)lds;
    LAS int* LI = (LAS int*)(lds + 32768);
    for (int r = 0; r < 16; ++r) {
        float best = v[0]; int bi = 0;
#pragma unroll
        for (int i = 1; i < 64; ++i) { const bool g = v[i] > best; best = g ? v[i] : best; bi = g ? i : bi; }
        LV[(trow * 2 + half) * 16 + r] = best; LI[(trow * 2 + half) * 16 + r] = bi + half * 64;
#pragma unroll
        for (int i = 0; i < 64; ++i) v[i] = (i == bi) ? -INFINITY : v[i];
    }
    __syncthreads();
    if (half == 0) {
        int i = 0, j = 0;
        ScEnt* dst = SC + ((size_t)(row0 + trow) * 16 + pn) * 16;
        for (int r = 0; r < 16; ++r) {
            const float av = LV[(trow * 2) * 16 + i], bv = LV[(trow * 2 + 1) * 16 + j];
            const int ai = LI[(trow * 2) * 16 + i], bi = LI[(trow * 2 + 1) * 16 + j];
            const bool ta = av >= bv;
            ScEnt e; e.v = ta ? av : bv; e.i = ta ? ai : bi;
            dst[r] = e; i += ta ? 1 : 0; j += ta ? 0 : 1;
        }
    }
    __syncthreads();
}

DI void peer_token(const float* x1row, float* x2row, bf16_t* hrow, const ScEnt* SCt, const bf16_t* EU, const bf16_t* EV, const float* g_ple, int lane) {
    float h[16];
    { const u32x4 a = *(const u32x4*)(hrow + lane * 16), b = *(const u32x4*)(hrow + lane * 16 + 8);
#pragma unroll
      for (int j = 0; j < 4; ++j) { h[2 * j] = __builtin_bit_cast(float, a[j] << 16); h[2 * j + 1] = __builtin_bit_cast(float, a[j] & 0xffff0000u);
                                    h[8 + 2 * j] = __builtin_bit_cast(float, b[j] << 16); h[8 + 2 * j + 1] = __builtin_bit_cast(float, b[j] & 0xffff0000u); } }
    float o[16];
#pragma unroll
    for (int j = 0; j < 16; ++j) o[j] = 0.f;
    for (int hd = 0; hd < PEER_H; ++hd) {
        const ScEnt* L0 = SCt + (hd * 2) * 16; const ScEnt* L1 = SCt + (hd * 2 + 1) * 16;
        const float s0 = L0[lane >> 2].v;
        float c0 = s0 + L1[(lane & 3) * 4 + 0].v, c1 = s0 + L1[(lane & 3) * 4 + 1].v, c2 = s0 + L1[(lane & 3) * 4 + 2].v, c3 = s0 + L1[(lane & 3) * 4 + 3].v;
        float myv = -INFINITY; int myp = 0;
        for (int r = 0; r < 16; ++r) {
            float bv = c0; int bp = lane * 4;
            if (c1 > bv) { bv = c1; bp = lane * 4 + 1; }
            if (c2 > bv) { bv = c2; bp = lane * 4 + 2; }
            if (c3 > bv) { bv = c3; bp = lane * 4 + 3; }
#pragma unroll
            for (int off = 32; off >= 1; off >>= 1) { const float ov = __shfl_xor(bv, off); const int op = __shfl_xor(bp, off);
                const bool t = (ov > bv) || (ov == bv && op < bp); bv = t ? ov : bv; bp = t ? op : bp; }
            if (lane == r) { myv = bv; myp = bp; }
            if ((bp >> 2) == lane) { const int q = bp & 3; c0 = (q == 0) ? -INFINITY : c0; c1 = (q == 1) ? -INFINITY : c1; c2 = (q == 2) ? -INFINITY : c2; c3 = (q == 3) ? -INFINITY : c3; }
        }
        const float mx = __shfl(myv, 0);
        const float e = (lane < 16) ? __expf(myv - mx) : 0.f;
        const float gate = e / wave_sum(e);
        int eidx = 0;
        if (lane < 16) eidx = L0[myp >> 4].i * 128 + L1[myp & 15].i;
        for (int ex = 0; ex < 16; ++ex) {
            const int id = __shfl(eidx, ex); const float gt = __shfl(gate, ex);
            const bf16_t* ur = EU + (size_t)id * D + lane * 16; const bf16_t* vr = EV + (size_t)id * D + lane * 16;
            const u32x4 ua = *(const u32x4*)ur, ub = *(const u32x4*)(ur + 8);
            const u32x4 va = *(const u32x4*)vr, vb = *(const u32x4*)(vr + 8);
            float d = 0.f;
#pragma unroll
            for (int j = 0; j < 4; ++j) { d += h[2 * j] * __builtin_bit_cast(float, ua[j] << 16) + h[2 * j + 1] * __builtin_bit_cast(float, ua[j] & 0xffff0000u);
                                          d += h[8 + 2 * j] * __builtin_bit_cast(float, ub[j] << 16) + h[8 + 2 * j + 1] * __builtin_bit_cast(float, ub[j] & 0xffff0000u); }
            d = wave_sum(d);
            const float cf = gt * gelu_erf(d);
#pragma unroll
            for (int j = 0; j < 4; ++j) { o[2 * j] += cf * __builtin_bit_cast(float, va[j] << 16); o[2 * j + 1] += cf * __builtin_bit_cast(float, va[j] & 0xffff0000u);
                                          o[8 + 2 * j] += cf * __builtin_bit_cast(float, vb[j] << 16); o[8 + 2 * j + 1] += cf * __builtin_bit_cast(float, vb[j] & 0xffff0000u); }
        }
    }
    float ss = 0.f;
#pragma unroll
    for (int j = 0; j < 4; ++j) { const f32x4 xv = *(const f32x4*)(x1row + lane * 16 + 4 * j);
        o[4 * j] += xv.x; o[4 * j + 1] += xv.y; o[4 * j + 2] += xv.z; o[4 * j + 3] += xv.w;
        *(f32x4*)(x2row + lane * 16 + 4 * j) = (f32x4){o[4 * j], o[4 * j + 1], o[4 * j + 2], o[4 * j + 3]};
        ss += o[4 * j] * o[4 * j] + o[4 * j + 1] * o[4 * j + 1] + o[4 * j + 2] * o[4 * j + 2] + o[4 * j + 3] * o[4 * j + 3]; }
    const float rr = 1.f / sqrtf(wave_sum(ss) * (1.f / D) + NORM_EPS);
    u32x4 w0, w1;
#pragma unroll
    for (int j = 0; j < 4; ++j) { const f32x4 g0 = *(const f32x4*)(g_ple + lane * 16 + 4 * j);
        const unsigned lo = pk2(o[4 * j] * rr * g0.x, o[4 * j + 1] * rr * g0.y), hi = pk2(o[4 * j + 2] * rr * g0.z, o[4 * j + 3] * rr * g0.w);
        if (j < 2) { w0[2 * j] = lo; w0[2 * j + 1] = hi; } else { w1[2 * (j - 2)] = lo; w1[2 * (j - 2) + 1] = hi; } }
    *(u32x4*)(hrow + lane * 16) = w0; *(u32x4*)(hrow + lane * 16 + 8) = w1;
}


DI float ushift(const bf16_t* U, int t, int col, float mu) {
    const float c = bf2f(U[(size_t)t * UW + col]);
    const float pv = t > 0 ? bf2f(U[(size_t)(t - 1) * UW + col]) : 0.f;
    const float nx = t < T - 1 ? bf2f(U[(size_t)(t + 1) * UW + col]) : 0.f;
    return c + mu * (0.5f * (pv + nx) - c);
}
DI void rwkv_scan_naive(const Params& P, const bf16_t* U, bf16_t* RO, float* BS, int d, int h, LAS unsigned char* lds) {
    const int tid = tid_fresh();
    LAS float* W2S = (LAS float*)lds;
    LAS float* A2S = W2S + 4096;
    LAS float* INB = A2S + 4096;
    LAS float* STP = INB + 5 * 2048;
    const float* mu = P.in[5];
    const float* w2 = P.in[7] + (size_t)d * 64 * 512;
    const float* a2 = P.in[9] + (size_t)d * 64 * 512;
    for (int i = tid; i < 4096; i += NTHREADS) { const int l = i >> 6, c = i & 63; W2S[i] = w2[l * 512 + h * 64 + c]; A2S[i] = a2[l * 512 + h * 64 + c]; }
    const int i2 = tid >> 4, c2 = (tid & 15) * 4;
    float w0c[4], a0c[4], kkc[4], kac[4], rkc[4];
#pragma unroll
    for (int j = 0; j < 4; ++j) { const int hc = h * 64 + c2 + j; w0c[j] = P.in[6][d * 512 + hc]; a0c[j] = P.in[8][d * 512 + hc]; kkc[j] = P.in[11][hc]; kac[j] = P.in[12][hc]; rkc[j] = P.in[13][hc]; }
    const int v3 = tid >> 3, q3 = tid & 7;
    float S[8];
#pragma unroll
    for (int j = 0; j < 8; ++j) S[j] = 0.f;
    __syncthreads();
    for (int ch = 0; ch < T / 32; ++ch) {
#pragma unroll 2
        for (int e = tid; e < 5 * 2048; e += NTHREADS) {
            const int grp = e >> 11, i = (e >> 6) & 31, c = e & 63;
            const int sidx = ch * 32 + i, t = d ? (T - 1 - sidx) : sidx;
            const int col = (grp < 3 ? grp * 512 + h * 64 : (grp == 3 ? 1536 : 1664) + d * 64) + c;
            float v = ushift(U, t, col, mu[col]);
            if (grp == 3) v = tanhf(v);
            INB[e] = v;
        }
        __syncthreads();
        {
            float wl[4], al[4];
#pragma unroll
            for (int j = 0; j < 4; ++j) { wl[j] = w0c[j]; al[j] = a0c[j]; }
#pragma unroll 4
            for (int l = 0; l < 64; ++l) {
                const float tw = INB[3 * 2048 + i2 * 64 + l], ta = INB[4 * 2048 + i2 * 64 + l];
                const f32x4 wv = *(const LAS f32x4*)(W2S + l * 64 + c2), av = *(const LAS f32x4*)(A2S + l * 64 + c2);
#pragma unroll
                for (int j = 0; j < 4; ++j) { wl[j] += tw * wv[j]; al[j] += ta * av[j]; }
            }
            float kk[4], ss = 0.f, bsum = 0.f, kd[4], alr[4], dec[4], rr[4];
#pragma unroll
            for (int j = 0; j < 4; ++j) {
                const float kv = INB[1 * 2048 + i2 * 64 + c2 + j]; rr[j] = INB[0 * 2048 + i2 * 64 + c2 + j];
                kk[j] = kv * kkc[j]; ss += kk[j] * kk[j];
                alr[j] = 1.f / (1.f + expf(-al[j]));
                const float wlog = -log1pf(expf(-wl[j])) - 0.5f;
                dec[j] = expf(-expf(wlog));
                kd[j] = kv * (1.f + (alr[j] - 1.f) * kac[j]);
                bsum += rr[j] * kd[j] * rkc[j];
            }
#pragma unroll
            for (int o = 1; o < 16; o <<= 1) { ss += __shfl_xor(ss, o); bsum += __shfl_xor(bsum, o); }
            const float inv = 1.f / fmaxf(sqrtf(ss), 1e-12f);
            const int sidx = ch * 32 + i2, t = d ? (T - 1 - sidx) : sidx;
            if ((tid & 15) == 0) BS[((size_t)d * T + t) * 8 + h] = bsum;
#pragma unroll
            for (int j = 0; j < 4; ++j) { const float k1 = kk[j] * inv;
                STP[(i2 * 5 + 0) * 64 + c2 + j] = -k1; STP[(i2 * 5 + 1) * 64 + c2 + j] = k1 * alr[j];
                STP[(i2 * 5 + 2) * 64 + c2 + j] = kd[j]; STP[(i2 * 5 + 3) * 64 + c2 + j] = dec[j]; STP[(i2 * 5 + 4) * 64 + c2 + j] = rr[j]; }
        }
        __syncthreads();
#pragma unroll 2
        for (int i = 0; i < 32; ++i) {
            const LAS float* sp = STP + i * 320 + q3 * 8;
            float av[8], bv[8], kv[8], wv[8], rv[8];
#pragma unroll
            for (int j = 0; j < 8; j += 4) {
                const f32x4 a4 = *(const LAS f32x4*)(sp + j), b4 = *(const LAS f32x4*)(sp + 64 + j), k4 = *(const LAS f32x4*)(sp + 128 + j), w4 = *(const LAS f32x4*)(sp + 192 + j), r4 = *(const LAS f32x4*)(sp + 256 + j);
#pragma unroll
                for (int u = 0; u < 4; ++u) { av[j + u] = a4[u]; bv[j + u] = b4[u]; kv[j + u] = k4[u]; wv[j + u] = w4[u]; rv[j + u] = r4[u]; }
            }
            const float vv = INB[2 * 2048 + i * 64 + v3];
            float sa = 0.f;
#pragma unroll
            for (int j = 0; j < 8; ++j) sa += S[j] * av[j];
            sa += __shfl_xor(sa, 1); sa += __shfl_xor(sa, 2); sa += __shfl_xor(sa, 4);
            float ov = 0.f;
#pragma unroll
            for (int j = 0; j < 8; ++j) { S[j] = S[j] * wv[j] + sa * bv[j] + vv * kv[j]; ov += S[j] * rv[j]; }
            ov += __shfl_xor(ov, 1); ov += __shfl_xor(ov, 2); ov += __shfl_xor(ov, 4);
            if (q3 == 0) { const int sidx = ch * 32 + i, t = d ? (T - 1 - sidx) : sidx; RO[((size_t)d * T + t) * 512 + h * 64 + v3] = (bf16_t)f2bf(ov); }
        }
        __syncthreads();
    }
}
DI void rwkv_merge_token(const Params& P, const bf16_t* VS, const bf16_t* RO, const float* BS, const bf16_t* Gm, bf16_t* YRW, int t, int lane) {
    const int c0 = lane * 8, h = lane >> 3;
    const u32x4 o0 = *(const u32x4*)(RO + (size_t)t * 512 + c0), o1 = *(const u32x4*)(RO + ((size_t)T + t) * 512 + c0);
    float o[8]; float s = 0.f;
#pragma unroll
    for (int j = 0; j < 4; ++j) { o[2 * j] = __builtin_bit_cast(float, o0[j] << 16) + __builtin_bit_cast(float, o1[j] << 16);
        o[2 * j + 1] = __builtin_bit_cast(float, o0[j] & 0xffff0000u) + __builtin_bit_cast(float, o1[j] & 0xffff0000u); s += o[2 * j] + o[2 * j + 1]; }
    s += __shfl_xor(s, 1); s += __shfl_xor(s, 2); s += __shfl_xor(s, 4);
    const float mean = s * (1.f / 64.f); float q = 0.f;
#pragma unroll
    for (int j = 0; j < 8; ++j) { o[j] -= mean; q += o[j] * o[j]; }
    q += __shfl_xor(q, 1); q += __shfl_xor(q, 2); q += __shfl_xor(q, 4);
    const float rstd = 1.f / sqrtf(q * (1.f / 64.f) + 64e-5f);
    const float bonus = BS[(size_t)t * 8 + h] + BS[((size_t)T + t) * 8 + h];
    const u32x4 g4 = *(const u32x4*)(Gm + (size_t)t * 512 + c0);
    const u32x4 v4 = *(const u32x4*)(VS + (size_t)t * 512 + c0);
    u32x4 w;
#pragma unroll
    for (int j = 0; j < 4; ++j) {
        float y[2];
#pragma unroll
        for (int u = 0; u < 2; ++u) { const int c = c0 + 2 * j + u;
            const float vs = u ? __builtin_bit_cast(float, v4[j] & 0xffff0000u) : __builtin_bit_cast(float, v4[j] << 16);
            const float gg = u ? __builtin_bit_cast(float, g4[j] & 0xffff0000u) : __builtin_bit_cast(float, g4[j] << 16);
            y[u] = (o[2 * j + u] * rstd * P.in[14][c] + P.in[15][c] + bonus * vs) * gg; }
        w[j] = pk2(y[0], y[1]);
    }
    *(u32x4*)(YRW + (size_t)t * 512 + c0) = w;
}


constexpr int PA_RF = 0, PA_KF = 16384, PA_VF = 32768, PA_WL = 49152, PA_AL = 65536, PA_LW = 81920, PA_LA = 90112, PA_AR = 98304, PA_BK = 114688,
              PA_YG = 131072, PA_VT = 147456, PA_SEG = 155648, PA_GCL = 157696;
constexpr int PA_N = 0, PA_NT = 8192, PA_QRB = 16384, PA_QRK = 24576, PA_T0 = 32768, PA_T1 = 40960, PA_A0 = 49152, PA_AT0 = 57344, PA_A1 = 65536, PA_AT1 = 73728,
              PA_BT = 81920, PA_KT = 90112, PA_GT = 114688, PA_OK = 32768, PA_AT = PA_YG, PA_PAKT = PA_YG + 8192;
constexpr int CM_ITEM = 32768;
typedef __bf16 bf16x2_t __attribute__((ext_vector_type(2)));
DI unsigned cvtpk(float lo, float hi) { f32x2 v = {lo, hi}; bf16x2_t b = __builtin_convertvector(v, bf16x2_t); return __builtin_bit_cast(unsigned, b); }
DI int lofs(int row, int col) { return row * 128 + ((((col >> 3) ^ (row & 7))) << 4) + (col & 7) * 2; }
DI bf16x8 lfrag(const LAS unsigned char* M, int row, int kk, int fq) { return *(const LAS bf16x8*)(M + row * 128 + (((kk * 4 + fq) ^ (row & 7)) << 4)); }
template <int NT, bool SWAP>
DI void mm16(f32x4 (&acc)[NT], const LAS unsigned char* X, int xrow0, const LAS unsigned char* Y, int yrow0, int fr, int fq) {
#pragma unroll
    for (int kk = 0; kk < 2; ++kk) {
        const bf16x8 xf = lfrag(X, xrow0 + fr, kk, fq);
#pragma unroll
        for (int n = 0; n < NT; ++n) {
            const bf16x8 yf = lfrag(Y, yrow0 + n * 16 + fr, kk, fq);
            acc[n] = SWAP ? __builtin_amdgcn_mfma_f32_16x16x32_bf16(yf, xf, acc[n], 0, 0, 0) : __builtin_amdgcn_mfma_f32_16x16x32_bf16(xf, yf, acc[n], 0, 0, 0);
        }
    }
}
DI void st4(LAS unsigned char* M, int row, int col, f32x4 v) { *(LAS u32x2*)(M + lofs(row, col)) = (u32x2){cvtpk(v[0], v[1]), cvtpk(v[2], v[3])}; }
DI f32x4 ld4(const LAS unsigned char* M, int row, int col) { const u32x2 p = *(const LAS u32x2*)(M + lofs(row, col));
    return (f32x4){__builtin_bit_cast(float, p.x << 16), __builtin_bit_cast(float, p.x & 0xffff0000u), __builtin_bit_cast(float, p.y << 16), __builtin_bit_cast(float, p.y & 0xffff0000u)}; }
DI void st1(LAS unsigned char* M, int row, int col, float v) { *(LAS bf16_t*)(M + lofs(row, col)) = (bf16_t)(cvtpk(v, 0.f) & 0xffffu); }

DI void rwkv_passA(const Params& P, const bf16_t* U, const bf16_t* W2T, const bf16_t* A2T, unsigned char* CM, float* GC, float* BS, bf16_t* VS, int item, LAS unsigned char* lds) {
    const int tid = tid_fresh(), lane = tid & 63, wid = tid >> 6, fr = lane & 15, fq = lane >> 4;
    const int c = item & 255, h = (item >> 8) & 7, d = item >> 11;
    {
        const int i = tid >> 3, c8 = tid & 7;
        const int sidx = c * 64 + i, t = d ? (T - 1 - sidx) : sidx;
#pragma unroll
        for (int q = 0; q < 5; ++q) {
            const int col = (q < 3 ? q * 512 + h * 64 : (q == 3 ? 1536 : 1664) + d * 64) + c8 * 8;
            const bf16_t* up = U + (size_t)t * UW + col;
            const u32x4 cu = *(const u32x4*)up;
            u32x4 pu = (u32x4){0u, 0u, 0u, 0u}, nu = (u32x4){0u, 0u, 0u, 0u};
            if (t > 0) pu = *(const u32x4*)(up - UW);
            if (t < T - 1) nu = *(const u32x4*)(up + UW);
            const f32x4 m0 = *(const f32x4*)(P.in[5] + col), m1 = *(const f32x4*)(P.in[5] + col + 4);
            float v[8];
#pragma unroll
            for (int j = 0; j < 4; ++j) {
                const float c0 = __builtin_bit_cast(float, cu[j] << 16), c1 = __builtin_bit_cast(float, cu[j] & 0xffff0000u);
                const float p0 = __builtin_bit_cast(float, pu[j] << 16), p1 = __builtin_bit_cast(float, pu[j] & 0xffff0000u);
                const float n0 = __builtin_bit_cast(float, nu[j] << 16), n1 = __builtin_bit_cast(float, nu[j] & 0xffff0000u);
                const float mu0 = j < 2 ? m0[2 * j] : m1[2 * j - 4], mu1 = j < 2 ? m0[2 * j + 1] : m1[2 * j - 3];
                v[2 * j] = c0 + mu0 * (0.5f * (p0 + n0) - c0); v[2 * j + 1] = c1 + mu1 * (0.5f * (p1 + n1) - c1);
            }
            if (q < 3) {
                LAS float* dst = (LAS float*)(lds + q * 16384) + i * 64 + c8 * 8;
                *(LAS f32x4*)dst = (f32x4){v[0], v[1], v[2], v[3]}; *(LAS f32x4*)(dst + 4) = (f32x4){v[4], v[5], v[6], v[7]};
                if (q == 2) {
#pragma unroll
                    for (int j = 0; j < 8; ++j) st1(lds + PA_VT, c8 * 8 + j, i, v[j]);
                    if (d == 0) *(u32x4*)(VS + (size_t)t * 512 + h * 64 + c8 * 8) = (u32x4){cvtpk(v[0], v[1]), cvtpk(v[2], v[3]), cvtpk(v[4], v[5]), cvtpk(v[6], v[7])};
                }
            } else {
                if (q == 3) {
#pragma unroll
                    for (int j = 0; j < 8; ++j) v[j] = tanhf(v[j]);
                }
                *(LAS u32x4*)(lds + (q == 3 ? PA_LW : PA_LA) + i * 128 + ((c8 ^ (i & 7)) << 4)) = (u32x4){cvtpk(v[0], v[1]), cvtpk(v[2], v[3]), cvtpk(v[4], v[5]), cvtpk(v[6], v[7])};
            }
        }
    }
    __syncthreads();
    {
        const int sel = wid >> 2, rb = wid & 3;
        const bf16_t* Yg = (sel ? A2T : W2T) + (size_t)(d * 8 + h) * 4096;
        const LAS unsigned char* X = lds + (sel ? PA_LA : PA_LW);
        f32x4 acc[4];
#pragma unroll
        for (int n = 0; n < 4; ++n) acc[n] = (f32x4){0.f, 0.f, 0.f, 0.f};
#pragma unroll
        for (int kk = 0; kk < 2; ++kk) {
            const bf16x8 xf = lfrag(X, rb * 16 + fr, kk, fq);
#pragma unroll
            for (int n = 0; n < 4; ++n) { const bf16x8 yf = *(const bf16x8*)(Yg + (n * 16 + fr) * 64 + (kk * 4 + fq) * 8);
                acc[n] = __builtin_amdgcn_mfma_f32_16x16x32_bf16(yf, xf, acc[n], 0, 0, 0); }
        }
        const int i = rb * 16 + fr;
#pragma unroll
        for (int n = 0; n < 4; ++n) {
            const int cc = n * 16 + 4 * fq;
            const f32x4 b0 = *(const f32x4*)(P.in[sel ? 8 : 6] + d * 512 + h * 64 + cc);
            f32x4 o;
#pragma unroll
            for (int j = 0; j < 4; ++j) { const float z = acc[n][j] + b0[j];
                o[j] = sel ? 1.f / (1.f + __expf(-z)) : -__expf(-log1pf(__expf(-z)) - 0.5f); }
            *(LAS f32x4*)((LAS float*)(lds + (sel ? PA_AL : PA_WL)) + i * 64 + cc) = o;
        }
    }
    __syncthreads();
    {
        const int k = tid & 63, seg = tid >> 6;
        LAS float* WL = (LAS float*)(lds + PA_WL); LAS float* SEG = (LAS float*)(lds + PA_SEG);
        float run = 0.f, tmp[8];
#pragma unroll
        for (int ii = 0; ii < 8; ++ii) { run += WL[(seg * 8 + ii) * 64 + k]; tmp[ii] = run; }
        SEG[seg * 64 + k] = run;
        __syncthreads();
        float off = 0.f;
#pragma unroll
        for (int s = 0; s < 8; ++s) off += (s < seg) ? SEG[s * 64 + k] : 0.f;
#pragma unroll
        for (int ii = 0; ii < 8; ++ii) WL[(seg * 8 + ii) * 64 + k] = tmp[ii] + off;
    }
    __syncthreads();
    {
        const int i = tid >> 3, c8 = tid & 7, cc = c8 * 8;
        const LAS float* Rf = (const LAS float*)(lds + PA_RF) + i * 64 + cc; const LAS float* Kf = (const LAS float*)(lds + PA_KF) + i * 64 + cc;
        const LAS float* Lf = (const LAS float*)(lds + PA_WL) + i * 64 + cc; const LAS float* Af = (const LAS float*)(lds + PA_AL) + i * 64 + cc;
        float rr[8], kv[8], L[8], Lp[8], al[8];
#pragma unroll
        for (int j = 0; j < 8; j += 4) { const f32x4 a = *(const LAS f32x4*)(Rf + j), b = *(const LAS f32x4*)(Kf + j), l4 = *(const LAS f32x4*)(Lf + j), a4 = *(const LAS f32x4*)(Af + j);
            f32x4 lp = (f32x4){0.f, 0.f, 0.f, 0.f}; if (i > 0) lp = *(const LAS f32x4*)(Lf - 64 + j);
#pragma unroll
            for (int u = 0; u < 4; ++u) { rr[j + u] = a[u]; kv[j + u] = b[u]; L[j + u] = l4[u]; Lp[j + u] = lp[u]; al[j + u] = a4[u]; } }
        const float* kkp = P.in[11] + h * 64 + cc; const float* kap = P.in[12] + h * 64 + cc; const float* rkp = P.in[13] + h * 64 + cc;
        float kk[8], kd[8], ss = 0.f, bsum = 0.f;
#pragma unroll
        for (int j = 0; j < 8; ++j) { kk[j] = kv[j] * kkp[j]; ss += kk[j] * kk[j]; kd[j] = kv[j] * (1.f + (al[j] - 1.f) * kap[j]); bsum += rr[j] * kd[j] * rkp[j]; }
#pragma unroll
        for (int o = 1; o < 8; o <<= 1) { ss += __shfl_xor(ss, o); bsum += __shfl_xor(bsum, o); }
        const float inv = 1.f / fmaxf(sqrtf(ss), 1e-12f);
        const int sidx = c * 64 + i, t = d ? (T - 1 - sidx) : sidx;
        if (c8 == 0) BS[((size_t)d * T + t) * 8 + h] = bsum;
        float ah[8], rh[8], bh[8], kh[8];
#pragma unroll
        for (int j = 0; j < 8; ++j) { const float k1 = kk[j] * inv, eL = __expf(L[j]), eLm = __expf(-L[j]), eP = __expf(Lp[j]);
            ah[j] = -k1 * eP; rh[j] = rr[j] * eL; bh[j] = k1 * al[j] * eLm; kh[j] = kd[j] * eLm;
            if (i == 63) { ((LAS float*)(lds + PA_GCL))[cc + j] = eL; GC[(size_t)item * 64 + cc + j] = eL; } }
        const int so = ((c8 ^ (i & 7)) << 4);
        *(LAS u32x4*)(lds + PA_AR + i * 128 + so) = (u32x4){cvtpk(ah[0], ah[1]), cvtpk(ah[2], ah[3]), cvtpk(ah[4], ah[5]), cvtpk(ah[6], ah[7])};
        *(LAS u32x4*)(lds + PA_AR + (64 + i) * 128 + so) = (u32x4){cvtpk(rh[0], rh[1]), cvtpk(rh[2], rh[3]), cvtpk(rh[4], rh[5]), cvtpk(rh[6], rh[7])};
        *(LAS u32x4*)(lds + PA_BK + i * 128 + so) = (u32x4){cvtpk(bh[0], bh[1]), cvtpk(bh[2], bh[3]), cvtpk(bh[4], bh[5]), cvtpk(bh[6], bh[7])};
        *(LAS u32x4*)(lds + PA_BK + (64 + i) * 128 + so) = (u32x4){cvtpk(kh[0], kh[1]), cvtpk(kh[2], kh[3]), cvtpk(kh[4], kh[5]), cvtpk(kh[6], kh[7])};
#pragma unroll
        for (int j = 0; j < 8; ++j) { st1(lds + PA_AT, cc + j, i, ah[j]); st1(lds + PA_BT, cc + j, i, bh[j]); st1(lds + PA_KT, cc + j, i, kh[j]); }
    }
    __syncthreads();
    {
        f32x4 acc[8];
#pragma unroll
        for (int n = 0; n < 8; ++n) acc[n] = (f32x4){0.f, 0.f, 0.f, 0.f};
        mm16<8, true>(acc, lds + PA_AR, wid * 16, lds + PA_BK, 0, fr, fq);
        const int t = (wid & 3) * 16 + fr; const bool isR = wid >= 4;
#pragma unroll
        for (int n = 0; n < 8; ++n) {
            const int j0 = (n & 3) * 16 + 4 * fq; const bool isK = n >= 4;
            f32x4 v = acc[n];
#pragma unroll
            for (int j = 0; j < 4; ++j) { const bool keep = isR ? (j0 + j <= t) : (j0 + j < t); v[j] = keep ? v[j] : 0.f; }
            if (!isR && !isK) {
                st4(lds + PA_N, t, j0, v);
#pragma unroll
                for (int j = 0; j < 4; ++j) st1(lds + PA_NT, j0 + j, t, v[j]);
                f32x4 tv = v;
#pragma unroll
                for (int j = 0; j < 4; ++j) tv[j] += (j0 + j == t) ? 1.f : 0.f;
                st4(lds + PA_T0, t, j0, tv);
            } else if (!isR && isK) {
#pragma unroll
                for (int j = 0; j < 4; ++j) st1(lds + PA_PAKT, j0 + j, t, v[j]);
            } else if (isR && !isK) st4(lds + PA_QRB, t, j0, v);
            else st4(lds + PA_QRK, t, j0, v);
        }
    }
    __syncthreads();
    {
        const int mt = wid >> 1, nt0 = (wid & 1) * 2, row = mt * 16 + fr;
#pragma unroll 1
        for (int s = 0; s < 6; ++s) {
            const LAS unsigned char* Ac = lds + (s == 0 ? PA_N : ((s & 1) ? PA_A0 : PA_A1));
            const LAS unsigned char* ATc = lds + (s == 0 ? PA_NT : ((s & 1) ? PA_AT0 : PA_AT1));
            LAS unsigned char* An = lds + ((s & 1) ? PA_A1 : PA_A0);
            LAS unsigned char* ATn = lds + ((s & 1) ? PA_AT1 : PA_AT0);
            const LAS unsigned char* To = lds + (((s - 1) & 1) ? PA_T1 : PA_T0);
            LAS unsigned char* Tn = lds + ((s & 1) ? PA_T1 : PA_T0);
            if (s < 5) {
                f32x4 aa[2] = {(f32x4){0.f, 0.f, 0.f, 0.f}, (f32x4){0.f, 0.f, 0.f, 0.f}};
                mm16<2, true>(aa, Ac, mt * 16, ATc, nt0 * 16, fr, fq);
#pragma unroll
                for (int n = 0; n < 2; ++n) { const int c0 = (nt0 + n) * 16 + 4 * fq; st4(An, row, c0, aa[n]);
#pragma unroll
                    for (int j = 0; j < 4; ++j) st1(ATn, c0 + j, row, aa[n][j]); }
            }
            if (s > 0) {
                f32x4 ta[2] = {(f32x4){0.f, 0.f, 0.f, 0.f}, (f32x4){0.f, 0.f, 0.f, 0.f}};
                mm16<2, true>(ta, To, mt * 16, ATc, nt0 * 16, fr, fq);
#pragma unroll
                for (int n = 0; n < 2; ++n) { const int c0 = (nt0 + n) * 16 + 4 * fq; const f32x4 o = ld4(To, row, c0) + ta[n]; st4(Tn, row, c0, o); }
            }
            __syncthreads();
        }
    }
    {
        const int mt = wid >> 1, nt0 = (wid & 1) * 4;
        f32x4 acc[4];
#pragma unroll
        for (int n = 0; n < 4; ++n) acc[n] = (f32x4){0.f, 0.f, 0.f, 0.f};
        mm16<4, false>(acc, lds + PA_T1, mt * 16, lds + PA_YG, nt0 * 16, fr, fq);
#pragma unroll
        for (int n = 0; n < 4; ++n) st4(lds + PA_GT, (nt0 + n) * 16 + fr, mt * 16 + 4 * fq, acc[n]);
    }
    __syncthreads();
    {
        const int sel = wid >> 2, mt = wid & 3, row = mt * 16 + fr;
        f32x4 acc[8];
#pragma unroll
        for (int n = 0; n < 8; ++n) acc[n] = (f32x4){0.f, 0.f, 0.f, 0.f};
        mm16<8, true>(acc, lds + (sel ? PA_BT : PA_QRB), mt * 16, lds + PA_GT, 0, fr, fq);
        const float gc = ((const LAS float*)(lds + PA_GCL))[row];
        bf16_t* gout = (bf16_t*)(CM + (size_t)item * CM_ITEM + (sel ? 8192 : 0));
#pragma unroll
        for (int n = 0; n < 8; ++n) {
            const int c0 = (n & 3) * 16 + 4 * fq;
            f32x4 v = acc[n];
            if (n < 4) {
                if (sel == 0) v = v + ld4(lds + PA_AR, 64 + row, c0); else v = v * gc;
                const int tb = row >> 5, lanep = (row & 31) + 32 * (fq & 1);
                *(u32x2*)(gout + (((tb * 4 + n) * 64 + lanep) * 8 + 4 * (fq >> 1))) = (u32x2){cvtpk(v[0], v[1]), cvtpk(v[2], v[3])};
            } else {
                if (sel == 0) v = v + ld4(lds + PA_QRK, row, c0); else v = (v + ld4(lds + PA_KT, row, c0)) * gc;
                st4(lds + PA_OK, sel * 64 + row, c0, v);
            }
        }
    }
    __syncthreads();
    {
        f32x4 acc[4];
#pragma unroll
        for (int n = 0; n < 4; ++n) acc[n] = (f32x4){0.f, 0.f, 0.f, 0.f};
        mm16<4, false>(acc, lds + PA_OK, wid * 16, lds + PA_VT, 0, fr, fq);
        bf16_t* gout = (bf16_t*)(CM + (size_t)item * CM_ITEM + (wid < 4 ? 16384 : 24576));
        const int mt = wid & 3, blk = mt >> 1, reg0 = 4 * ((mt & 1) * 2 + (fq >> 1));
#pragma unroll
        for (int n = 0; n < 4; ++n) {
            const int vhalf = n >> 1, lanep = (n & 1) * 16 + fr + 32 * (fq & 1);
            *(u32x2*)(gout + (((vhalf * 2 + blk) * 64 + lanep) * 16 + reg0)) = (u32x2){cvtpk(acc[n][0], acc[n][1]), cvtpk(acc[n][2], acc[n][3])};
        }
    }
    __syncthreads();
}

constexpr int PB_STAGE = 32768 + 256;
DI void rwkv_passB(const unsigned char* CM, const float* GC, bf16_t* RO, int d, int h, LAS unsigned char* lds) {
    const int tid = tid_fresh(), lane = tid & 63, wid = tid >> 6, r = lane & 31, hh = lane >> 5;
    const size_t item0 = (size_t)(d * 8 + h) * 256;
    for (int i = tid; i < 2048 + 16; i += NTHREADS) {
        const u32x4 v = (i < 2048) ? *(const u32x4*)(CM + item0 * CM_ITEM + (size_t)i * 16) : *(const u32x4*)((const unsigned char*)(GC + item0 * 64) + (size_t)(i - 2048) * 16);
        *(LAS u32x4*)(lds + i * 16) = v;
    }
    __syncthreads();
    f32x16 S0, S1;
#pragma unroll
    for (int i = 0; i < 16; ++i) { S0[i] = 0.f; S1[i] = 0.f; }
#pragma unroll 1
    for (int c = 0; c < 256; ++c) {
        const LAS unsigned char* st = lds + (c & 1) * PB_STAGE;
        if (wid >= 2) {
            if (c + 1 < 256) {
                LAS unsigned char* nx = lds + ((c + 1) & 1) * PB_STAGE;
                const unsigned char* src = CM + (item0 + c + 1) * CM_ITEM; const unsigned char* gsrc = (const unsigned char*)(GC + (item0 + c + 1) * 64);
                for (int i = tid - 128; i < 2048 + 16; i += NTHREADS - 128) {
                    const u32x4 v = (i < 2048) ? *(const u32x4*)(src + (size_t)i * 16) : *(const u32x4*)(gsrc + (size_t)(i - 2048) * 16);
                    *(LAS u32x4*)(nx + i * 16) = v;
                }
            }
        } else {
            const int vhalf = wid;
            bf16x8 xs[4];
            { u32x4 w;
              w = (u32x4){cvtpk(S0[0], S0[1]), cvtpk(S0[2], S0[3]), cvtpk(S0[4], S0[5]), cvtpk(S0[6], S0[7])}; xs[0] = __builtin_bit_cast(bf16x8, w);
              w = (u32x4){cvtpk(S0[8], S0[9]), cvtpk(S0[10], S0[11]), cvtpk(S0[12], S0[13]), cvtpk(S0[14], S0[15])}; xs[1] = __builtin_bit_cast(bf16x8, w);
              w = (u32x4){cvtpk(S1[0], S1[1]), cvtpk(S1[2], S1[3]), cvtpk(S1[4], S1[5]), cvtpk(S1[6], S1[7])}; xs[2] = __builtin_bit_cast(bf16x8, w);
              w = (u32x4){cvtpk(S1[8], S1[9]), cvtpk(S1[10], S1[11]), cvtpk(S1[12], S1[13]), cvtpk(S1[14], S1[15])}; xs[3] = __builtin_bit_cast(bf16x8, w); }
#pragma unroll
            for (int tb = 0; tb < 2; ++tb) {
                const LAS unsigned char* op = st + 16384 + ((vhalf * 2 + tb) * 64 + lane) * 32;
                const u32x4 a = *(const LAS u32x4*)op, b = *(const LAS u32x4*)(op + 16);
                f32x16 o;
#pragma unroll
                for (int j = 0; j < 4; ++j) { o[2 * j] = __builtin_bit_cast(float, a[j] << 16); o[2 * j + 1] = __builtin_bit_cast(float, a[j] & 0xffff0000u);
                                              o[8 + 2 * j] = __builtin_bit_cast(float, b[j] << 16); o[8 + 2 * j + 1] = __builtin_bit_cast(float, b[j] & 0xffff0000u); }
#pragma unroll
                for (int s = 0; s < 4; ++s) o = __builtin_amdgcn_mfma_f32_32x32x16_bf16(*(const LAS bf16x8*)(st + ((tb * 4 + s) * 64 + lane) * 16), xs[s], o, 0, 0, 0);
#pragma unroll
                for (int i = 0; i < 16; ++i) { const int tt = c * 64 + tb * 32 + (i & 3) + 8 * (i >> 2) + 4 * hh; const int tok = d ? (T - 1 - tt) : tt;
                    RO[((size_t)d * T + tok) * 512 + h * 64 + vhalf * 32 + r] = (bf16_t)(cvtpk(o[i], 0.f) & 0xffffu); }
            }
            f32x16 n0, n1;
            {
                const LAS float* gcl = (const LAS float*)(st + 32768);
                const LAS unsigned char* hp0 = st + 24576 + ((vhalf * 2 + 0) * 64 + lane) * 32; const LAS unsigned char* hp1 = st + 24576 + ((vhalf * 2 + 1) * 64 + lane) * 32;
                const u32x4 a0 = *(const LAS u32x4*)hp0, b0 = *(const LAS u32x4*)(hp0 + 16), a1 = *(const LAS u32x4*)hp1, b1 = *(const LAS u32x4*)(hp1 + 16);
#pragma unroll
                for (int j = 0; j < 4; ++j) { n0[2 * j] = __builtin_bit_cast(float, a0[j] << 16); n0[2 * j + 1] = __builtin_bit_cast(float, a0[j] & 0xffff0000u);
                                              n0[8 + 2 * j] = __builtin_bit_cast(float, b0[j] << 16); n0[8 + 2 * j + 1] = __builtin_bit_cast(float, b0[j] & 0xffff0000u);
                                              n1[2 * j] = __builtin_bit_cast(float, a1[j] << 16); n1[2 * j + 1] = __builtin_bit_cast(float, a1[j] & 0xffff0000u);
                                              n1[8 + 2 * j] = __builtin_bit_cast(float, b1[j] << 16); n1[8 + 2 * j + 1] = __builtin_bit_cast(float, b1[j] & 0xffff0000u); }
#pragma unroll
                for (int i = 0; i < 16; ++i) { const int kr = (i & 3) + 8 * (i >> 2) + 4 * hh; n0[i] += gcl[kr] * S0[i]; n1[i] += gcl[32 + kr] * S1[i]; }
            }
#pragma unroll
            for (int s = 0; s < 4; ++s) {
                n0 = __builtin_amdgcn_mfma_f32_32x32x16_bf16(*(const LAS bf16x8*)(st + 8192 + ((0 * 4 + s) * 64 + lane) * 16), xs[s], n0, 0, 0, 0);
                n1 = __builtin_amdgcn_mfma_f32_32x32x16_bf16(*(const LAS bf16x8*)(st + 8192 + ((1 * 4 + s) * 64 + lane) * 16), xs[s], n1, 0, 0, 0);
            }
            S0 = n0; S1 = n1;
        }
        __syncthreads();
    }
}

constexpr float QSCALE = 0.10206207261596575f * 1.4426950408889634f;
DI void mla_prep_token(const Params& P, const bf16_t* U, float* IR, bf16_t* Kb, int t, int lane) {
    const bf16_t* ur = U + (size_t)t * UW;
    { const u32x2 v = *(const u32x2*)(ur + 1920 + lane * 4);
      const float x0 = __builtin_bit_cast(float, v.x << 16), x1 = __builtin_bit_cast(float, v.x & 0xffff0000u), x2 = __builtin_bit_cast(float, v.y << 16), x3 = __builtin_bit_cast(float, v.y & 0xffff0000u);
      const float ss = wave_sum(x0 * x0 + x1 * x1 + x2 * x2 + x3 * x3);
      if (lane == 0) IR[(size_t)t * 2] = 1.f / sqrtf(ss * (1.f / 256.f) + NORM_EPS); }
    { const unsigned v = *(const unsigned*)(ur + 2176 + lane * 2);
      const float x0 = __builtin_bit_cast(float, v << 16), x1 = __builtin_bit_cast(float, v & 0xffff0000u);
      const float ss = wave_sum(x0 * x0 + x1 * x1);
      if (lane == 0) IR[(size_t)t * 2 + 1] = 1.f / sqrtf(ss * (1.f / 128.f) + NORM_EPS); }
    if (lane < 16) {
        const float x1 = bf2f(ur[2304 + lane]), x2 = bf2f(ur[2304 + 16 + lane]);
        const float pos = (float)((const int*)P.in[2])[t];
        const float inv = exp2f(-(float)lane * (13.287712379549449f / 16.f));
        const float ang = pos * inv; float sn, cs; sincosf(ang, &sn, &cs);
        const bf16_t o1 = (bf16_t)f2bf(x1 * cs - x2 * sn), o2 = (bf16_t)f2bf(x2 * cs + x1 * sn);
#pragma unroll
        for (int h = 0; h < 8; ++h) { bf16_t* kp = Kb + ((size_t)h * T + t) * 96; kp[64 + lane] = o1; kp[80 + lane] = o2; }
    }
}
constexpr int ATT_KB = 64 * 208, ATT_VB = 64 * 144, ATT_STAGE = ATT_KB + ATT_VB, ATT_SCR = 2 * ATT_STAGE;
DI int crow(int reg, int hh) { return (reg & 3) + 8 * (reg >> 2) + 4 * hh; }
DI void attn_unit(const bf16_t* Q, const bf16_t* Kb, const bf16_t* VT, bf16_t* YM, int h, int qb, LAS unsigned char* lds) {
    const int tid = tid_fresh(), lane = tid & 63, wid = tid >> 6, r = lane & 31, hh = lane >> 5;
    const int q0 = qb * 256 + wid * 32;
    bf16x8 qf[6];
    { const bf16_t* qp = Q + ((size_t)h * T + q0 + r) * 96 + 8 * hh;
#pragma unroll
      for (int ks = 0; ks < 6; ++ks) qf[ks] = *(const bf16x8*)(qp + 16 * ks); }
    f32x16 o0, o1;
#pragma unroll
    for (int i = 0; i < 16; ++i) { o0[i] = 0.f; o1[i] = 0.f; }
    float mrow = -1e30f, lrow = 0.f;
    LAS float* scr = (LAS float*)(lds + ATT_SCR + wid * 256);
    const bf16_t* kg = Kb + (size_t)h * T * 96;
    const bf16_t* vg = VT + (size_t)(h * 64 + (tid >> 3)) * T + (tid & 7) * 8;
    const int kl0 = (tid / 12) * 208 + (tid % 12) * 16, c1 = 512 + tid, kl1 = (c1 / 12) * 208 + (c1 % 12) * 16;
    const int vl = ATT_KB + (tid >> 3) * 144 + (tid & 7) * 16;
    u32x4 rk0, rk1, rv;
    rk0 = *(const u32x4*)(kg + (size_t)tid * 8); if (tid < 256) rk1 = *(const u32x4*)(kg + (size_t)c1 * 8);
    rv = *(const u32x4*)(vg);
    *(LAS u32x4*)(lds + kl0) = rk0; if (tid < 256) *(LAS u32x4*)(lds + kl1) = rk1; *(LAS u32x4*)(lds + vl) = rv;
    __syncthreads();
    constexpr int NT_ = T / 64;
    for (int t = 0; t < NT_; ++t) {
        LAS unsigned char* cur = lds + (t & 1) * ATT_STAGE;
        LAS unsigned char* nxt = lds + ((t + 1) & 1) * ATT_STAGE;
        const bool more = (t + 1 < NT_);
        if (more) { const size_t t1 = (size_t)(t + 1) * 64;
            rk0 = *(const u32x4*)(kg + t1 * 96 + (size_t)tid * 8); if (tid < 256) rk1 = *(const u32x4*)(kg + t1 * 96 + (size_t)c1 * 8);
            rv = *(const u32x4*)(vg + t1); }
        f32x16 p0, p1;
#pragma unroll
        for (int i = 0; i < 16; ++i) { p0[i] = 0.f; p1[i] = 0.f; }
#pragma unroll
        for (int ks = 0; ks < 6; ++ks) {
            const bf16x8 ka0 = *(const LAS bf16x8*)(cur + r * 208 + (16 * ks + 8 * hh) * 2);
            const bf16x8 ka1 = *(const LAS bf16x8*)(cur + (32 + r) * 208 + (16 * ks + 8 * hh) * 2);
            p0 = __builtin_amdgcn_mfma_f32_32x32x16_bf16(ka0, qf[ks], p0, 0, 0, 0);
            p1 = __builtin_amdgcn_mfma_f32_32x32x16_bf16(ka1, qf[ks], p1, 0, 0, 0);
        }
        float mx = p0[0];
#pragma unroll
        for (int i = 1; i < 16; ++i) mx = fmaxf(mx, p0[i]);
#pragma unroll
        for (int i = 0; i < 16; ++i) mx = fmaxf(mx, p1[i]);
        mx = fmaxf(mx, __shfl_xor(mx, 32));
        const float mnew = fmaxf(mrow, mx);
        if (__any(mnew > mrow)) {
            const float alpha = exp2f(mrow - mnew);
            lrow *= alpha; mrow = mnew;
            if (hh == 0) scr[r] = alpha;
            asm volatile("s_waitcnt lgkmcnt(0)" ::: "memory");
#pragma unroll
            for (int i = 0; i < 16; ++i) { const float a = scr[crow(i, hh)]; o0[i] *= a; o1[i] *= a; }
        }
        float ls = 0.f;
#pragma unroll
        for (int i = 0; i < 16; ++i) { p0[i] = exp2f(p0[i] - mrow); p1[i] = exp2f(p1[i] - mrow); ls += p0[i] + p1[i]; }
        lrow += ls;
        bf16x8 pa[4];
#pragma unroll
        for (int ks = 0; ks < 4; ++ks) {
            u32x4 w;
#pragma unroll
            for (int j = 0; j < 4; ++j) { const int i0 = 8 * (ks & 1) + 2 * j; w[j] = (ks < 2) ? pk2(p0[i0], p0[i0 + 1]) : pk2(p1[i0], p1[i0 + 1]); }
            pa[ks] = __builtin_bit_cast(bf16x8, w);
        }
#pragma unroll
        for (int ks = 0; ks < 4; ++ks) {
            const bf16x8 vb0 = *(const LAS bf16x8*)(cur + ATT_KB + r * 144 + (16 * ks + 8 * hh) * 2);
            const bf16x8 vb1 = *(const LAS bf16x8*)(cur + ATT_KB + (32 + r) * 144 + (16 * ks + 8 * hh) * 2);
            o0 = __builtin_amdgcn_mfma_f32_32x32x16_bf16(pa[ks], vb0, o0, 0, 0, 0);
            o1 = __builtin_amdgcn_mfma_f32_32x32x16_bf16(pa[ks], vb1, o1, 0, 0, 0);
        }
        if (more) { *(LAS u32x4*)(nxt + kl0) = rk0; if (tid < 256) *(LAS u32x4*)(nxt + kl1) = rk1; *(LAS u32x4*)(nxt + vl) = rv; }
        __syncthreads();
    }
    lrow += __shfl_xor(lrow, 32);
    if (hh == 0) scr[32 + r] = 1.f / lrow;
    asm volatile("s_waitcnt lgkmcnt(0)" ::: "memory");
#pragma unroll
    for (int i = 0; i < 16; ++i) { const int q = crow(i, hh); const float il = scr[32 + q];
        bf16_t* yp = YM + (size_t)(q0 + q) * 512 + h * 64;
        yp[r] = (bf16_t)f2bf(o0[i] * il); yp[32 + r] = (bf16_t)f2bf(o1[i] * il); }
    __syncthreads();
}

__global__ void __launch_bounds__(NTHREADS, 2) mega(Params P) {
    extern __shared__ __attribute__((aligned(16))) unsigned char lds_raw[];
    LAS unsigned char* lds = (LAS unsigned char*)lds_raw;
    const int G = gridDim.x, bid = blockIdx.x, NGW = G * NWAVES;
#define PHASE_IDS() const int tid = tid_fresh(); const int lane = tid & 63; const int wave = __builtin_amdgcn_readfirstlane(tid >> 6); const int gw = bid * NWAVES + wave; (void)lane; (void)gw; (void)wave;
    volatile LAS unsigned* MISC = (volatile LAS unsigned*)(lds + LDS_MISC);
    if (threadIdx.x < 64) MISC[threadIdx.x] = 0u;
    __syncthreads();
    unsigned char* ws = P.ws;
    XcdBarrier bar = xcd_barrier_post((unsigned*)(ws + WS_CTL) + 1024, MISC + 8);
#define GRID_BAR() xcd_barrier(bar)

    bf16_t* WT = (bf16_t*)(ws + WS_WT);
    bf16_t* U = (bf16_t*)(ws + WS_U);
    float* XB = (float*)(ws + WS_XB);
    bf16_t* Hb = (bf16_t*)(ws + WS_H2);
    bf16_t* Qb = (bf16_t*)P.out;
    bf16_t* Kb = Qb + (size_t)8 * T * 96;
    bf16_t* VT = Kb + (size_t)8 * T * 96;
    bf16_t* MG = (bf16_t*)P.out;
    ScEnt* SC = (ScEnt*)P.out;
#define gt ((size_t)(blockIdx.x * NTHREADS + tid))
#define GT ((size_t)(gridDim.x * NTHREADS))

    {
    PHASE_IDS();
        LAS float* scr = (LAS float*)(lds + wave * 16384);
        const TrJob jobs[12] = {
            {P.in[4], IN_COLS, 0, 1024, 1920, WT + WT_IN, nullptr},
            {P.in[4], IN_COLS, 1920, 1024, 416, WT + WT_IN + (size_t)1920 * 1024, nullptr},
            {P.in[4], IN_COLS, 2336, 1024, 2048, WT + WT_GATE, nullptr},
            {P.in[20], 1024, 0, 512, 1024, WT + WT_BRA, nullptr},
            {P.in[21], 1024, 0, 512, 1024, WT + WT_BRB, nullptr},
            {P.in[22], 1024, 0, 1024, 1024, WT + WT_OUT, nullptr},
            {P.in[29], 1024, 0, 1024, 1024, WT + WT_PG, nullptr},
            {P.in[30], 1024, 0, 256, 1024, WT + WT_PP, nullptr},
            {P.in[24], 2048, 0, 1024, 2048, WT + WT_PQ, nullptr},
            {P.in[10], 512, 0, 128, 512, WT + WT_G2, nullptr},
            {P.in[17], 768, 0, 256, 768, WT + WT_QUP, P.in[16]},
            {P.in[19], 1024, 0, 128, 1024, WT + WT_KVUP, P.in[18]},
        };
#pragma unroll
        for (int j = 0; j < 12; ++j) {
            const int ni = trjob_items(jobs[j]);
            for (int it = gw; it < ni; it += NGW) transpose_item(jobs[j].W, jobs[j].ldw, jobs[j].col_off, jobs[j].K, jobs[j].WT, jobs[j].ncols, scr, it, lane, jobs[j].ks);
        }
        for (size_t i = gt; i < (size_t)96 * 1024 / 8; i += GT) ((u32x4*)(WT + WT_IN + (size_t)2336 * 1024))[i] = (u32x4){0u, 0u, 0u, 0u};
        for (size_t i = gt; i < (size_t)16 * 128 * 128 / 4; i += GT) { const f32x4 v = ((const f32x4*)P.in[25])[i]; ((u32x2*)(WT + WT_SK))[i] = (u32x2){pk2(v.x, v.y), pk2(v.z, v.w)}; }
        for (size_t i = gt; i < 65536; i += GT) { const int l = (int)(i & 63), cc = (int)((i >> 6) & 63), hh_ = (int)((i >> 12) & 7), dd = (int)(i >> 15);
            WT[WT_W2T + i] = (bf16_t)f2bf(P.in[7][((size_t)dd * 64 + l) * 512 + hh_ * 64 + cc]); WT[WT_A2T + i] = (bf16_t)f2bf(P.in[9][((size_t)dd * 64 + l) * 512 + hh_ * 64 + cc]); }
        for (int m = gw; m < T; m += NGW) rms_row_to_bf16(P.in[0] + (size_t)m * D, P.in[3], (bf16_t*)(ws + WS_H) + (size_t)m * D, lane);
    }
    GRID_BAR();
    {
    PHASE_IDS();
        const int ntn = UW / G_BN, ntile = (T / G_BM) * ntn;
        for (int tile = bid; tile < ntile; tile += G) {
            const int row0 = (tile / ntn) * G_BM, col0 = (tile % ntn) * G_BN;
            f32x4 acc[4][4]; acc_zero(acc);
            gemm_accum(acc, GemmSrc{(const bf16_t*)(ws + WS_H), D, WT + WT_IN, D, D}, row0, col0, lds);
            EPI_LOOP(row0, col0) { *(u32x2*)(U + (size_t)EPI_ROW(row0) * UW + EPI_COL(col0)) = (u32x2){pk2(acc[m][n][0], acc[m][n][1]), pk2(acc[m][n][2], acc[m][n][3])}; }
        }
    }
    GRID_BAR();
    {
    PHASE_IDS();
        for (int item = bid; item < 4096; item += G)
            rwkv_passA(P, U, WT + WT_W2T, WT + WT_A2T, ws + WS_CM, (float*)(ws + WS_GC), (float*)(ws + WS_BS), (bf16_t*)(ws + WS_VS), item, lds);
        bf16_t* LG = (bf16_t*)(ws + WS_LG);
        for (size_t i = gt; i < (size_t)T * 128; i += GT) { const int t = (int)(i >> 7), j = (int)(i & 127);
            LG[i] = (bf16_t)f2bf(sigmoidf_(ushift(U, t, 1792 + j, P.in[5][1792 + j]))); }
        for (int m = gw; m < T; m += NGW) mla_prep_token(P, U, (float*)(ws + WS_IR), Kb, m, lane);
    }
    GRID_BAR();
    {
    PHASE_IDS();
        const float* IR = (const float*)(ws + WS_IR);
        const int nq = (T / G_BM) * 6, nkv = (T / G_BM) * 8;
        for (int tile = bid; tile < nq + nkv; tile += G) {
            f32x4 acc[4][4]; acc_zero(acc);
            if (tile < nq) {
                const int row0 = (tile / 6) * G_BM, col0 = (tile % 6) * G_BN;
                gemm_accum(acc, GemmSrc{U + 1920, UW, WT + WT_QUP, 256, 256}, row0, col0, lds);
                EPI_LOOP(row0, col0) { const int row = EPI_ROW(row0), col = EPI_COL(col0), hq = col / 96, dq = col % 96; const float sc = IR[(size_t)row * 2] * QSCALE;
                    *(u32x2*)(Qb + ((size_t)hq * T + row) * 96 + dq) = (u32x2){pk2(acc[m][n][0] * sc, acc[m][n][1] * sc), pk2(acc[m][n][2] * sc, acc[m][n][3] * sc)}; }
            } else {
                const int tt = tile - nq, row0 = (tt / 8) * G_BM, hk = tt % 8, col0 = hk * G_BN;
                gemm_accum<false>(acc, GemmSrc{U + 2176, UW, WT + WT_KVUP, 128, 128}, row0, col0, lds);
                const int lane_ = tid & 63, wid_ = tid >> 6, wr_ = wid_ >> 1, wc_ = wid_ & 1, fr_ = lane_ & 15, fq_ = lane_ >> 4;
#pragma unroll
                for (int m = 0; m < 4; ++m)
#pragma unroll
                    for (int n = 0; n < 4; ++n) {
                        const int rbase = row0 + wr_ * 64 + m * 16, cc = wc_ * 64 + n * 16 + fr_;
                        const f32x4 ir = (f32x4){IR[(size_t)(rbase + 4 * fq_) * 2 + 1], IR[(size_t)(rbase + 4 * fq_ + 1) * 2 + 1], IR[(size_t)(rbase + 4 * fq_ + 2) * 2 + 1], IR[(size_t)(rbase + 4 * fq_ + 3) * 2 + 1]};
                        const f32x4 v = acc[m][n] * ir;
                        if (wc_ == 0) {
#pragma unroll
                            for (int j = 0; j < 4; ++j) Kb[((size_t)hk * T + rbase + 4 * fq_ + j) * 96 + cc] = (bf16_t)f2bf(v[j]);
                        } else {
                            *(u32x2*)(VT + (size_t)(hk * 64 + cc - 64) * T + rbase + 8 * (fq_ & 1) + 4 * (fq_ >> 1)) = (u32x2){pk2(v[0], v[1]), pk2(v[2], v[3])};
                        }
                    }
            }
        }
    }
    GRID_BAR();
    {
    PHASE_IDS();
    for (size_t i = gt; i < (size_t)T * 8 * 16; i += GT) {
        const int ii = (int)(i & 15), hq = (int)((i >> 4) & 7), t = (int)(i >> 7);
        bf16_t* qp = Qb + ((size_t)hq * T + t) * 96 + 64;
        const float x1 = bf2f(qp[ii]), x2 = bf2f(qp[16 + ii]);
        const float pos = (float)((const int*)P.in[2])[t];
        const float inv = exp2f(-(float)ii * (13.287712379549449f / 16.f));
        float sn, cs; sincosf(pos * inv, &sn, &cs);
        qp[ii] = (bf16_t)f2bf(x1 * cs - x2 * sn); qp[16 + ii] = (bf16_t)f2bf(x2 * cs + x1 * sn);
    }
    }
    GRID_BAR();
    {
    PHASE_IDS();
        if (bid < 16) rwkv_passB(ws + WS_CM, (const float*)(ws + WS_GC), (bf16_t*)(ws + WS_RO), bid >> 3, bid & 7, lds);
        unsigned* qctr = (unsigned*)(ws + WS_CTL) + 8192;
        for (;;) {
            if (tid == 0) MISC[16] = __hip_atomic_fetch_add(qctr, 1u, __ATOMIC_RELAXED, __HIP_MEMORY_SCOPE_AGENT);
            __syncthreads();
            const unsigned unit = MISC[16];
            __syncthreads();
            if (unit >= 8u * (T / 256)) break;
            attn_unit(Qb, Kb, VT, (bf16_t*)(ws + WS_YM), (int)(unit >> 6), (int)(unit & 63), lds);
        }
    }
    GRID_BAR();
    {
    PHASE_IDS();
        bf16_t* Gm = (bf16_t*)(ws + WS_GM);
        const int ntn = 512 / G_BN, ntile = (T / G_BM) * ntn;
        for (int tile = bid; tile < ntile; tile += G) {
            const int row0 = (tile / ntn) * G_BM, col0 = (tile % ntn) * G_BN;
            f32x4 acc[4][4]; acc_zero(acc);
            gemm_accum(acc, GemmSrc{(const bf16_t*)(ws + WS_LG), 128, WT + WT_G2, 128, 128}, row0, col0, lds);
            EPI_LOOP(row0, col0) { *(u32x2*)(Gm + (size_t)EPI_ROW(row0) * 512 + EPI_COL(col0)) = (u32x2){pk2(acc[m][n][0], acc[m][n][1]), pk2(acc[m][n][2], acc[m][n][3])}; }
        }
        for (int m = gw; m < T; m += NGW) rms_row_to_bf16(P.in[0] + (size_t)m * D, P.in[3], Hb + (size_t)m * D, lane);
    }
    GRID_BAR();
    {
    PHASE_IDS();
    for (int m = gw; m < T; m += NGW) rwkv_merge_token(P, (const bf16_t*)(ws + WS_VS), (const bf16_t*)(ws + WS_RO), (const float*)(ws + WS_BS), (const bf16_t*)(ws + WS_GM), (bf16_t*)(ws + WS_YRW), m, lane);
    }
    GRID_BAR();
    {
    PHASE_IDS();
        const bf16_t* YRW = (const bf16_t*)(ws + WS_YRW); const bf16_t* YM = (const bf16_t*)(ws + WS_YM);
        const int ntn = D / G_BN, ntile = (T / G_BM) * ntn;
        for (int tile = bid; tile < ntile; tile += G) {
            const int row0 = (tile / ntn) * G_BM, col0 = (tile % ntn) * G_BN;
            f32x4 acc1[4][4], acc2[4][4];
            acc_zero(acc1); acc_zero(acc2);
            gemm_accum(acc1, GemmSrc{Hb, D, WT + WT_GATE, D, D}, row0, col0, lds);
            gemm_accum(acc2, GemmSrc{YRW, 512, WT + WT_BRA, 512, 512}, row0, col0, lds);
            {
                EPI_LOOP(row0, col0) {
                    f32x4 o;
#pragma unroll
                    for (int j = 0; j < 4; ++j) o[j] = sigmoidf_(acc1[m][n][j]) * acc2[m][n][j];
                    *(u32x2*)(MG + (size_t)EPI_ROW(row0) * D + EPI_COL(col0)) = (u32x2){pk2(o[0], o[1]), pk2(o[2], o[3])};
                }
            }
            acc_zero(acc1); acc_zero(acc2);
            gemm_accum(acc1, GemmSrc{Hb, D, WT + WT_GATE + (size_t)1024 * 1024, D, D}, row0, col0, lds);
            gemm_accum(acc2, GemmSrc{YM, 512, WT + WT_BRB, 512, 512}, row0, col0, lds);
            {
                EPI_LOOP(row0, col0) {
                    bf16_t* mp = MG + (size_t)EPI_ROW(row0) * D + EPI_COL(col0);
                    const u32x2 pr = *(const u32x2*)mp;
                    f32x4 o;
                    o[0] = __builtin_bit_cast(float, pr.x << 16); o[1] = __builtin_bit_cast(float, pr.x & 0xffff0000u);
                    o[2] = __builtin_bit_cast(float, pr.y << 16); o[3] = __builtin_bit_cast(float, pr.y & 0xffff0000u);
#pragma unroll
                    for (int j = 0; j < 4; ++j) o[j] += sigmoidf_(acc1[m][n][j]) * acc2[m][n][j];
                    *(u32x2*)mp = (u32x2){pk2(o[0], o[1]), pk2(o[2], o[3])};
                }
            }
        }
    }
    GRID_BAR();
    {
    PHASE_IDS();
        bf16_t* EU = (bf16_t*)(ws + WS_ET); bf16_t* EV = (bf16_t*)(ws + WS_ET + 32 * MiB); bf16_t* PB = (bf16_t*)(ws + WS_PB);
        const int ntn = D / G_BN, ntile = (T / G_BM) * ntn;
        for (int tile = bid; tile < ntile; tile += G) {
            const int row0 = (tile / ntn) * G_BM, col0 = (tile % ntn) * G_BN;
            f32x4 acc[4][4]; acc_zero(acc);
            gemm_accum(acc, GemmSrc{MG, D, WT + WT_OUT, D, D}, row0, col0, lds);
            EPI_LOOP(row0, col0) { const size_t off = (size_t)EPI_ROW(row0) * D + EPI_COL(col0);
                const f32x4 xv = *(const f32x4*)(P.in[0] + off); *(f32x4*)(XB + off) = xv + acc[m][n]; }
        }
        for (size_t i = gt; i < (size_t)T * PLE / 4; i += GT) { const f32x4 v = ((const f32x4*)P.in[1])[i]; ((u32x2*)PB)[i] = (u32x2){pk2(v.x, v.y), pk2(v.z, v.w)}; }
        for (size_t i = gt; i < (size_t)16384 * 1024 / 4; i += GT) {
            const f32x4 a = ((const f32x4*)P.in[26])[i]; ((u32x2*)EU)[i] = (u32x2){pk2(a.x, a.y), pk2(a.z, a.w)};
            const f32x4 b = ((const f32x4*)P.in[27])[i]; ((u32x2*)EV)[i] = (u32x2){pk2(b.x, b.y), pk2(b.z, b.w)}; }
    }
    GRID_BAR();
    {
    PHASE_IDS();
    for (int m = gw; m < T; m += NGW) rms_row_to_bf16(XB + (size_t)m * D, P.in[23], Hb + (size_t)m * D, lane);
    }
    GRID_BAR();
    {
    PHASE_IDS();
        const int ntile = (T / G_BM) * 16;
        for (int tile = bid; tile < ntile; tile += G) peer_query_tile(Hb, WT + WT_PQ, WT + WT_SK, SC, tile / 16, tile % 16, lds);
    }
    GRID_BAR();
    {
    PHASE_IDS();
    for (int m = gw; m < T; m += NGW) peer_token(XB + (size_t)m * D, XB + (size_t)m * D, Hb + (size_t)m * D, SC + (size_t)m * 256, (const bf16_t*)(ws + WS_ET), (const bf16_t*)(ws + WS_ET + 32 * MiB), P.in[28], lane);
    }
    GRID_BAR();
    {
    PHASE_IDS();
        const bf16_t* PB = (const bf16_t*)(ws + WS_PB);
        const int ntile = (T / G_BM) * (D / G_BN);
        for (int tile = bid; tile < ntile; tile += G) {
            const int pm = tile / (D / G_BN), pn = tile % (D / G_BN);
            const int row0 = pm * G_BM, col0 = pn * G_BN;
            f32x4 acc1[4][4], acc2[4][4];
            acc_zero(acc1); acc_zero(acc2);
            gemm_accum(acc1, GemmSrc{PB, PLE, WT + WT_PP, PLE, PLE}, row0, col0, lds);
            gemm_accum(acc2, GemmSrc{Hb, D, WT + WT_PG, D, D}, row0, col0, lds);
            EPI_LOOP(row0, col0) {
                const size_t off = (size_t)EPI_ROW(row0) * D + EPI_COL(col0);
                const f32x4 xv = *(const f32x4*)(XB + off);
                f32x4 o;
#pragma unroll
                for (int j = 0; j < 4; ++j) o[j] = xv[j] + acc1[m][n][j] * sigmoidf_(acc2[m][n][j]);
                *(f32x4*)(XB + off) = o;
            }
        }
    }
    GRID_BAR();
    {
    PHASE_IDS();
    for (int m = gw; m < T; m += NGW) rms_row_to_f32(XB + (size_t)m * D, P.in[31], P.out + (size_t)m * D, lane);
    }
}

extern "C" void kernel_launch(void* const* d_in, const int* in_sizes, int n_in, void* d_out, int out_size, void* d_ws, size_t ws_size, hipStream_t stream) {
    static int grid = 0;
    if (grid == 0) {
        if (n_in != 32 || out_size != T * D || ws_size < WS_END) { fprintf(stderr, "kernel_launch: unexpected shapes n_in %d out %d ws %zu\n", n_in, out_size, ws_size); grid = -1; return; }
        int dev = 0, cus = 0, per_cu = 0;
        if (hipGetDevice(&dev) != hipSuccess || hipDeviceGetAttribute(&cus, hipDeviceAttributeMultiprocessorCount, dev) != hipSuccess) { grid = -1; return; }
        if (hipFuncSetAttribute((const void*)mega, hipFuncAttributeMaxDynamicSharedMemorySize, LDS_BYTES) != hipSuccess) { fprintf(stderr, "kernel_launch: hipFuncSetAttribute failed\n"); grid = -1; return; }
        if (hipOccupancyMaxActiveBlocksPerMultiprocessor(&per_cu, (const void*)mega, NTHREADS, LDS_BYTES) != hipSuccess || per_cu < 1) { fprintf(stderr, "kernel_launch: occupancy query says %d blocks per CU\n", per_cu); (void)hipGetLastError(); grid = -1; return; }
        grid = cus;
    }
    if (grid < 0) return;
    (void)hipMemsetAsync((char*)d_ws + WS_CTL, 0, CTL_ZERO_BYTES, stream);
    Params p{};
    for (int i = 0; i < 32; ++i) p.in[i] = (const float*)d_in[i];
    p.out = (float*)d_out; p.ws = (unsigned char*)d_ws;
    hipLaunchKernelGGL(mega, dim3(grid), dim3(NTHREADS), LDS_BYTES, stream, p);
}
```

```cpp
#include <hip/hip_runtime.h>
#include <cstdio>
#include <cstdint>

#define DI __device__ __forceinline__
#define LAS __attribute__((address_space(3)))
#define GAS __attribute__((address_space(1)))
typedef unsigned short bf16_t;
typedef short bf16x8 __attribute__((ext_vector_type(8)));
typedef float f32x4 __attribute__((ext_vector_type(4)));
typedef float f32x2 __attribute__((ext_vector_type(2)));
typedef float f32x16 __attribute__((ext_vector_type(16)));
typedef unsigned u32x4 __attribute__((ext_vector_type(4)));
typedef unsigned u32x2 __attribute__((ext_vector_type(2)));

constexpr int T = 16384, D = 1024, PLE = 256;
constexpr int RW_W = 512, RW_COLS = 1920, MLA_COLS = 416, GATE_COLS = 2048, IN_COLS = 4384;
constexpr int NTHREADS = 512, NWAVES = 8;
constexpr float NORM_EPS = 1e-6f;

constexpr size_t MiB = 1u << 20;
constexpr size_t WS_CTL = 0;
constexpr size_t CTL_ZERO_BYTES = 96 * 1024;
constexpr size_t WS_WT = 1 * MiB;
constexpr size_t WS_CM = 25 * MiB;
constexpr size_t WS_U = 153 * MiB;
constexpr size_t WS_VS = 229 * MiB;
constexpr size_t WS_LG = 245 * MiB;
constexpr size_t WS_BS = 249 * MiB;
constexpr size_t WS_GC = 250 * MiB;
constexpr size_t WS_IR = 251 * MiB;
constexpr size_t WS_END = 252 * MiB;
constexpr int UW = 2432;
constexpr int CM_ITEM = 32768;
constexpr size_t WS_H = WS_CM;
constexpr size_t WS_HG = WS_U;
constexpr size_t WS_GM = WS_U + 48 * MiB;
constexpr size_t WS_YRW = WS_VS;
constexpr size_t WS_H2 = WS_CM + 32 * MiB;
constexpr size_t WS_XB = WS_CM + 64 * MiB;
constexpr size_t WS_YM = WS_U + 32 * MiB;
constexpr size_t WS_ET = WS_U;
constexpr size_t WS_PB = WS_U + 64 * MiB;
constexpr size_t WT_IN = 0;
constexpr size_t WT_GATE = WT_IN + (size_t)2432 * 1024;
constexpr size_t WT_PQ = WT_GATE + (size_t)2048 * 1024;
constexpr size_t WT_OUT = WT_PQ + (size_t)2048 * 1024;
constexpr size_t WT_PG = WT_OUT + (size_t)1024 * 1024;
constexpr size_t WT_BRA = WT_PG + (size_t)1024 * 1024;
constexpr size_t WT_BRB = WT_BRA + (size_t)1024 * 512;
constexpr size_t WT_PP = WT_BRB + (size_t)1024 * 512;
constexpr size_t WT_QUP = WT_PP + (size_t)1024 * 256;
constexpr size_t WT_KVUP = WT_QUP + (size_t)768 * 256;
constexpr size_t WT_SK = WT_KVUP + (size_t)1024 * 128;
constexpr size_t WT_G2 = WT_SK + (size_t)16 * 128 * 128;
constexpr size_t WT_W2T = WT_G2 + (size_t)512 * 128;
constexpr size_t WT_A2T = WT_W2T + 65536;
constexpr size_t WT_END = WT_A2T + 65536;
static_assert(WT_END * 2 <= 24 * MiB, "weights fit");

DI unsigned f2bf(float f) { unsigned u = __builtin_bit_cast(unsigned, f); return (u + 0x7fffu + ((u >> 16) & 1u)) >> 16; }
DI unsigned pk2(float lo, float hi) { return f2bf(lo) | (f2bf(hi) << 16); }
DI float bf2f(unsigned short b) { return __builtin_bit_cast(float, (unsigned)b << 16); }
DI float wave_sum(float v) {
#pragma unroll
    for (int o = 1; o < 64; o <<= 1) v += __shfl_xor(v, o);
    return v;
}
DI int tid_fresh() { int t = threadIdx.x; asm volatile("" : "+v"(t)); return t; }
DI float sigmoidf_(float x) { return __builtin_amdgcn_rcpf(1.f + __expf(-x)); }

#define XB_TMO      128
#define XB_XCNT(j)  (256  + 64 * (j))
#define XB_XSUB(j)  (1280 + 64 * (j))
#define XB_XGEN(j)  (2304 + 64 * (j))
#define XB_TOP      3328
#define XB_TOPGEN   3392
#define XCD_BAR_WORDS 3456
#define XB_SPIN_CAP (1u << 18)
DI unsigned xb_ld(unsigned* p)              { return __hip_atomic_load(p, __ATOMIC_RELAXED, __HIP_MEMORY_SCOPE_AGENT); }
DI unsigned xb_add(unsigned* p, unsigned v) { return __hip_atomic_fetch_add(p, v, __ATOMIC_RELAXED, __HIP_MEMORY_SCOPE_AGENT); }
DI unsigned xb_xcc_id() { return (unsigned)__builtin_amdgcn_s_getreg((3 << 11) | 20) & 0xFu; }
#define XB_SPIN(cond, bar) do { unsigned _sp = 0; while (cond) { __builtin_amdgcn_s_sleep(1); \
    if ((++_sp & 255u) == 0u) { if (xb_ld(&(bar)[XB_TMO])) break; if (_sp > XB_SPIN_CAP) { atomicAdd(&(bar)[XB_TMO], 1u); break; } } } } while (0)
struct XcdBarrier { unsigned* bar; unsigned x; volatile LAS unsigned* st; };
DI XcdBarrier xcd_barrier_post(unsigned* bar, volatile LAS unsigned* st) {
    XcdBarrier b; b.bar = bar; b.x = xb_xcc_id(); b.st = st;
    if (threadIdx.x == 0) (void)xb_add(&bar[XB_XCNT(b.x)], 1u);
    return b;
}
DI void xcd_barrier_complete(unsigned* bar, unsigned x, unsigned& nloc, unsigned& nx) {
    const unsigned G = gridDim.x * gridDim.y * gridDim.z;
    unsigned sum, cnt, mine, sp = 0u;
    for (;;) {
        sum = 0u; cnt = 0u; mine = 0u;
#pragma unroll
        for (unsigned j = 0; j < 16; ++j) { const unsigned c = xb_ld(&bar[XB_XCNT(j)]); sum += c; cnt += (c > 0u) ? 1u : 0u; mine = (j == x) ? c : mine; }
        if (sum == G) break;
        __builtin_amdgcn_s_sleep(1);
        if ((++sp & 255u) == 0u) { if (xb_ld(&bar[XB_TMO])) break; if (sp > XB_SPIN_CAP) { atomicAdd(&bar[XB_TMO], 1u); break; } }
    }
    nloc = mine > 0u ? mine : 1u; nx = cnt > 0u ? cnt : 1u;
}
DI void xcd_barrier(const XcdBarrier& b) {
    asm volatile("s_waitcnt vmcnt(0)" ::: "memory");
    __syncthreads();
    if (threadIdx.x == 0) {
        unsigned* bar = b.bar;
        __builtin_amdgcn_s_waitcnt(0);
        unsigned nloc = b.st[0], nx = b.st[1];
        if (nloc == 0u) { xcd_barrier_complete(bar, b.x, nloc, nx); b.st[0] = nloc; b.st[1] = nx; }
        const unsigned old = xb_add(&bar[XB_XSUB(b.x)], 1u);
        const unsigned gen = old / nloc;
        if (old + 1u == (gen + 1u) * nloc) {
            __builtin_amdgcn_fence(__ATOMIC_RELEASE, "agent");
            asm volatile("s_waitcnt vmcnt(0)" ::: "memory");
            const unsigned og = xb_add(&bar[XB_TOP], 1u);
            const unsigned tg = og / nx;
            if (og + 1u == (tg + 1u) * nx) xb_add(&bar[XB_TOPGEN], 1u);
            else XB_SPIN(xb_ld(&bar[XB_TOPGEN]) == tg, bar);
            __builtin_amdgcn_fence(__ATOMIC_ACQUIRE, "agent");
            xb_add(&bar[XB_XGEN(b.x)], 1u);
            asm volatile("s_waitcnt vmcnt(0)" ::: "memory");
        } else {
            XB_SPIN(xb_ld(&bar[XB_XGEN(b.x)]) == gen, bar);
            __builtin_amdgcn_fence(__ATOMIC_ACQUIRE, "agent");
            asm volatile("s_waitcnt vmcnt(0)" ::: "memory");
        }
    }
    __syncthreads();
}

struct Params { const float* in[32]; float* out; unsigned char* ws; };

constexpr int LDS_MISC = 157952;
constexpr int LDS_BYTES = 158208;

DI void transpose_item(const float* W, int ldw, int col_off, int K, bf16_t* WT, int ncols, LAS float* scr, int item, int lane, const float* ks = nullptr) {
    const int nblk = ncols / 32, kb = item / nblk, nb = item % nblk, k0 = 64 * kb, n0 = 32 * nb;
#pragma unroll 8
    for (int i = 0; i < 32; ++i) { const int kk = 2 * i + (lane >> 5); scr[kk * 33 + (lane & 31)] = W[(size_t)(k0 + kk) * ldw + col_off + n0 + (lane & 31)] * (ks ? ks[k0 + kk] : 1.f); }
    asm volatile("s_waitcnt lgkmcnt(0)" ::: "memory");
    const int c = lane & 7;
#pragma unroll
    for (int j = 0; j < 4; ++j) { const int n = (lane >> 3) + 8 * j; const LAS float* s = scr + (8 * c) * 33 + n;
        u32x4 o; o.x = pk2(s[0 * 33], s[1 * 33]); o.y = pk2(s[2 * 33], s[3 * 33]); o.z = pk2(s[4 * 33], s[5 * 33]); o.w = pk2(s[6 * 33], s[7 * 33]);
        *(u32x4*)(WT + (size_t)(n0 + n) * K + k0 + 8 * c) = o; }
    asm volatile("s_waitcnt lgkmcnt(0)" ::: "memory");
}
struct TrJob { const float* W; int ldw, col_off, K, ncols; bf16_t* WT; const float* ks; };
DI int trjob_items(const TrJob& j) { return (j.K / 64) * (j.ncols / 32); }

DI void rms_row_to_bf16(const float* xrow, const float* g, bf16_t* orow, int lane) {
    const f32x4* xr = (const f32x4*)xrow + lane; const f32x4* gr = (const f32x4*)g + lane;
    f32x4 v[4]; float s = 0.f;
#pragma unroll
    for (int j = 0; j < 4; ++j) { v[j] = xr[64 * j]; s += (v[j].x * v[j].x + v[j].y * v[j].y) + (v[j].z * v[j].z + v[j].w * v[j].w); }
    const float r = 1.f / sqrtf(wave_sum(s) * (1.f / D) + NORM_EPS);
    unsigned long long* o8 = (unsigned long long*)orow + lane;
#pragma unroll
    for (int j = 0; j < 4; ++j) { const f32x4 gg = gr[64 * j];
        o8[64 * j] = (unsigned long long)pk2(v[j].x * r * gg.x, v[j].y * r * gg.y) | ((unsigned long long)pk2(v[j].z * r * gg.z, v[j].w * r * gg.w) << 32); }
}
DI void rms_row_to_f32(const float* xrow, const float* g, float* orow, int lane) {
    const f32x4* xr = (const f32x4*)xrow + lane; const f32x4* gr = (const f32x4*)g + lane;
    f32x4 v[4]; float s = 0.f;
#pragma unroll
    for (int j = 0; j < 4; ++j) { v[j] = xr[64 * j]; s += (v[j].x * v[j].x + v[j].y * v[j].y) + (v[j].z * v[j].z + v[j].w * v[j].w); }
    const float r = 1.f / sqrtf(wave_sum(s) * (1.f / D) + NORM_EPS);
    f32x4* o = (f32x4*)orow + lane;
#pragma unroll
    for (int j = 0; j < 4; ++j) { const f32x4 gg = gr[64 * j]; o[64 * j] = (f32x4){v[j].x * r * gg.x, v[j].y * r * gg.y, v[j].z * r * gg.z, v[j].w * r * gg.w}; }
}

struct GemmSrc { const bf16_t* A; int lda; const bf16_t* Bt; int ldb; int K; };
constexpr int G_BM = 256, G_BN = 128, G_BK = 64, G_STAGE = 49152;
#define GEMM_BAR() do { asm volatile("s_waitcnt lgkmcnt(0)" ::: "memory"); __builtin_amdgcn_s_barrier(); asm volatile("" ::: "memory"); } while (0)
template <bool SWAP = true, bool SSQ = false>
DI void gemm_accum_(f32x4 (&acc)[4][4], const GemmSrc s, int row0, int col0, LAS unsigned char* lds, f32x4& ssv) {
    const int tid = tid_fresh(), lane = tid & 63, wid = __builtin_amdgcn_readfirstlane(tid >> 6), wr = wid >> 1, wc = wid & 1, fr = lane & 15, fq = lane >> 4;
    const int nt = s.K / G_BK;
    const int prow = lane >> 3, pch = ((lane & 7) ^ prow) * 8;
    const bf16_t* src[6]; int dst[6];
#pragma unroll
    for (int q = 0; q < 6; ++q) { const int piece = wid * 6 + q;
        src[q] = (piece < 32) ? s.A + (size_t)(row0 + piece * 8 + prow) * s.lda + pch : s.Bt + (size_t)(col0 + (piece - 32) * 8 + prow) * s.ldb + pch;
        dst[q] = (piece < 32) ? piece * 1024 : 32768 + (piece - 32) * 1024; }
#define GEMM_ISSUE(t_, stg_) do { _Pragma("unroll") for (int q = 0; q < 6; ++q) \
        __builtin_amdgcn_global_load_lds((const unsigned*)(src[q] + (t_) * G_BK), (LAS unsigned*)(lds + (stg_) * G_STAGE + dst[q]), 16, 0, 0); } while (0)
    GEMM_ISSUE(0, 0);
    if (nt > 1) { GEMM_ISSUE(1, 1); asm volatile("s_waitcnt vmcnt(6)" ::: "memory"); } else asm volatile("s_waitcnt vmcnt(0)" ::: "memory");
    GEMM_BAR();
    const int aoff = (wr * 64 + fr) * 128, boff = 32768 + (wc * 64 + fr) * 128;
    int sc = 0, sn = 2;
#pragma unroll 1
    for (int t = 0; t < nt; ++t) {
        const LAS unsigned char* cur = lds + sc * G_STAGE;
#pragma unroll
        for (int kk = 0; kk < 2; ++kk) {
            const int ch = ((kk * 4 + fq) ^ (fr & 7)) << 4;
            bf16x8 a[4], b[4];
#pragma unroll
            for (int m = 0; m < 4; ++m) a[m] = *(const LAS bf16x8*)(cur + aoff + m * 2048 + ch);
#pragma unroll
            for (int n = 0; n < 4; ++n) b[n] = *(const LAS bf16x8*)(cur + boff + n * 2048 + ch);
            if constexpr (SSQ) {
#pragma unroll
                for (int m = 0; m < 4; ++m) { const u32x4 w = __builtin_bit_cast(u32x4, a[m]);
#pragma unroll
                    for (int j = 0; j < 4; ++j) { const float lo = __builtin_bit_cast(float, w[j] << 16), hi = __builtin_bit_cast(float, w[j] & 0xffff0000u); ssv[m] += lo * lo + hi * hi; } }
            }
#pragma unroll
            for (int m = 0; m < 4; ++m)
#pragma unroll
                for (int n = 0; n < 4; ++n) acc[m][n] = SWAP ? __builtin_amdgcn_mfma_f32_16x16x32_bf16(b[n], a[m], acc[m][n], 0, 0, 0)
                                                        : __builtin_amdgcn_mfma_f32_16x16x32_bf16(a[m], b[n], acc[m][n], 0, 0, 0);
        }
        if (t + 2 < nt) { GEMM_ISSUE(t + 2, sn); asm volatile("s_waitcnt vmcnt(6)" ::: "memory"); } else asm volatile("s_waitcnt vmcnt(0)" ::: "memory");
        GEMM_BAR();
        sc = (sc == 2) ? 0 : sc + 1; sn = (sn == 2) ? 0 : sn + 1;
    }
#undef GEMM_ISSUE
}
template <bool SWAP = true>
DI void gemm_accum(f32x4 (&acc)[4][4], const GemmSrc s, int row0, int col0, LAS unsigned char* lds) { f32x4 dummy; gemm_accum_<SWAP, false>(acc, s, row0, col0, lds, dummy); }
DI void acc_zero(f32x4 (&acc)[4][4]) {
#pragma unroll
    for (int m = 0; m < 4; ++m)
#pragma unroll
        for (int n = 0; n < 4; ++n) acc[m][n] = (f32x4){0.f, 0.f, 0.f, 0.f};
}
#define EPI_LOOP(row0, col0) \
    const int _tid = tid_fresh(); const int _lane = _tid & 63, _wid = _tid >> 6, _wr = _wid >> 1, _wc = _wid & 1, _fr = _lane & 15, _fq = _lane >> 4; \
    _Pragma("unroll") for (int m = 0; m < 4; ++m) _Pragma("unroll") for (int n = 0; n < 4; ++n)
#define EPI_ROW(row0) ((row0) + _wr * 64 + m * 16 + _fr)
#define EPI_COL(col0) ((col0) + _wc * 64 + n * 16 + 4 * _fq)


constexpr int PEER_H = 8, PEER_K = 16;
struct ScEnt { float v; int i; };
DI float gelu_erf(float x) { return 0.5f * x * (1.f + erff(x * 0.70710678118654752f)); }

DI void ce_desc(unsigned& a, unsigned& b) { const unsigned hi = a > b ? a : b, lo = a > b ? b : a; a = hi; b = lo; }
DI void bitonic_merge16_desc(unsigned (&k)[16]) {
#pragma unroll
    for (int st = 8; st > 0; st >>= 1)
#pragma unroll
        for (int i = 0; i < 16; ++i) if ((i & st) == 0) ce_desc(k[i], k[i | st]);
}
DI void bitonic_sort16_desc(unsigned (&k)[16]) {
#pragma unroll
    for (int size = 2; size <= 16; size <<= 1)
#pragma unroll
        for (int st = size >> 1; st > 0; st >>= 1)
#pragma unroll
            for (int i = 0; i < 16; ++i) if ((i & st) == 0) { if ((i & size) == 0 || size == 16) ce_desc(k[i], k[i | st]); else ce_desc(k[i | st], k[i]); }
}
DI void top16_merge(unsigned (&a)[16], const unsigned (&b)[16]) {
#pragma unroll
    for (int i = 0; i < 16; ++i) a[i] = a[i] > b[15 - i] ? a[i] : b[15 - i];
    bitonic_merge16_desc(a);
}
DI unsigned score_key(float f, int idx) { const unsigned u = __builtin_bit_cast(unsigned, f); const unsigned m = (u & 0x80000000u) ? ~u : (u | 0x80000000u); return (m & ~127u) | (unsigned)(127 - idx); }
DI float key_score(unsigned key) { const unsigned k = key & ~127u; return __builtin_bit_cast(float, (k & 0x80000000u) ? (k & 0x7fffffffu) : ~k); }
DI float ssq16(const float* P16, int row) { float q = 0.f;
#pragma unroll
    for (int k = 0; k < 16; ++k) q += P16[(size_t)k * T + row];
    return q; }
DI void peer_query_tile(const bf16_t* Hb, const bf16_t* WTpq, const bf16_t* SK, const float* SSQ, ScEnt* SC, int pm, int pn, LAS unsigned char* lds) {
    const int tid = tid_fresh(), lane = tid & 63, wid = tid >> 6, wr = wid >> 1, wc = wid & 1, fr = lane & 15, fq = lane >> 4;
    const int row0 = pm * G_BM, col0 = pn * G_BN;
    f32x4 acc[4][4]; acc_zero(acc);
    gemm_accum(acc, GemmSrc{Hb, D, WTpq, D, D}, row0, col0, lds);
#pragma unroll
    for (int m = 0; m < 4; ++m)
#pragma unroll
        for (int n = 0; n < 4; ++n) {
            const int r = wr * 64 + m * 16 + fr, c = wc * 64 + n * 16 + 4 * fq;
            const int kt = c >> 6, ch = (c & 63) >> 3;
            *(LAS u32x2*)(lds + kt * 32768 + r * 128 + ((ch ^ (r & 7)) << 4) + (c & 7) * 2) = (u32x2){pk2(acc[m][n][0], acc[m][n][1]), pk2(acc[m][n][2], acc[m][n][3])};
        }
    {
        const bf16_t* sk = SK + (size_t)pn * 128 * 128;
#pragma unroll
        for (int i = 0; i < 4; ++i) { const int id = tid + i * 512, r = id >> 4, c16 = id & 15, kt = c16 >> 3, ch = c16 & 7;
            *(LAS u32x4*)(lds + 65536 + kt * 16384 + r * 128 + ((ch ^ (r & 7)) << 4)) = *(const u32x4*)(sk + (size_t)r * 128 + c16 * 8); }
    }
    __syncthreads();
    acc_zero(acc);
#pragma unroll
    for (int kt = 0; kt < 2; ++kt)
#pragma unroll
        for (int kk = 0; kk < 2; ++kk) {
            const int ch = ((kk * 4 + fq) ^ (fr & 7)) << 4;
            bf16x8 a[4], b[4];
#pragma unroll
            for (int m = 0; m < 4; ++m) a[m] = *(const LAS bf16x8*)(lds + kt * 32768 + (wr * 64 + m * 16 + fr) * 128 + ch);
#pragma unroll
            for (int n = 0; n < 4; ++n) b[n] = *(const LAS bf16x8*)(lds + 65536 + kt * 16384 + (wc * 64 + n * 16 + fr) * 128 + ch);
#pragma unroll
            for (int m = 0; m < 4; ++m)
#pragma unroll
                for (int n = 0; n < 4; ++n) acc[m][n] = __builtin_amdgcn_mfma_f32_16x16x32_bf16(b[n], a[m], acc[m][n], 0, 0, 0);
        }
    __syncthreads();
    LAS float* SS = (LAS float*)lds;
#pragma unroll
    for (int m = 0; m < 4; ++m)
#pragma unroll
        for (int n = 0; n < 4; ++n) {
            const int r = wr * 64 + m * 16 + fr, c = wc * 64 + n * 16 + 4 * fq;
            const float irms = __builtin_amdgcn_rsqf(ssq16(SSQ, row0 + r) * (1.f / D) + NORM_EPS);
#pragma unroll
            for (int j = 0; j < 4; ++j) SS[r * 129 + c + j] = acc[m][n][j] * irms;
        }
    __syncthreads();
    const int trow = tid & 255, half = tid >> 8;
    unsigned best[16];
#pragma unroll
    for (int g = 0; g < 4; ++g) {
        unsigned k[16];
#pragma unroll
        for (int i = 0; i < 16; ++i) k[i] = score_key(SS[trow * 129 + half * 64 + g * 16 + i], half * 64 + g * 16 + i);
        bitonic_sort16_desc(k);
        if (g == 0) {
#pragma unroll
            for (int i = 0; i < 16; ++i) best[i] = k[i];
        } else top16_merge(best, k);
    }
    __syncthreads();
    LAS unsigned* LK = (LAS unsigned*)lds;
#pragma unroll
    for (int i = 0; i < 16; i += 4) *(LAS u32x4*)(LK + (trow * 2 + half) * 16 + i) = (u32x4){best[i], best[i + 1], best[i + 2], best[i + 3]};
    __syncthreads();
    if (half == 0) {
        unsigned oth[16];
#pragma unroll
        for (int i = 0; i < 16; i += 4) { const u32x4 t = *(const LAS u32x4*)(LK + (trow * 2 + 1) * 16 + i); oth[i] = t[0]; oth[i + 1] = t[1]; oth[i + 2] = t[2]; oth[i + 3] = t[3]; }
        top16_merge(best, oth);
        ScEnt* dst = SC + ((size_t)(row0 + trow) * 16 + pn) * 16;
#pragma unroll
        for (int r = 0; r < 16; r += 2) { u32x4 o; o[0] = __builtin_bit_cast(unsigned, key_score(best[r])); o[1] = 127u - (best[r] & 127u);
            o[2] = __builtin_bit_cast(unsigned, key_score(best[r + 1])); o[3] = 127u - (best[r + 1] & 127u); *(u32x4*)(dst + r) = o; }
    }
    __syncthreads();
}

typedef __bf16 bf16x2p __attribute__((ext_vector_type(2)));
DI float dot2bf(unsigned a, unsigned b, float acc) { return __builtin_amdgcn_fdot2_f32_bf16(__builtin_bit_cast(bf16x2p, a), __builtin_bit_cast(bf16x2p, b), acc, false); }
DI float reduce8(const float (&d)[8], int lane) {
    const bool h32 = (lane & 32) != 0, h16 = (lane & 16) != 0, h8 = (lane & 8) != 0;
    float a[4], b[2], c;
#pragma unroll
    for (int i = 0; i < 4; ++i) { const float snd = h32 ? d[i] : d[4 + i]; const float rcv = __shfl_xor(snd, 32); a[i] = (h32 ? d[4 + i] : d[i]) + rcv; }
#pragma unroll
    for (int i = 0; i < 2; ++i) { const float snd = h16 ? a[i] : a[2 + i]; const float rcv = __shfl_xor(snd, 16); b[i] = (h16 ? a[2 + i] : a[i]) + rcv; }
    { const float snd = h8 ? b[0] : b[1]; const float rcv = __shfl_xor(snd, 8); c = (h8 ? b[1] : b[0]) + rcv; }
    c += __shfl_xor(c, 4); c += __shfl_xor(c, 2); c += __shfl_xor(c, 1);
    return c;
}
struct PeerTab { const unsigned char* U8; const unsigned char* V8; const float* su; const float* sv; };
DI void peer_load_group(const unsigned char* T8, int eslot, int g7, u32x4 (&rows)[8], int lane) {
#pragma unroll
    for (int j = 0; j < 8; ++j) { const int id = __shfl(eslot, g7 * 8 + j); rows[j] = *(const u32x4*)(T8 + (size_t)id * D + lane * 16); }
    __builtin_amdgcn_sched_barrier(0x4);
}
DI float peer_u_consume(const u32x4 (&ua)[8], float suslot, float svslot, float gslot, int g7, const float (&h)[16], int lane) {
    float dd[8];
#pragma unroll
    for (int j = 0; j < 8; ++j) { float a = 0.f, b = 0.f;
#pragma unroll
        for (int q = 0; q < 4; ++q) { const f32x2 lo = __builtin_amdgcn_cvt_pk_f32_fp8((int)ua[j][q], false), hi = __builtin_amdgcn_cvt_pk_f32_fp8((int)ua[j][q], true);
            a += lo.x * h[4 * q] + lo.y * h[4 * q + 1]; b += hi.x * h[4 * q + 2] + hi.y * h[4 * q + 3]; }
        dd[j] = a + b; }
    const float tot = reduce8(dd, lane);
    const int src = g7 * 8 + (lane >> 3);
    const float gt_ = __shfl(gslot, src), su_ = __shfl(suslot, src), sv_ = __shfl(svslot, src);
    return gt_ * gelu_erf(tot * su_) * sv_;
}
DI void peer_v_consume(const u32x4 (&va)[8], float cslot, int g7, float (&o)[16], int lane) {
#pragma unroll
    for (int j = 0; j < 8; ++j) { const float cf = __shfl(cslot, g7 * 8 + j);
#pragma unroll
        for (int q = 0; q < 4; ++q) { const f32x2 lo = __builtin_amdgcn_cvt_pk_f32_fp8((int)va[j][q], false), hi = __builtin_amdgcn_cvt_pk_f32_fp8((int)va[j][q], true);
            o[4 * q] += cf * lo.x; o[4 * q + 1] += cf * lo.y; o[4 * q + 2] += cf * hi.x; o[4 * q + 3] += cf * hi.y; } }
}
constexpr size_t PEER_SLICE_B = (size_t)16384 * 128;
DI void row_to_fp8(const float* src, unsigned char* dst, float* inv_scale, int lane) {
    const f32x4* xr = (const f32x4*)src + lane;
    f32x4 v[4]; float am = 0.f;
#pragma unroll
    for (int j = 0; j < 4; ++j) { v[j] = xr[64 * j]; am = fmaxf(am, fmaxf(fmaxf(fabsf(v[j].x), fabsf(v[j].y)), fmaxf(fabsf(v[j].z), fabsf(v[j].w)))); }
#pragma unroll
    for (int o = 1; o < 64; o <<= 1) am = fmaxf(am, __shfl_xor(am, o));
    am = fmaxf(am, 1e-20f);
    const float sc = 256.f / am;
#pragma unroll
    for (int j = 0; j < 4; ++j) { int t = 0; t = __builtin_amdgcn_cvt_pk_fp8_f32(v[j].x * sc, v[j].y * sc, t, false); t = __builtin_amdgcn_cvt_pk_fp8_f32(v[j].z * sc, v[j].w * sc, t, true);
        *(unsigned*)(dst + (size_t)(2 * j + (lane >> 5)) * PEER_SLICE_B + 4 * (lane & 31)) = (unsigned)t; }
    if (lane == 0) *inv_scale = am * (1.f / 256.f);
}
DI void peer_token(const float* x1row, float* x2row, bf16_t* hrow, const ScEnt* SCt, const PeerTab& tb, const float* g_ple, float irms, int lane) {
    int ci = 0, st = 0;
    { const int th[15] = {16, 24, 29, 33, 36, 38, 40, 42, 43, 44, 45, 46, 47, 48, 49};
#pragma unroll
      for (int k = 0; k < 15; ++k) { const bool ge = lane >= th[k]; ci += ge ? 1 : 0; st = ge ? th[k] : st; } }
    const int cj = lane - st;
    int es0 = 0, es1 = 0; float gs0 = 0.f, gs1 = 0.f;
#pragma unroll 1
    for (int hd = 0; hd < PEER_H; ++hd) {
        const ScEnt* L0 = SCt + (hd * 2) * 16; const ScEnt* L1 = SCt + (hd * 2 + 1) * 16;
        float v = -INFINITY; int p = 1024 + lane;
        if (lane < 50) { v = L0[ci].v + L1[cj].v; p = ci * 16 + cj; }
#pragma unroll
        for (int k = 2; k <= 64; k <<= 1)
#pragma unroll
            for (int j = k >> 1; j > 0; j >>= 1) {
                const float ov = __shfl_xor(v, j); const int op = __shfl_xor(p, j);
                const bool lower = (lane & j) == 0, desc = (lane & k) == 0 || k == 64;
                const bool og = (ov > v) || (ov == v && op < p);
                const bool sw = (lower == desc) ? og : !og;
                v = sw ? ov : v; p = sw ? op : p;
            }
        const float mx = __shfl(v, 0);
        const float e = (lane < 16) ? __expf(v - mx) : 0.f;
        const float gate = e / wave_sum(e);
        int eidx = 0;
        if (lane < 16) eidx = L0[p >> 4].i * 128 + L1[p & 15].i;
        const int te = __shfl(eidx, lane & 15); const float tg = __shfl(gate, lane & 15);
        if ((lane >> 4) == (hd & 3)) { if (hd < 4) { es0 = te; gs0 = tg; } else { es1 = te; gs1 = tg; } }
    }
    float h[16];
    { const u32x4 ha = *(const u32x4*)(hrow + lane * 16), hb = *(const u32x4*)(hrow + lane * 16 + 8);
#pragma unroll
      for (int j = 0; j < 4; ++j) { h[2 * j] = __builtin_bit_cast(float, ha[j] << 16); h[2 * j + 1] = __builtin_bit_cast(float, ha[j] & 0xffff0000u); h[8 + 2 * j] = __builtin_bit_cast(float, hb[j] << 16); h[8 + 2 * j + 1] = __builtin_bit_cast(float, hb[j] & 0xffff0000u); }
#pragma unroll
      for (int j = 0; j < 16; ++j) h[j] *= irms; }
    const float sus0 = tb.su[es0], svs0 = tb.sv[es0], sus1 = tb.su[es1], svs1 = tb.sv[es1];
    float cs0 = 0.f, cs1 = 0.f;
    float o[16];
#pragma unroll
    for (int j = 0; j < 16; ++j) o[j] = 0.f;
    {
        u32x4 ra[8], rb[8];
        peer_load_group(tb.U8, es0, 0, ra, lane);
#define PEER_PUT(cs, gg, cf) do { const float tmp_ = __shfl(cf, (lane & 7) * 8); if ((lane >> 3) == (gg)) cs = tmp_; } while (0)
#pragma unroll 1
        for (int g = 0; g < 8; g += 2) {
            peer_load_group(tb.U8, es0, g + 1, rb, lane);
            { const float cf = peer_u_consume(ra, sus0, svs0, gs0, g, h, lane); PEER_PUT(cs0, g, cf); }
            peer_load_group(tb.U8, g + 2 < 8 ? es0 : es1, (g + 2) & 7, ra, lane);
            { const float cf = peer_u_consume(rb, sus0, svs0, gs0, g + 1, h, lane); PEER_PUT(cs0, g + 1, cf); }
        }
#pragma unroll 1
        for (int g = 0; g < 8; g += 2) {
            peer_load_group(tb.U8, es1, g + 1, rb, lane);
            { const float cf = peer_u_consume(ra, sus1, svs1, gs1, g, h, lane); PEER_PUT(cs1, g, cf); }
            peer_load_group(g + 2 < 8 ? tb.U8 : tb.V8, g + 2 < 8 ? es1 : es0, (g + 2) & 7, ra, lane);
            { const float cf = peer_u_consume(rb, sus1, svs1, gs1, g + 1, h, lane); PEER_PUT(cs1, g + 1, cf); }
        }
#pragma unroll 1
        for (int g = 0; g < 8; g += 2) {
            peer_load_group(tb.V8, es0, g + 1, rb, lane);
            peer_v_consume(ra, cs0, g, o, lane);
            peer_load_group(tb.V8, g + 2 < 8 ? es0 : es1, (g + 2) & 7, ra, lane);
            peer_v_consume(rb, cs0, g + 1, o, lane);
        }
#pragma unroll 1
        for (int g = 0; g < 8; g += 2) {
            peer_load_group(tb.V8, es1, g + 1, rb, lane);
            peer_v_consume(ra, cs1, g, o, lane);
            if (g + 2 < 8) peer_load_group(tb.V8, es1, g + 2, ra, lane);
            peer_v_consume(rb, cs1, g + 1, o, lane);
        }
#undef PEER_PUT
    }
    float ss = 0.f;
#pragma unroll
    for (int j = 0; j < 4; ++j) { const f32x4 xv = *(const f32x4*)(x1row + lane * 16 + 4 * j);
        o[4 * j] += xv.x; o[4 * j + 1] += xv.y; o[4 * j + 2] += xv.z; o[4 * j + 3] += xv.w;
        *(f32x4*)(x2row + lane * 16 + 4 * j) = (f32x4){o[4 * j], o[4 * j + 1], o[4 * j + 2], o[4 * j + 3]};
        ss += o[4 * j] * o[4 * j] + o[4 * j + 1] * o[4 * j + 1] + o[4 * j + 2] * o[4 * j + 2] + o[4 * j + 3] * o[4 * j + 3]; }
    const float rr = 1.f / sqrtf(wave_sum(ss) * (1.f / D) + NORM_EPS);
    u32x4 w0, w1;
#pragma unroll
    for (int j = 0; j < 4; ++j) { const f32x4 g0 = *(const f32x4*)(g_ple + lane * 16 + 4 * j);
        const unsigned lo = pk2(o[4 * j] * rr * g0.x, o[4 * j + 1] * rr * g0.y), hi = pk2(o[4 * j + 2] * rr * g0.z, o[4 * j + 3] * rr * g0.w);
        if (j < 2) { w0[2 * j] = lo; w0[2 * j + 1] = hi; } else { w1[2 * (j - 2)] = lo; w1[2 * (j - 2) + 1] = hi; } }
    *(u32x4*)(hrow + lane * 16) = w0; *(u32x4*)(hrow + lane * 16 + 8) = w1;
}


DI void peer_route_cand(int lane, int& ci, int& cj) {
    int c_ = 0, st = 0;
    { const int th[15] = {16, 24, 29, 33, 36, 38, 40, 42, 43, 44, 45, 46, 47, 48, 49};
#pragma unroll
      for (int k = 0; k < 15; ++k) { const bool ge = lane >= th[k]; c_ += ge ? 1 : 0; st = ge ? th[k] : st; } }
    ci = c_; cj = lane - st;
}
DI void peer_route_load(const ScEnt* SCt, int ci, int cj, u32x2 (&l0)[8], u32x2 (&l1)[8]) {
#pragma unroll
    for (int hd = 0; hd < 8; ++hd) { l0[hd] = *(const u32x2*)(SCt + hd * 32 + ci); l1[hd] = *(const u32x2*)(SCt + hd * 32 + 16 + cj); }
    __builtin_amdgcn_sched_barrier(0x4);
}
DI void peer_route_compute(const u32x2 (&l0)[8], const u32x2 (&l1)[8], int* ELt, float* GTt, int lane) {
    int es0 = 0, es1 = 0; float gs0 = 0.f, gs1 = 0.f;
#pragma unroll
    for (int h4 = 0; h4 < 8; h4 += 4) {
        float v[4]; unsigned key[4]; int rank[4];
#pragma unroll
        for (int u = 0; u < 4; ++u) { const float vs = __builtin_bit_cast(float, l0[h4 + u].x) + __builtin_bit_cast(float, l1[h4 + u].x); v[u] = lane < 50 ? vs : -INFINITY;
            const unsigned x = __builtin_bit_cast(unsigned, v[u]); const unsigned k = x ^ ((unsigned)((int)x >> 31) | 0x80000000u);
            key[u] = (k & ~63u) | (unsigned)(63 - lane); rank[u] = 0; }
#pragma unroll
        for (int c = 0; c < 50; ++c) {
            unsigned s0, s1, s2, s3;
            asm volatile("v_readlane_b32 %4, %8, %12\n\tv_readlane_b32 %5, %9, %12\n\tv_readlane_b32 %6, %10, %12\n\tv_readlane_b32 %7, %11, %12\n\t"
                         "v_cmp_gt_u32 vcc, %4, %8\n\tv_addc_co_u32 %0, vcc, 0, %0, vcc\n\t"
                         "v_cmp_gt_u32 vcc, %5, %9\n\tv_addc_co_u32 %1, vcc, 0, %1, vcc\n\t"
                         "v_cmp_gt_u32 vcc, %6, %10\n\tv_addc_co_u32 %2, vcc, 0, %2, vcc\n\t"
                         "v_cmp_gt_u32 vcc, %7, %11\n\tv_addc_co_u32 %3, vcc, 0, %3, vcc"
                         : "+v"(rank[0]), "+v"(rank[1]), "+v"(rank[2]), "+v"(rank[3]), "=&s"(s0), "=&s"(s1), "=&s"(s2), "=&s"(s3)
                         : "v"(key[0]), "v"(key[1]), "v"(key[2]), "v"(key[3]), "i"(c) : "vcc");
        }
#pragma unroll
        for (int u = 0; u < 4; ++u) {
            const int eidx = (int)l0[h4 + u].y * 128 + (int)l1[h4 + u].y;
            const float mx = __builtin_bit_cast(float, __builtin_amdgcn_readlane(__builtin_bit_cast(int, v[u]), 0));
            const float e = rank[u] < 16 ? __expf(v[u] - mx) : 0.f;
            const float gate = e / wave_sum(e);
            const int dst = (rank[u] < 16 ? u * 16 + rank[u] : (u ^ 1) * 16) * 4;
            const int te = __builtin_amdgcn_ds_permute(dst, eidx); const float tg = __builtin_bit_cast(float, __builtin_amdgcn_ds_permute(dst, __builtin_bit_cast(int, gate)));
            if ((lane >> 4) == u) { if (h4 == 0) { es0 = te; gs0 = tg; } else { es1 = te; gs1 = tg; } }
        }
    }
    ELt[lane] = es0; ELt[64 + lane] = es1; GTt[lane] = gs0; GTt[64 + lane] = gs1;
}
DI constexpr int cand_ci(int c) { const int th[15] = {16, 24, 29, 33, 36, 38, 40, 42, 43, 44, 45, 46, 47, 48, 49}; int ci = 0; for (int k = 0; k < 15; ++k) if (c >= th[k]) ci = k + 1; return ci; }
DI constexpr int cand_cj(int c) { const int st[16] = {0, 16, 24, 29, 33, 36, 38, 40, 42, 43, 44, 45, 46, 47, 48, 49}; return c - st[cand_ci(c)]; }
DI void peer_route_pair(const LAS u32x4* SCq, LAS int* ELq, LAS float* GTq) {
    u32x4 raw[16];
#pragma unroll
    for (int k = 0; k < 16; ++k) raw[k] = SCq[k];
    asm volatile("s_waitcnt lgkmcnt(0)" : "+v"(raw[0]), "+v"(raw[1]), "+v"(raw[2]), "+v"(raw[3]), "+v"(raw[4]), "+v"(raw[5]), "+v"(raw[6]), "+v"(raw[7]) :: "memory");
    asm volatile("" : "+v"(raw[8]), "+v"(raw[9]), "+v"(raw[10]), "+v"(raw[11]), "+v"(raw[12]), "+v"(raw[13]), "+v"(raw[14]), "+v"(raw[15]) :: "memory");
    __builtin_amdgcn_wave_barrier();
    float v[50]; int L[50];
#pragma unroll
    for (int c = 0; c < 50; ++c) { constexpr int dummy = 0; (void)dummy;
        const int ci = cand_ci(c), cj = cand_cj(c);
        const float a = __builtin_bit_cast(float, (ci & 1) ? raw[ci >> 1].z : raw[ci >> 1].x), b = __builtin_bit_cast(float, (cj & 1) ? raw[8 + (cj >> 1)].z : raw[8 + (cj >> 1)].x);
        v[c] = a + b; L[c] = (ci + 1) * (cj + 1) - 1; }
#pragma unroll
    for (int a = 0; a < 50; ++a) {
        int W = 0, nl = 0;
#pragma unroll
        for (int b = a + 1; b < 50; ++b) {
            if (cand_ci(a) <= cand_ci(b) && cand_cj(a) <= cand_cj(b)) continue;
            const int ge = v[a] >= v[b] ? 1 : 0;
            L[b] += ge; W += ge; ++nl;
        }
        L[a] += nl - W;
    }
    const float mx = v[0];
    float sum = 0.f;
#pragma unroll
    for (int c = 0; c < 50; ++c) { v[c] = L[c] < 16 ? __expf(v[c] - mx) : 0.f; sum += v[c]; }
    const float inv = 1.f / sum;
#pragma unroll
    for (int c = 0; c < 50; ++c) {
        const int ci = cand_ci(c), cj = cand_cj(c);
        if (L[c] < 16) {
            const int i0 = (int)((ci & 1) ? raw[ci >> 1].w : raw[ci >> 1].y), i1 = (int)((cj & 1) ? raw[8 + (cj >> 1)].w : raw[8 + (cj >> 1)].y);
            ELq[L[c]] = i0 * 128 + i1; GTq[L[c]] = v[c] * inv;
        }
    }
}
constexpr size_t PEER_SLICE = (size_t)16384 * 128;
DI void psl_ids(const int* ELt, int g, u32x4 (&id)[4]) {
#pragma unroll
    for (int q = 0; q < 4; ++q) id[q] = *(const u32x4*)(ELt + 16 * g + 4 * q);
    __builtin_amdgcn_sched_barrier(0x4);
}
DI void psl_rows(const unsigned char* sl, const u32x4 (&id)[4], int i, u32x4 (&rows)[16]) {
#pragma unroll
    for (int k = 0; k < 16; ++k) rows[k] = *(const u32x4*)(sl + (size_t)id[k >> 2][k & 3] * 128 + i * 16);
    __builtin_amdgcn_sched_barrier(0x4);
}
DI void psl_u_consume(const u32x4 (&rows)[16], const u32x4 (&hraw)[2], float* Pt, int lane, bool valid) {
    f32x2 hp[8];
#pragma unroll
    for (int j = 0; j < 4; ++j) { hp[j] = (f32x2){__builtin_bit_cast(float, hraw[0][j] << 16), __builtin_bit_cast(float, hraw[0][j] & 0xffff0000u)};
                                  hp[4 + j] = (f32x2){__builtin_bit_cast(float, hraw[1][j] << 16), __builtin_bit_cast(float, hraw[1][j] & 0xffff0000u)}; }
    float d[16];
#pragma unroll
    for (int k = 0; k < 16; ++k) { f32x2 a = (f32x2){0.f, 0.f};
#pragma unroll
        for (int q = 0; q < 4; ++q) { const f32x2 lo = __builtin_amdgcn_cvt_pk_f32_fp8((int)rows[k][q], false), hi = __builtin_amdgcn_cvt_pk_f32_fp8((int)rows[k][q], true);
            a += lo * hp[2 * q]; a += hi * hp[2 * q + 1]; }
        d[k] = a.x + a.y; }
    const bool s4 = (lane & 4) != 0, s2 = (lane & 2) != 0, s1 = (lane & 1) != 0;
    float a[8], b[4], c[2];
#pragma unroll
    for (int j = 0; j < 8; ++j) { const float snd = s4 ? d[j] : d[8 + j]; const float rcv = __shfl_xor(snd, 4); a[j] = (s4 ? d[8 + j] : d[j]) + rcv; }
#pragma unroll
    for (int j = 0; j < 4; ++j) { const float snd = s2 ? a[j] : a[4 + j]; const float rcv = __shfl_xor(snd, 2); b[j] = (s2 ? a[4 + j] : a[j]) + rcv; }
#pragma unroll
    for (int j = 0; j < 2; ++j) { const float snd = s1 ? b[j] : b[2 + j]; const float rcv = __shfl_xor(snd, 1); c[j] = (s1 ? b[2 + j] : b[j]) + rcv; }
    if (valid) *(f32x2*)(Pt + 2 * lane) = (f32x2){c[0], c[1]};
}
DI void peer_gu_slice(const int* EL, const bf16_t* Hb, const unsigned char* sl, float* Px, int x, int w0, int nw, int lane) {
    const int g = lane >> 3, i = lane & 7;
    const int cnt = (T - w0 + nw - 1) / nw;
    if (w0 >= T) return;
#define PSL_TOK(n_) ({ const int t_ = w0 + (n_) * nw; t_ < T ? t_ : T - 1; })
#define PSL_H(hv_, t_) do { const bf16_t* hp_ = Hb + (size_t)(t_) * D + x * 128 + i * 16; hv_[0] = *(const u32x4*)hp_; hv_[1] = *(const u32x4*)(hp_ + 8); } while (0)
    u32x4 ia[4], ib[4], ra[16], rb[16], ha[2], hb[2];
    psl_ids(EL + (size_t)PSL_TOK(0) * 128, g, ia);
    psl_ids(EL + (size_t)PSL_TOK(1) * 128, g, ib);
    PSL_H(ha, PSL_TOK(0)); psl_rows(sl, ia, i, ra);
#pragma unroll 1
    for (int n = 0; n < cnt; n += 2) {
        const int t0 = PSL_TOK(n), t1 = PSL_TOK(n + 1), t2 = PSL_TOK(n + 2), t3 = PSL_TOK(n + 3);
        psl_ids(EL + (size_t)t2 * 128, g, ia);
        PSL_H(hb, t1); psl_rows(sl, ib, i, rb);
        psl_u_consume(ra, ha, Px + (size_t)t0 * 128, lane, true);
        psl_ids(EL + (size_t)t3 * 128, g, ib);
        PSL_H(ha, t2); psl_rows(sl, ia, i, ra);
        psl_u_consume(rb, hb, Px + (size_t)t1 * 128, lane, n + 1 < cnt);
    }
#undef PSL_H
}
DI void psl_v_consume(const u32x4 (&rows)[16], const u32x4 (&cw)[4], f32x2 x1v, float* xrow, bf16_t* hrow, f32x2 gp, float* ssq, int lane, bool valid) {
    f32x2 o[8];
#pragma unroll
    for (int q = 0; q < 8; ++q) o[q] = (f32x2){0.f, 0.f};
#pragma unroll
    for (int k = 0; k < 16; ++k) { const float c1 = __builtin_bit_cast(float, cw[k >> 2][k & 3] & 0xFFFFC000u); const f32x2 c2 = (f32x2){c1, c1};
#pragma unroll
        for (int q = 0; q < 4; ++q) { const f32x2 lo = __builtin_amdgcn_cvt_pk_f32_fp8((int)rows[k][q], false), hi = __builtin_amdgcn_cvt_pk_f32_fp8((int)rows[k][q], true);
            o[2 * q] += c2 * lo; o[2 * q + 1] += c2 * hi; } }
    float d[16];
#pragma unroll
    for (int q = 0; q < 8; ++q) { d[2 * q] = o[q].x; d[2 * q + 1] = o[q].y; }
    const bool s4 = (lane & 32) != 0, s2 = (lane & 16) != 0, s1 = (lane & 8) != 0;
    float a[8], b[4], c[2];
#pragma unroll
    for (int j = 0; j < 8; ++j) { const float snd = s4 ? d[j] : d[8 + j]; const float rcv = __shfl_xor(snd, 32); a[j] = (s4 ? d[8 + j] : d[j]) + rcv; }
#pragma unroll
    for (int j = 0; j < 4; ++j) { const float snd = s2 ? a[j] : a[4 + j]; const float rcv = __shfl_xor(snd, 16); b[j] = (s2 ? a[4 + j] : a[j]) + rcv; }
#pragma unroll
    for (int j = 0; j < 2; ++j) { const float snd = s1 ? b[j] : b[2 + j]; const float rcv = __shfl_xor(snd, 8); c[j] = (s1 ? b[2 + j] : b[j]) + rcv; }
    const int tsrc = 8 * (lane & 7) + (lane >> 3);
    const f32x2 x2 = x1v + (f32x2){__shfl(c[0], tsrc), __shfl(c[1], tsrc)};
    const float ss = wave_sum(x2.x * x2.x + x2.y * x2.y);
    if (valid) {
        *(f32x2*)xrow = x2;
        *(unsigned*)hrow = pk2(x2.x * gp.x, x2.y * gp.y);
        if (lane == 0) *ssq = ss;
    }
}
DI void psl_rows_packed(const unsigned char* sl, const u32x4 (&cw)[4], int i, u32x4 (&rows)[16]) {
#pragma unroll
    for (int k = 0; k < 16; ++k) rows[k] = *(const u32x4*)(sl + (size_t)(cw[k >> 2][k & 3] & 0x3FFFu) * 128 + i * 16);
    __builtin_amdgcn_sched_barrier(0x4);
}
DI void peer_gv_slice(const unsigned* CW, const unsigned char* sl, float* XB, bf16_t* Hb, const float* g_ple, float* SSQ2, int x, int w0, int nw, int lane) {
    const int g = lane >> 3, i = lane & 7, col = x * 128 + 2 * lane;
    const int cnt = (T - w0 + nw - 1) / nw;
    if (w0 >= T) return;
    const f32x2 gp = *(const f32x2*)(g_ple + col);
    u32x4 ia[4], ib[4], ra[16], rb[16], ca[4], cb[4]; f32x2 xa, xb;
    psl_ids((const int*)CW + (size_t)PSL_TOK(0) * 128, g, ia);
    psl_ids((const int*)CW + (size_t)PSL_TOK(1) * 128, g, ib);
    xa = *(const f32x2*)(XB + (size_t)PSL_TOK(0) * D + col); psl_rows_packed(sl, ia, i, ra);
#pragma unroll
    for (int q = 0; q < 4; ++q) ca[q] = ia[q];
#pragma unroll 1
    for (int n = 0; n < cnt; n += 2) {
        const int t0 = PSL_TOK(n), t1 = PSL_TOK(n + 1), t2 = PSL_TOK(n + 2), t3 = PSL_TOK(n + 3);
        psl_ids((const int*)CW + (size_t)t2 * 128, g, ia);
        xb = *(const f32x2*)(XB + (size_t)t1 * D + col); psl_rows_packed(sl, ib, i, rb);
#pragma unroll
        for (int q = 0; q < 4; ++q) cb[q] = ib[q];
        psl_v_consume(ra, ca, xa, XB + (size_t)t0 * D + col, Hb + (size_t)t0 * D + col, gp, SSQ2 + (size_t)x * T + t0, lane, true);
        psl_ids((const int*)CW + (size_t)t3 * 128, g, ib);
        xa = *(const f32x2*)(XB + (size_t)t2 * D + col); psl_rows_packed(sl, ia, i, ra);
#pragma unroll
        for (int q = 0; q < 4; ++q) ca[q] = ia[q];
        psl_v_consume(rb, cb, xb, XB + (size_t)t1 * D + col, Hb + (size_t)t1 * D + col, gp, SSQ2 + (size_t)x * T + t1, lane, n + 1 < cnt);
    }
#undef PSL_TOK
}

DI float ushift(const bf16_t* U, int t, int col, float mu) {
    const float c = bf2f(U[(size_t)t * UW + col]);
    const float pv = t > 0 ? bf2f(U[(size_t)(t - 1) * UW + col]) : 0.f;
    const float nx = t < T - 1 ? bf2f(U[(size_t)(t + 1) * UW + col]) : 0.f;
    return c + mu * (0.5f * (pv + nx) - c);
}
DI void rwkv_scan_naive(const Params& P, const bf16_t* U, bf16_t* RO, float* BS, int d, int h, LAS unsigned char* lds) {
    const int tid = tid_fresh();
    LAS float* W2S = (LAS float*)lds;
    LAS float* A2S = W2S + 4096;
    LAS float* INB = A2S + 4096;
    LAS float* STP = INB + 5 * 2048;
    const float* mu = P.in[5];
    const float* w2 = P.in[7] + (size_t)d * 64 * 512;
    const float* a2 = P.in[9] + (size_t)d * 64 * 512;
    for (int i = tid; i < 4096; i += NTHREADS) { const int l = i >> 6, c = i & 63; W2S[i] = w2[l * 512 + h * 64 + c]; A2S[i] = a2[l * 512 + h * 64 + c]; }
    const int i2 = tid >> 4, c2 = (tid & 15) * 4;
    float w0c[4], a0c[4], kkc[4], kac[4], rkc[4];
#pragma unroll
    for (int j = 0; j < 4; ++j) { const int hc = h * 64 + c2 + j; w0c[j] = P.in[6][d * 512 + hc]; a0c[j] = P.in[8][d * 512 + hc]; kkc[j] = P.in[11][hc]; kac[j] = P.in[12][hc]; rkc[j] = P.in[13][hc]; }
    const int v3 = tid >> 3, q3 = tid & 7;
    float S[8];
#pragma unroll
    for (int j = 0; j < 8; ++j) S[j] = 0.f;
    __syncthreads();
    for (int ch = 0; ch < T / 32; ++ch) {
#pragma unroll 2
        for (int e = tid; e < 5 * 2048; e += NTHREADS) {
            const int grp = e >> 11, i = (e >> 6) & 31, c = e & 63;
            const int sidx = ch * 32 + i, t = d ? (T - 1 - sidx) : sidx;
            const int col = (grp < 3 ? grp * 512 + h * 64 : (grp == 3 ? 1536 : 1664) + d * 64) + c;
            float v = ushift(U, t, col, mu[col]);
            if (grp == 3) v = tanhf(v);
            INB[e] = v;
        }
        __syncthreads();
        {
            float wl[4], al[4];
#pragma unroll
            for (int j = 0; j < 4; ++j) { wl[j] = w0c[j]; al[j] = a0c[j]; }
#pragma unroll 4
            for (int l = 0; l < 64; ++l) {
                const float tw = INB[3 * 2048 + i2 * 64 + l], ta = INB[4 * 2048 + i2 * 64 + l];
                const f32x4 wv = *(const LAS f32x4*)(W2S + l * 64 + c2), av = *(const LAS f32x4*)(A2S + l * 64 + c2);
#pragma unroll
                for (int j = 0; j < 4; ++j) { wl[j] += tw * wv[j]; al[j] += ta * av[j]; }
            }
            float kk[4], ss = 0.f, bsum = 0.f, kd[4], alr[4], dec[4], rr[4];
#pragma unroll
            for (int j = 0; j < 4; ++j) {
                const float kv = INB[1 * 2048 + i2 * 64 + c2 + j]; rr[j] = INB[0 * 2048 + i2 * 64 + c2 + j];
                kk[j] = kv * kkc[j]; ss += kk[j] * kk[j];
                alr[j] = 1.f / (1.f + expf(-al[j]));
                const float wlog = -log1pf(expf(-wl[j])) - 0.5f;
                dec[j] = expf(-expf(wlog));
                kd[j] = kv * (1.f + (alr[j] - 1.f) * kac[j]);
                bsum += rr[j] * kd[j] * rkc[j];
            }
#pragma unroll
            for (int o = 1; o < 16; o <<= 1) { ss += __shfl_xor(ss, o); bsum += __shfl_xor(bsum, o); }
            const float inv = 1.f / fmaxf(sqrtf(ss), 1e-12f);
            const int sidx = ch * 32 + i2, t = d ? (T - 1 - sidx) : sidx;
            if ((tid & 15) == 0) BS[((size_t)d * T + t) * 8 + h] = bsum;
#pragma unroll
            for (int j = 0; j < 4; ++j) { const float k1 = kk[j] * inv;
                STP[(i2 * 5 + 0) * 64 + c2 + j] = -k1; STP[(i2 * 5 + 1) * 64 + c2 + j] = k1 * alr[j];
                STP[(i2 * 5 + 2) * 64 + c2 + j] = kd[j]; STP[(i2 * 5 + 3) * 64 + c2 + j] = dec[j]; STP[(i2 * 5 + 4) * 64 + c2 + j] = rr[j]; }
        }
        __syncthreads();
#pragma unroll 2
        for (int i = 0; i < 32; ++i) {
            const LAS float* sp = STP + i * 320 + q3 * 8;
            float av[8], bv[8], kv[8], wv[8], rv[8];
#pragma unroll
            for (int j = 0; j < 8; j += 4) {
                const f32x4 a4 = *(const LAS f32x4*)(sp + j), b4 = *(const LAS f32x4*)(sp + 64 + j), k4 = *(const LAS f32x4*)(sp + 128 + j), w4 = *(const LAS f32x4*)(sp + 192 + j), r4 = *(const LAS f32x4*)(sp + 256 + j);
#pragma unroll
                for (int u = 0; u < 4; ++u) { av[j + u] = a4[u]; bv[j + u] = b4[u]; kv[j + u] = k4[u]; wv[j + u] = w4[u]; rv[j + u] = r4[u]; }
            }
            const float vv = INB[2 * 2048 + i * 64 + v3];
            float sa = 0.f;
#pragma unroll
            for (int j = 0; j < 8; ++j) sa += S[j] * av[j];
            sa += __shfl_xor(sa, 1); sa += __shfl_xor(sa, 2); sa += __shfl_xor(sa, 4);
            float ov = 0.f;
#pragma unroll
            for (int j = 0; j < 8; ++j) { S[j] = S[j] * wv[j] + sa * bv[j] + vv * kv[j]; ov += S[j] * rv[j]; }
            ov += __shfl_xor(ov, 1); ov += __shfl_xor(ov, 2); ov += __shfl_xor(ov, 4);
            if (q3 == 0) { const int sidx = ch * 32 + i, t = d ? (T - 1 - sidx) : sidx; RO[((size_t)d * T + t) * 512 + h * 64 + v3] = (bf16_t)f2bf(ov); }
        }
        __syncthreads();
    }
}
DI void rwkv_merge_token(const Params& P, bf16_t* VSY, const unsigned char* CM, const float* BS, const bf16_t* Gm, int t, int lane) {
    const int c0 = lane * 8, h = lane >> 3, vhalf = (lane >> 2) & 1, ch32 = (lane & 3) * 8;
    const int s1 = T - 1 - t;
    const u32x4 o0 = *(const u32x4*)(CM + ((size_t)(h * 256 + (t >> 6))) * CM_ITEM + 16384 + vhalf * 4096 + (t & 63) * 64 + ch32 * 2);
    const u32x4 o1 = *(const u32x4*)(CM + ((size_t)((8 + h) * 256 + (s1 >> 6))) * CM_ITEM + 16384 + vhalf * 4096 + (s1 & 63) * 64 + ch32 * 2);
    float o[8]; float s = 0.f;
#pragma unroll
    for (int j = 0; j < 4; ++j) { o[2 * j] = __builtin_bit_cast(float, o0[j] << 16) + __builtin_bit_cast(float, o1[j] << 16);
        o[2 * j + 1] = __builtin_bit_cast(float, o0[j] & 0xffff0000u) + __builtin_bit_cast(float, o1[j] & 0xffff0000u); s += o[2 * j] + o[2 * j + 1]; }
    s += __shfl_xor(s, 1); s += __shfl_xor(s, 2); s += __shfl_xor(s, 4);
    const float mean = s * (1.f / 64.f); float q = 0.f;
#pragma unroll
    for (int j = 0; j < 8; ++j) { o[j] -= mean; q += o[j] * o[j]; }
    q += __shfl_xor(q, 1); q += __shfl_xor(q, 2); q += __shfl_xor(q, 4);
    const float rstd = 1.f / sqrtf(q * (1.f / 64.f) + 64e-5f);
    const float bonus = BS[(size_t)t * 8 + h] + BS[((size_t)T + t) * 8 + h];
    const u32x4 g4 = *(const u32x4*)(Gm + (size_t)t * 512 + c0);
    const u32x4 v4 = *(const u32x4*)(VSY + (size_t)t * 512 + c0);
    const f32x4 gw0 = *(const f32x4*)(P.in[14] + c0), gw1 = *(const f32x4*)(P.in[14] + c0 + 4), gb0 = *(const f32x4*)(P.in[15] + c0), gb1 = *(const f32x4*)(P.in[15] + c0 + 4);
    u32x4 w;
#pragma unroll
    for (int j = 0; j < 4; ++j) {
        float y[2];
#pragma unroll
        for (int u = 0; u < 2; ++u) { const int e = 2 * j + u;
            const float vs = u ? __builtin_bit_cast(float, v4[j] & 0xffff0000u) : __builtin_bit_cast(float, v4[j] << 16);
            const float gg = u ? __builtin_bit_cast(float, g4[j] & 0xffff0000u) : __builtin_bit_cast(float, g4[j] << 16);
            const float gnw = e < 4 ? gw0[e] : gw1[e - 4], gnb = e < 4 ? gb0[e] : gb1[e - 4];
            y[u] = (o[e] * rstd * gnw + gnb + bonus * vs) * gg; }
        w[j] = pk2(y[0], y[1]);
    }
    *(u32x4*)(VSY + (size_t)t * 512 + c0) = w;
}


constexpr int PA_RF = 0, PA_KF = 16384, PA_VF = 32768, PA_WL = 49152, PA_AL = 65536, PA_LW = 81920, PA_LA = 90112, PA_AR = 98304, PA_BK = 114688,
              PA_YG = 131072, PA_VT = 147456, PA_SEG = 155648, PA_GCL = 157696;
constexpr int PA_N = 0, PA_NT = 8192, PA_QRB = 16384, PA_QRK = 24576, PA_T0 = 32768, PA_T1 = 40960, PA_A0 = 49152, PA_AT0 = 57344, PA_A1 = 65536, PA_AT1 = 73728,
              PA_BT = 81920, PA_KT = 90112, PA_GT = 114688, PA_OK = 32768, PA_AT = PA_YG, PA_PAKT = PA_YG + 8192;
typedef __bf16 bf16x2_t __attribute__((ext_vector_type(2)));
DI unsigned cvtpk(float lo, float hi) { f32x2 v = {lo, hi}; bf16x2_t b = __builtin_convertvector(v, bf16x2_t); return __builtin_bit_cast(unsigned, b); }
DI int pswz(int row) { return (row ^ (row >> 3)) & 7; }
DI int lofs(int row, int col) { return row * 128 + ((((col >> 3) ^ pswz(row))) << 4) + (col & 7) * 2; }
DI bf16x8 lfrag(const LAS unsigned char* M, int row, int kk, int fq) { return *(const LAS bf16x8*)(M + row * 128 + (((kk * 4 + fq) ^ pswz(row)) << 4)); }
template <int NT, bool SWAP>
DI void mm16(f32x4 (&acc)[NT], const LAS unsigned char* X, int xrow0, const LAS unsigned char* Y, int yrow0, int fr, int fq) {
#pragma unroll
    for (int kk = 0; kk < 2; ++kk) {
        const bf16x8 xf = lfrag(X, xrow0 + fr, kk, fq);
#pragma unroll
        for (int n = 0; n < NT; ++n) {
            const bf16x8 yf = lfrag(Y, yrow0 + n * 16 + fr, kk, fq);
            acc[n] = SWAP ? __builtin_amdgcn_mfma_f32_16x16x32_bf16(yf, xf, acc[n], 0, 0, 0) : __builtin_amdgcn_mfma_f32_16x16x32_bf16(xf, yf, acc[n], 0, 0, 0);
        }
    }
}
DI void st4(LAS unsigned char* M, int row, int col, f32x4 v) { *(LAS u32x2*)(M + lofs(row, col)) = (u32x2){cvtpk(v[0], v[1]), cvtpk(v[2], v[3])}; }
DI f32x4 ld4(const LAS unsigned char* M, int row, int col) { const u32x2 p = *(const LAS u32x2*)(M + lofs(row, col));
    return (f32x4){__builtin_bit_cast(float, p.x << 16), __builtin_bit_cast(float, p.x & 0xffff0000u), __builtin_bit_cast(float, p.y << 16), __builtin_bit_cast(float, p.y & 0xffff0000u)}; }
DI void st1(LAS unsigned char* M, int row, int col, float v) { *(LAS bf16_t*)(M + lofs(row, col)) = (bf16_t)(cvtpk(v, 0.f) & 0xffffu); }

#define LDS_BAR() do { asm volatile("s_waitcnt lgkmcnt(0)" ::: "memory"); __builtin_amdgcn_s_barrier(); asm volatile("" ::: "memory"); } while (0)
struct PaPre { u32x4 cu[5], pu[5], nu[5]; f32x4 m0[5], m1[5]; };
DI void pa_prefetch(const bf16_t* U, const float* mu, int item, int tid, PaPre& pre) {
    const int c = item & 255, h = (item >> 8) & 7, d = item >> 11;
    const int i = tid >> 3, c8 = tid & 7;
    const int sidx = c * 64 + i, t = d ? (T - 1 - sidx) : sidx;
#pragma unroll
    for (int q = 0; q < 5; ++q) {
        const int col = (q < 3 ? q * 512 + h * 64 : (q == 3 ? 1536 : 1664) + d * 64) + c8 * 8;
        const bf16_t* up = U + (size_t)t * UW + col;
        pre.cu[q] = *(const u32x4*)up; pre.pu[q] = *(const u32x4*)(t > 0 ? up - UW : up); pre.nu[q] = *(const u32x4*)(t < T - 1 ? up + UW : up);
        pre.m0[q] = *(const f32x4*)(mu + col); pre.m1[q] = *(const f32x4*)(mu + col + 4);
    }
}
DI void rwkv_passA(const Params& P, const bf16_t* U, const bf16_t* W2T, const bf16_t* A2T, unsigned char* CM, float* GC, float* BS, bf16_t* VS, unsigned* flags, int item, int prev_item, int next_item, PaPre& pre, LAS unsigned char* lds, unsigned long long* tacc = nullptr) {
#ifdef DBG_TS
    unsigned long long t_prev = __builtin_amdgcn_s_memrealtime();
#define PA_MARK(k) do { if (tacc && threadIdx.x == 0) { const unsigned long long t_now = __builtin_amdgcn_s_memrealtime(); tacc[k] += t_now - t_prev; t_prev = t_now; } } while (0)
#else
#define PA_MARK(k) do {} while (0)
#endif
    const int tid = tid_fresh(), lane = tid & 63, wid = __builtin_amdgcn_readfirstlane(tid >> 6), fr = lane & 15, fq = lane >> 4;
    const int c = item & 255, h = (item >> 8) & 7, d = item >> 11;
    bf16x8 yfr[2][4];
    { const bf16_t* Yg = ((wid >> 2) ? A2T : W2T) + (size_t)(d * 8 + h) * 4096;
#pragma unroll
      for (int kk = 0; kk < 2; ++kk)
#pragma unroll
        for (int n = 0; n < 4; ++n) yfr[kk][n] = *(const bf16x8*)(Yg + (n * 16 + fr) * 64 + (kk * 4 + fq) * 8); }
    f32x4 b0c[4]; f32x4 kkc[2], kac[2], rkc[2];
    { const float* bp = ((wid >> 2) ? P.in[8] : P.in[6]) + d * 512 + h * 64 + 4 * fq;
#pragma unroll
      for (int n = 0; n < 4; ++n) b0c[n] = *(const f32x4*)(bp + n * 16);
      const int cc_ = (tid & 7) * 8;
      kkc[0] = *(const f32x4*)(P.in[11] + h * 64 + cc_); kkc[1] = *(const f32x4*)(P.in[11] + h * 64 + cc_ + 4);
      kac[0] = *(const f32x4*)(P.in[12] + h * 64 + cc_); kac[1] = *(const f32x4*)(P.in[12] + h * 64 + cc_ + 4);
      rkc[0] = *(const f32x4*)(P.in[13] + h * 64 + cc_); rkc[1] = *(const f32x4*)(P.in[13] + h * 64 + cc_ + 4); }
    {
        const int i = tid >> 3, c8 = tid & 7;
        const int sidx = c * 64 + i, t = d ? (T - 1 - sidx) : sidx;
        const float pf = t > 0 ? 0.5f : 0.f, nf = t < T - 1 ? 0.5f : 0.f;
#pragma unroll
        for (int q = 0; q < 5; ++q) {
            const int col = (q < 3 ? q * 512 + h * 64 : (q == 3 ? 1536 : 1664) + d * 64) + c8 * 8;
            const u32x4 cu = pre.cu[q], pu = pre.pu[q], nu = pre.nu[q];
            const f32x4 m0 = pre.m0[q], m1 = pre.m1[q];
            float v[8];
#pragma unroll
            for (int j = 0; j < 4; ++j) {
                const float c0 = __builtin_bit_cast(float, cu[j] << 16), c1 = __builtin_bit_cast(float, cu[j] & 0xffff0000u);
                const float p0 = __builtin_bit_cast(float, pu[j] << 16), p1 = __builtin_bit_cast(float, pu[j] & 0xffff0000u);
                const float n0 = __builtin_bit_cast(float, nu[j] << 16), n1 = __builtin_bit_cast(float, nu[j] & 0xffff0000u);
                const float mu0 = j < 2 ? m0[2 * j] : m1[2 * j - 4], mu1 = j < 2 ? m0[2 * j + 1] : m1[2 * j - 3];
                v[2 * j] = c0 + mu0 * ((pf * p0 + nf * n0) - c0); v[2 * j + 1] = c1 + mu1 * ((pf * p1 + nf * n1) - c1);
            }
            if (q < 3) {
                LAS float* dst = (LAS float*)(lds + q * 16384) + i * 64 + c8 * 8;
                *(LAS f32x4*)dst = (f32x4){v[0], v[1], v[2], v[3]}; *(LAS f32x4*)(dst + 4) = (f32x4){v[4], v[5], v[6], v[7]};
                if (q == 2) {
#pragma unroll
                    for (int j = 0; j < 8; ++j) st1(lds + PA_VT, c8 * 8 + j, i, v[j]);
                    if (d == 0) *(u32x4*)(VS + (size_t)t * 512 + h * 64 + c8 * 8) = (u32x4){cvtpk(v[0], v[1]), cvtpk(v[2], v[3]), cvtpk(v[4], v[5]), cvtpk(v[6], v[7])};
                }
            } else {
                if (q == 3) {
#pragma unroll
                    for (int j = 0; j < 8; ++j) v[j] = 1.f - 2.f * __builtin_amdgcn_rcpf(1.f + __expf(2.f * v[j]));
                }
                *(LAS u32x4*)(lds + (q == 3 ? PA_LW : PA_LA) + i * 128 + ((c8 ^ pswz(i)) << 4)) = (u32x4){cvtpk(v[0], v[1]), cvtpk(v[2], v[3]), cvtpk(v[4], v[5]), cvtpk(v[6], v[7])};
            }
        }
    }
    LDS_BAR();
    if (next_item >= 0) pa_prefetch(U, P.in[5], next_item, tid, pre);
    PA_MARK(0);
    {
        const int sel = wid >> 2, rb = wid & 3;
        const LAS unsigned char* X = lds + (sel ? PA_LA : PA_LW);
        f32x4 acc[4];
#pragma unroll
        for (int n = 0; n < 4; ++n) acc[n] = (f32x4){0.f, 0.f, 0.f, 0.f};
#pragma unroll
        for (int kk = 0; kk < 2; ++kk) {
            const bf16x8 xf = lfrag(X, rb * 16 + fr, kk, fq);
#pragma unroll
            for (int n = 0; n < 4; ++n) acc[n] = __builtin_amdgcn_mfma_f32_16x16x32_bf16(yfr[kk][n], xf, acc[n], 0, 0, 0);
        }
        const int i = rb * 16 + fr;
#pragma unroll
        for (int n = 0; n < 4; ++n) {
            const int cc = n * 16 + 4 * fq;
            const f32x4 b0 = b0c[n];
            f32x4 o;
#pragma unroll
            for (int j = 0; j < 4; ++j) { const float z = acc[n][j] + b0[j];
                const float sg = __builtin_amdgcn_rcpf(1.f + __expf(-z));
                o[j] = sel ? sg : -0.6065306597126334f * sg; }
            *(LAS f32x4*)((LAS float*)(lds + (sel ? PA_AL : PA_WL)) + i * 64 + cc) = o;
        }
    }
    LDS_BAR();
    PA_MARK(6);
    {
        const int k = tid & 63, seg = tid >> 6;
        LAS float* WL = (LAS float*)(lds + PA_WL); LAS float* SEG = (LAS float*)(lds + PA_SEG);
        float run = 0.f, tmp[8];
#pragma unroll
        for (int ii = 0; ii < 8; ++ii) { run += WL[(seg * 8 + ii) * 64 + k]; tmp[ii] = run; }
        SEG[seg * 64 + k] = run;
        LDS_BAR();
        float off = 0.f;
#pragma unroll
        for (int s = 0; s < 8; ++s) off += (s < seg) ? SEG[s * 64 + k] : 0.f;
#pragma unroll
        for (int ii = 0; ii < 8; ++ii) WL[(seg * 8 + ii) * 64 + k] = tmp[ii] + off;
    }
    LDS_BAR();
    PA_MARK(7);
    {
        const int i = tid >> 3, c8 = tid & 7, cc = c8 * 8;
        const LAS float* Rf = (const LAS float*)(lds + PA_RF) + i * 64 + cc; const LAS float* Kf = (const LAS float*)(lds + PA_KF) + i * 64 + cc;
        const LAS float* Lf = (const LAS float*)(lds + PA_WL) + i * 64 + cc; const LAS float* Af = (const LAS float*)(lds + PA_AL) + i * 64 + cc;
        float rr[8], kv[8], L[8], Lp[8], al[8];
#pragma unroll
        for (int j = 0; j < 8; j += 4) { const f32x4 a = *(const LAS f32x4*)(Rf + j), b = *(const LAS f32x4*)(Kf + j), l4 = *(const LAS f32x4*)(Lf + j), a4 = *(const LAS f32x4*)(Af + j);
            f32x4 lp = (f32x4){0.f, 0.f, 0.f, 0.f}; if (i > 0) lp = *(const LAS f32x4*)(Lf - 64 + j);
#pragma unroll
            for (int u = 0; u < 4; ++u) { rr[j + u] = a[u]; kv[j + u] = b[u]; L[j + u] = l4[u]; Lp[j + u] = lp[u]; al[j + u] = a4[u]; } }
        float kkp[8], kap[8], rkp[8];
#pragma unroll
        for (int j = 0; j < 8; ++j) { kkp[j] = kkc[j >> 2][j & 3]; kap[j] = kac[j >> 2][j & 3]; rkp[j] = rkc[j >> 2][j & 3]; }
        float kk[8], kd[8], ss = 0.f, bsum = 0.f;
#pragma unroll
        for (int j = 0; j < 8; ++j) { kk[j] = kv[j] * kkp[j]; ss += kk[j] * kk[j]; kd[j] = kv[j] * (1.f + (al[j] - 1.f) * kap[j]); bsum += rr[j] * kd[j] * rkp[j]; }
#pragma unroll
        for (int o = 1; o < 8; o <<= 1) { ss += __shfl_xor(ss, o); bsum += __shfl_xor(bsum, o); }
        const float inv = __builtin_amdgcn_rsqf(fmaxf(ss, 1e-24f));
        const int sidx = c * 64 + i, t = d ? (T - 1 - sidx) : sidx;
        if (c8 == 0) BS[((size_t)d * T + t) * 8 + h] = bsum;
        float ah[8], rh[8], bh[8], kh[8];
#pragma unroll
        for (int j = 0; j < 8; ++j) { const float k1 = kk[j] * inv, eL = __expf(L[j]), eLm = __expf(-L[j]), eP = __expf(Lp[j]);
            ah[j] = -k1 * eP; rh[j] = rr[j] * eL; bh[j] = k1 * al[j] * eLm; kh[j] = kd[j] * eLm;
            if (i == 63) { ((LAS float*)(lds + PA_GCL))[cc + j] = eL; __hip_atomic_store((unsigned*)(GC + (size_t)item * 64 + cc + j), __builtin_bit_cast(unsigned, eL), __ATOMIC_RELAXED, __HIP_MEMORY_SCOPE_AGENT); } }
        const int so = ((c8 ^ pswz(i)) << 4);
        *(LAS u32x4*)(lds + PA_AR + i * 128 + so) = (u32x4){cvtpk(ah[0], ah[1]), cvtpk(ah[2], ah[3]), cvtpk(ah[4], ah[5]), cvtpk(ah[6], ah[7])};
        *(LAS u32x4*)(lds + PA_AR + (64 + i) * 128 + so) = (u32x4){cvtpk(rh[0], rh[1]), cvtpk(rh[2], rh[3]), cvtpk(rh[4], rh[5]), cvtpk(rh[6], rh[7])};
        *(LAS u32x4*)(lds + PA_BK + i * 128 + so) = (u32x4){cvtpk(bh[0], bh[1]), cvtpk(bh[2], bh[3]), cvtpk(bh[4], bh[5]), cvtpk(bh[6], bh[7])};
        *(LAS u32x4*)(lds + PA_BK + (64 + i) * 128 + so) = (u32x4){cvtpk(kh[0], kh[1]), cvtpk(kh[2], kh[3]), cvtpk(kh[4], kh[5]), cvtpk(kh[6], kh[7])};
#pragma unroll
        for (int j = 0; j < 8; ++j) { st1(lds + PA_AT, cc + j, i, ah[j]); st1(lds + PA_BT, cc + j, i, bh[j]); st1(lds + PA_KT, cc + j, i, kh[j]); }
    }
    LDS_BAR();
    PA_MARK(1);
    {
        f32x4 acc[8];
#pragma unroll
        for (int n = 0; n < 8; ++n) acc[n] = (f32x4){0.f, 0.f, 0.f, 0.f};
        mm16<8, true>(acc, lds + PA_AR, wid * 16, lds + PA_BK, 0, fr, fq);
        const int t = (wid & 3) * 16 + fr; const bool isR = wid >= 4;
#pragma unroll
        for (int n = 0; n < 8; ++n) {
            const int j0 = (n & 3) * 16 + 4 * fq; const bool isK = n >= 4;
            f32x4 v = acc[n];
#pragma unroll
            for (int j = 0; j < 4; ++j) { const bool keep = isR ? (j0 + j <= t) : (j0 + j < t); v[j] = keep ? v[j] : 0.f; }
            if (!isR && !isK) {
                st4(lds + PA_N, t, j0, v);
#pragma unroll
                for (int j = 0; j < 4; ++j) st1(lds + PA_NT, j0 + j, t, v[j]);
                f32x4 tv = v;
#pragma unroll
                for (int j = 0; j < 4; ++j) tv[j] += (j0 + j == t) ? 1.f : 0.f;
                st4(lds + PA_T0, t, j0, tv);
            } else if (!isR && isK) {
#pragma unroll
                for (int j = 0; j < 4; ++j) st1(lds + PA_PAKT, j0 + j, t, v[j]);
            } else if (isR && !isK) st4(lds + PA_QRB, t, j0, v);
            else st4(lds + PA_QRK, t, j0, v);
        }
    }
    LDS_BAR();
    PA_MARK(2);
    {
        const int mt = wid >> 1, nt0 = (wid & 1) * 2, row = mt * 16 + fr;
#pragma unroll 1
        for (int s = 0; s < 6; ++s) {
            const LAS unsigned char* Ac = lds + (s == 0 ? PA_N : ((s & 1) ? PA_A0 : PA_A1));
            const LAS unsigned char* ATc = lds + (s == 0 ? PA_NT : ((s & 1) ? PA_AT0 : PA_AT1));
            LAS unsigned char* An = lds + ((s & 1) ? PA_A1 : PA_A0);
            LAS unsigned char* ATn = lds + ((s & 1) ? PA_AT1 : PA_AT0);
            const LAS unsigned char* To = lds + (((s - 1) & 1) ? PA_T1 : PA_T0);
            LAS unsigned char* Tn = lds + ((s & 1) ? PA_T1 : PA_T0);
            if (s < 5) {
                f32x4 aa[2] = {(f32x4){0.f, 0.f, 0.f, 0.f}, (f32x4){0.f, 0.f, 0.f, 0.f}};
                mm16<2, true>(aa, Ac, mt * 16, ATc, nt0 * 16, fr, fq);
#pragma unroll
                for (int n = 0; n < 2; ++n) { const int c0 = (nt0 + n) * 16 + 4 * fq; st4(An, row, c0, aa[n]);
#pragma unroll
                    for (int j = 0; j < 4; ++j) st1(ATn, c0 + j, row, aa[n][j]); }
            }
            if (s > 0) {
                f32x4 ta[2] = {(f32x4){0.f, 0.f, 0.f, 0.f}, (f32x4){0.f, 0.f, 0.f, 0.f}};
                mm16<2, true>(ta, To, mt * 16, ATc, nt0 * 16, fr, fq);
#pragma unroll
                for (int n = 0; n < 2; ++n) { const int c0 = (nt0 + n) * 16 + 4 * fq; const f32x4 o = ld4(To, row, c0) + ta[n]; st4(Tn, row, c0, o); }
            }
            LDS_BAR();
        }
    }
    PA_MARK(3);
    {
        const int mt = wid >> 1, nt0 = (wid & 1) * 4;
        f32x4 acc[4];
#pragma unroll
        for (int n = 0; n < 4; ++n) acc[n] = (f32x4){0.f, 0.f, 0.f, 0.f};
        mm16<4, false>(acc, lds + PA_T1, mt * 16, lds + PA_YG, nt0 * 16, fr, fq);
#pragma unroll
        for (int n = 0; n < 4; ++n) st4(lds + PA_GT, (nt0 + n) * 16 + fr, mt * 16 + 4 * fq, acc[n]);
    }
    asm volatile("s_waitcnt vmcnt(0)" ::: "memory");
    LDS_BAR();
    if (prev_item >= 0 && tid == 0) __hip_atomic_store(flags + prev_item, 1u, __ATOMIC_RELAXED, __HIP_MEMORY_SCOPE_AGENT);
    {
        const int sel = wid >> 2, mt = wid & 3, row = mt * 16 + fr;
        f32x4 acc[8];
#pragma unroll
        for (int n = 0; n < 8; ++n) acc[n] = (f32x4){0.f, 0.f, 0.f, 0.f};
        mm16<8, true>(acc, lds + (sel ? PA_BT : PA_QRB), mt * 16, lds + PA_GT, 0, fr, fq);
        const float gc = ((const LAS float*)(lds + PA_GCL))[row];
        bf16_t* gout = (bf16_t*)(CM + (size_t)item * CM_ITEM + (sel ? 8192 : 0));
#pragma unroll
        for (int n = 0; n < 8; ++n) {
            const int c0 = (n & 3) * 16 + 4 * fq;
            f32x4 v = acc[n];
            if (n < 4) {
                if (sel == 0) v = v + ld4(lds + PA_AR, 64 + row, c0); else v = v * gc;
                const int tb = row >> 5, lanep = (row & 31) + 32 * (fq & 1);
                __hip_atomic_store((unsigned long long*)(gout + (((tb * 4 + n) * 64 + lanep) * 8 + 4 * (fq >> 1))), (unsigned long long)cvtpk(v[0], v[1]) | ((unsigned long long)cvtpk(v[2], v[3]) << 32), __ATOMIC_RELAXED, __HIP_MEMORY_SCOPE_AGENT);
            } else {
                if (sel == 0) v = v + ld4(lds + PA_QRK, row, c0); else v = (v + ld4(lds + PA_KT, row, c0)) * gc;
                st4(lds + PA_OK, sel * 64 + row, c0, v);
            }
        }
    }
    LDS_BAR();
    PA_MARK(4);
    {
        f32x4 acc[4];
#pragma unroll
        for (int n = 0; n < 4; ++n) acc[n] = (f32x4){0.f, 0.f, 0.f, 0.f};
        mm16<4, false>(acc, lds + PA_OK, wid * 16, lds + PA_VT, 0, fr, fq);
        bf16_t* gout = (bf16_t*)(CM + (size_t)item * CM_ITEM + (wid < 4 ? 16384 : 24576));
        const int mt = wid & 3, blk = mt >> 1, reg0 = 4 * ((mt & 1) * 2 + (fq >> 1));
#pragma unroll
        for (int n = 0; n < 4; ++n) {
            const int vhalf = n >> 1, lanep = (n & 1) * 16 + fr + 32 * (fq & 1);
            __hip_atomic_store((unsigned long long*)(gout + (((vhalf * 2 + blk) * 64 + lanep) * 16 + reg0)), (unsigned long long)cvtpk(acc[n][0], acc[n][1]) | ((unsigned long long)cvtpk(acc[n][2], acc[n][3]) << 32), __ATOMIC_RELAXED, __HIP_MEMORY_SCOPE_AGENT);
        }
    }
    PA_MARK(5);
    if (next_item < 0) { asm volatile("s_waitcnt vmcnt(0)" ::: "memory"); LDS_BAR(); if (tid == 0) __hip_atomic_store(flags + item, 1u, __ATOMIC_RELAXED, __HIP_MEMORY_SCOPE_AGENT); }
    else LDS_BAR();
}

#undef PA_MARK
constexpr int PB_STAGE = 24576 + 256, PB_NST = 6, PB_XS = PB_NST * PB_STAGE, PB_XS_SZ = 4096;
DI void pb_out_chunk(const LAS unsigned char* st, const LAS unsigned char* xsb, unsigned char* ROitem, int vhalf, int tb, int lane) {
    const int r = lane & 31, hh = lane >> 5;
    bf16x8 xs[4];
#pragma unroll
    for (int s = 0; s < 4; ++s) xs[s] = *(const LAS bf16x8*)(xsb + (s * 64 + lane) * 16);
    const LAS unsigned char* op = st + 16384 + (tb * 64 + lane) * 32;
    const u32x4 a = *(const LAS u32x4*)op, b = *(const LAS u32x4*)(op + 16);
    f32x16 o;
#pragma unroll
    for (int j = 0; j < 4; ++j) { o[2 * j] = __builtin_bit_cast(float, a[j] << 16); o[2 * j + 1] = __builtin_bit_cast(float, a[j] & 0xffff0000u);
                                  o[8 + 2 * j] = __builtin_bit_cast(float, b[j] << 16); o[8 + 2 * j + 1] = __builtin_bit_cast(float, b[j] & 0xffff0000u); }
#pragma unroll
    for (int s = 0; s < 4; ++s) o = __builtin_amdgcn_mfma_f32_32x32x16_bf16(*(const LAS bf16x8*)(st + ((tb * 4 + s) * 64 + lane) * 16), xs[s], o, 0, 0, 0);
    bf16_t* rp = (bf16_t*)(ROitem + 16384 + vhalf * 4096) + (tb * 32 + 4 * hh) * 32 + r;
#pragma unroll
    for (int i = 0; i < 16; ++i) rp[((i & 3) + 8 * (i >> 2)) * 32] = (bf16_t)(cvtpk(o[i], 0.f) & 0xffffu);
}
DI void pb_state_chunk(const LAS unsigned char* st, const LAS unsigned char* xs_in, LAS unsigned char* xs_out, f32x16& S, int kb, int lane) {
    const int hh = lane >> 5;
    bf16x8 xs[4];
#pragma unroll
    for (int s = 0; s < 4; ++s) xs[s] = *(const LAS bf16x8*)(xs_in + (s * 64 + lane) * 16);
    f32x16 n;
    const LAS float* gcl = (const LAS float*)(st + 24576) + 32 * kb;
    const LAS unsigned char* hp = st + 20480 + (kb * 64 + lane) * 32;
    const u32x4 a0 = *(const LAS u32x4*)hp, b0 = *(const LAS u32x4*)(hp + 16);
#pragma unroll
    for (int j = 0; j < 4; ++j) { n[2 * j] = __builtin_bit_cast(float, a0[j] << 16); n[2 * j + 1] = __builtin_bit_cast(float, a0[j] & 0xffff0000u);
                                  n[8 + 2 * j] = __builtin_bit_cast(float, b0[j] << 16); n[8 + 2 * j + 1] = __builtin_bit_cast(float, b0[j] & 0xffff0000u); }
#pragma unroll
    for (int i = 0; i < 16; ++i) { const int kr = (i & 3) + 8 * (i >> 2) + 4 * hh; n[i] += gcl[kr] * S[i]; }
#pragma unroll
    for (int s = 0; s < 4; ++s) n = __builtin_amdgcn_mfma_f32_32x32x16_bf16(*(const LAS bf16x8*)(st + 8192 + ((kb * 4 + s) * 64 + lane) * 16), xs[s], n, 0, 0, 0);
    S = n;
    const u32x4 w0 = (u32x4){cvtpk(n[0], n[1]), cvtpk(n[2], n[3]), cvtpk(n[4], n[5]), cvtpk(n[6], n[7])};
    const u32x4 w1 = (u32x4){cvtpk(n[8], n[9]), cvtpk(n[10], n[11]), cvtpk(n[12], n[13]), cvtpk(n[14], n[15])};
    *(LAS u32x4*)(xs_out + ((2 * kb) * 64 + lane) * 16) = w0; *(LAS u32x4*)(xs_out + ((2 * kb + 1) * 64 + lane) * 16) = w1;
}
DI void pb_dma(const unsigned char* CM, const float* GC, unsigned* flags, size_t item0, int cc, int vhalf, LAS unsigned char* stg, int lw, int lane) {
    const int c_ = cc < 256 ? cc : 255;
    {
        unsigned sp = 0;
        while (__builtin_amdgcn_readfirstlane(__hip_atomic_load(flags + item0 + c_, __ATOMIC_RELAXED, __HIP_MEMORY_SCOPE_AGENT)) == 0u) { __builtin_amdgcn_s_sleep(4); if (++sp > (1u << 22)) break; }
        asm volatile("" ::: "memory");
    }
    const unsigned char* src = CM + (item0 + c_) * CM_ITEM;
#pragma unroll
    for (int q = 0; q < 6; ++q) {
        const int piece = lw * 6 + q;
        const int soff = piece < 16 ? piece * 1024 : (piece < 20 ? 16384 + vhalf * 4096 + (piece - 16) * 1024 : 24576 + vhalf * 4096 + (piece - 20) * 1024);
        __builtin_amdgcn_global_load_lds((const unsigned*)(src + soff + lane * 16), (LAS unsigned*)(stg + piece * 1024), 16, 0, 16);
    }
    __builtin_amdgcn_global_load_lds((const unsigned*)((const unsigned char*)(GC + (item0 + c_) * 64) + lane * 4), (LAS unsigned*)(stg + 24576), 4, 0, 16);
}
DI void rwkv_passB(unsigned char* CM, const float* GC, unsigned* flags, int d, int h, int vhalf, LAS unsigned char* lds) {
    const int tid = tid_fresh(), lane = tid & 63, wid = __builtin_amdgcn_readfirstlane(tid >> 6);
    const size_t item0 = (size_t)(d * 8 + h) * 256;
    const bool loader = (wid >= 4);
    if (loader) { pb_dma(CM, GC, flags, item0, 0, vhalf, lds + 0 * PB_STAGE, wid - 4, lane); pb_dma(CM, GC, flags, item0, 1, vhalf, lds + 1 * PB_STAGE, wid - 4, lane); pb_dma(CM, GC, flags, item0, 2, vhalf, lds + 2 * PB_STAGE, wid - 4, lane); pb_dma(CM, GC, flags, item0, 3, vhalf, lds + 3 * PB_STAGE, wid - 4, lane);
                  asm volatile("s_waitcnt vmcnt(21)" ::: "memory"); }
    else if (wid < 2) { *(LAS u32x4*)(lds + PB_XS + ((2 * wid) * 64 + lane) * 16) = (u32x4){0u, 0u, 0u, 0u}; *(LAS u32x4*)(lds + PB_XS + ((2 * wid + 1) * 64 + lane) * 16) = (u32x4){0u, 0u, 0u, 0u}; }
    LDS_BAR();
    f32x16 S;
#pragma unroll
    for (int i = 0; i < 16; ++i) S[i] = 0.f;
    int sc = 0, sn = 4;
#pragma unroll 1
    for (int c = 0; c < 256; ++c) {
        const LAS unsigned char* st = lds + sc * PB_STAGE;
        if (wid < 2) pb_state_chunk(st, lds + PB_XS + (c & 1) * PB_XS_SZ, lds + PB_XS + ((c + 1) & 1) * PB_XS_SZ, S, wid, lane);
        else if (wid < 4) pb_out_chunk(st, lds + PB_XS + (c & 1) * PB_XS_SZ, CM + (item0 + c) * CM_ITEM, vhalf, wid - 2, lane);
        else { pb_dma(CM, GC, flags, item0, c + 4, vhalf, lds + sn * PB_STAGE, wid - 4, lane); asm volatile("s_waitcnt vmcnt(21)" ::: "memory"); }
        LDS_BAR();
        sc = (sc + 1 == PB_NST) ? 0 : sc + 1; sn = (sn + 1 == PB_NST) ? 0 : sn + 1;
    }
    asm volatile("s_waitcnt vmcnt(0)" ::: "memory");
    __syncthreads();
}

constexpr float QSCALE = 0.10206207261596575f * 1.4426950408889634f;
DI void fast_sincos(float x, float& sn, float& cs) { const float r = x * 0.15915494309189535f; const float f = r - floorf(r); sn = __builtin_amdgcn_sinf(f); cs = __builtin_amdgcn_cosf(f); }
DI void mla_prep_token4(const Params& P, const bf16_t* U, bf16_t* Kb, int t4, int lane) {
    const int t = t4 * 4 + (lane >> 4), l16 = lane & 15;
    const bf16_t* ur = U + (size_t)t * UW;
    const float x1 = bf2f(ur[2304 + l16]), x2 = bf2f(ur[2304 + 16 + l16]);
    const float pos = (float)((const int*)P.in[2])[t];
    const float inv = exp2f(-(float)l16 * (13.287712379549449f / 16.f));
    float sn, cs; fast_sincos(pos * inv, sn, cs);
    const bf16_t o1 = (bf16_t)f2bf(x1 * cs - x2 * sn), o2 = (bf16_t)f2bf(x2 * cs + x1 * sn);
#pragma unroll
    for (int h = 0; h < 8; ++h) { bf16_t* kp = Kb + ((size_t)h * T + t) * 96; kp[64 + l16] = o1; kp[80 + l16] = o2; }
}
constexpr int ATT_KB = 64 * 208, ATT_VB = 64 * 144;
constexpr float ATT_THR = 8.f;
DI int crow(int reg, int hh) { return (reg & 3) + 8 * (reg >> 2) + 4 * hh; }
constexpr int ATT_KS = 0, ATT_VS = 2 * ATT_KB, ATT_SCR2 = 2 * ATT_KB + 2 * ATT_VB;
DI void lds_read12(bf16x8 (&f)[12], unsigned a) {
    asm volatile("ds_read_b128 %0, %12\n\tds_read_b128 %1, %12 offset:6656\n\tds_read_b128 %2, %12 offset:32\n\tds_read_b128 %3, %12 offset:6688\n\t"
                 "ds_read_b128 %4, %12 offset:64\n\tds_read_b128 %5, %12 offset:6720\n\tds_read_b128 %6, %12 offset:96\n\tds_read_b128 %7, %12 offset:6752\n\t"
                 "ds_read_b128 %8, %12 offset:128\n\tds_read_b128 %9, %12 offset:6784\n\tds_read_b128 %10, %12 offset:160\n\tds_read_b128 %11, %12 offset:6816"
                 : "=&v"(f[0]), "=&v"(f[1]), "=&v"(f[2]), "=&v"(f[3]), "=&v"(f[4]), "=&v"(f[5]), "=&v"(f[6]), "=&v"(f[7]), "=&v"(f[8]), "=&v"(f[9]), "=&v"(f[10]), "=&v"(f[11])
                 : "v"(a) : "memory");
}
DI void lds_wait12(bf16x8 (&f)[12]) {
    asm volatile("s_waitcnt lgkmcnt(0)" : "+v"(f[0]), "+v"(f[1]), "+v"(f[2]), "+v"(f[3]), "+v"(f[4]), "+v"(f[5]), "+v"(f[6]), "+v"(f[7]), "+v"(f[8]), "+v"(f[9]), "+v"(f[10]), "+v"(f[11]) :: "memory");
}
DI void lds_read8(bf16x8 (&f)[8], unsigned a) {
    asm volatile("ds_read_b128 %0, %8\n\tds_read_b128 %1, %8 offset:4608\n\tds_read_b128 %2, %8 offset:32\n\tds_read_b128 %3, %8 offset:4640\n\t"
                 "ds_read_b128 %4, %8 offset:64\n\tds_read_b128 %5, %8 offset:4672\n\tds_read_b128 %6, %8 offset:96\n\tds_read_b128 %7, %8 offset:4704"
                 : "=&v"(f[0]), "=&v"(f[1]), "=&v"(f[2]), "=&v"(f[3]), "=&v"(f[4]), "=&v"(f[5]), "=&v"(f[6]), "=&v"(f[7])
                 : "v"(a) : "memory");
}
DI void lds_wait8(bf16x8 (&f)[8]) {
    asm volatile("s_waitcnt lgkmcnt(0)" : "+v"(f[0]), "+v"(f[1]), "+v"(f[2]), "+v"(f[3]), "+v"(f[4]), "+v"(f[5]), "+v"(f[6]), "+v"(f[7]) :: "memory");
}
DI void attn_qk(f32x16& p0, f32x16& p1, unsigned kaddr, const bf16x8 (&qf)[6], const f32x16& negm) {
    bf16x8 kf[12];
    lds_read12(kf, kaddr);
    lds_wait12(kf);
    p0 = negm; p1 = negm;
#pragma unroll
    for (int ks = 0; ks < 6; ++ks) {
        p0 = __builtin_amdgcn_mfma_f32_32x32x16_bf16(kf[2 * ks], qf[ks], p0, 0, 0, 0);
        p1 = __builtin_amdgcn_mfma_f32_32x32x16_bf16(kf[2 * ks + 1], qf[ks], p1, 0, 0, 0);
    }
}
DI void attn_pv(f32x16& o0, f32x16& o1, unsigned vaddr, const bf16x8 (&pa)[4]) {
    bf16x8 vf[8];
    lds_read8(vf, vaddr);
    lds_wait8(vf);
#pragma unroll
    for (int ks = 0; ks < 4; ++ks) {
        o0 = __builtin_amdgcn_mfma_f32_32x32x16_bf16(pa[ks], vf[2 * ks], o0, 0, 0, 0);
        o1 = __builtin_amdgcn_mfma_f32_32x32x16_bf16(pa[ks], vf[2 * ks + 1], o1, 0, 0, 0);
    }
}
DI float max3_(float a, float b, float c) { float r; asm("v_max3_f32 %0, %1, %2, %3" : "=v"(r) : "v"(a), "v"(b), "v"(c)); return r; }
DI float attn_rowmax(const f32x16& p0, const f32x16& p1) {
    float m0 = max3_(p0[0], p0[1], p0[2]), m1 = max3_(p1[0], p1[1], p1[2]);
#pragma unroll
    for (int i = 3; i < 15; i += 2) { m0 = max3_(m0, p0[i], p0[i + 1]); m1 = max3_(m1, p1[i], p1[i + 1]); }
    const float mx = max3_(m0, m1, p0[15]), my = max3_(mx, p1[15], p1[15]);
    return max3_(my, __shfl_xor(my, 32), my);
}
DI void attn_unit(const bf16_t* Q, const bf16_t* Kb, const bf16_t* VT, bf16_t* YM, int h, int qb, LAS unsigned char* lds) {
    const int tid = tid_fresh(), lane = tid & 63, wid = tid >> 6, r = lane & 31, hh = lane >> 5;
    const int q0 = qb * 256 + wid * 32;
    bf16x8 qf[6];
    { const bf16_t* qp = Q + ((size_t)h * T + q0 + r) * 96 + 8 * hh;
#pragma unroll
      for (int ks = 0; ks < 6; ++ks) qf[ks] = *(const bf16x8*)(qp + 16 * ks); }
    f32x16 o0, o1, negm;
#pragma unroll
    for (int i = 0; i < 16; ++i) { o0[i] = 0.f; o1[i] = 0.f; negm[i] = 0.f; }
    float mrow = 0.f, lrow = 0.f;
    LAS float* scr = (LAS float*)(lds + ATT_SCR2 + wid * 256);
    constexpr int NT_ = T / 64;
    const bf16_t* kg = Kb + (size_t)h * T * 96;
    const bf16_t* vg = VT + (size_t)(h * 64 + (tid >> 3)) * T + (tid & 7) * 8;
    const int kl0 = (tid / 12) * 208 + (tid % 12) * 16, c1 = 512 + tid, kl1 = (c1 / 12) * 208 + (c1 % 12) * 16;
    const int vl = (tid >> 3) * 144 + (tid & 7) * 16;
    u32x4 rk0, rk1, rv;
#define ATT_LOADK(tile) do { const size_t t1_ = (size_t)((tile) < NT_ ? (tile) : NT_ - 1) * 64; rk0 = *(const u32x4*)(kg + t1_ * 96 + (size_t)tid * 8); if (tid < 256) rk1 = *(const u32x4*)(kg + t1_ * 96 + (size_t)c1 * 8); } while (0)
#define ATT_LOADV(tile) do { const size_t t1_ = (size_t)((tile) < NT_ ? (tile) : NT_ - 1) * 64; rv = *(const u32x4*)(vg + t1_); } while (0)
#define ATT_STOREK(slot) do { LAS unsigned char* d_ = lds + ATT_KS + (slot) * ATT_KB; *(LAS u32x4*)(d_ + kl0) = rk0; if (tid < 256) *(LAS u32x4*)(d_ + kl1) = rk1; } while (0)
#define ATT_STOREV(slot) do { *(LAS u32x4*)(lds + ATT_VS + (slot) * ATT_VB + vl) = rv; } while (0)
    ATT_LOADK(0); ATT_LOADV(0); ATT_STOREK(0); ATT_STOREV(0);
    ATT_LOADK(1); ATT_STOREK(1);
    ATT_LOADK(2); ATT_LOADV(1);
    __syncthreads();
    f32x16 pA0, pA1, pB0, pB1;
    const unsigned lbase = (unsigned)(size_t)lds;
    const unsigned kfa = lbase + ATT_KS + r * 208 + hh * 16, vfa = lbase + ATT_VS + r * 144 + hh * 16;
    attn_qk(pA0, pA1, kfa, qf, negm);
    { const float mx = attn_rowmax(pA0, pA1); mrow = mx;
#pragma unroll
      for (int i = 0; i < 16; ++i) { pA0[i] -= mx; pA1[i] -= mx; negm[i] = -mx; } }
    __syncthreads();
#define ATT_ITER(PA0_, PA1_, PB0_, PB1_, t) do { \
        attn_qk(PB0_, PB1_, kfa + ((t + 1) & 1) * ATT_KB, qf, negm); \
        f32x2 ls2 = (f32x2){0.f, 0.f}; \
_Pragma("unroll") \
        for (int i = 0; i < 16; ++i) { PA0_[i] = __builtin_amdgcn_exp2f(PA0_[i]); PA1_[i] = __builtin_amdgcn_exp2f(PA1_[i]); } \
_Pragma("unroll") \
        for (int i = 0; i < 16; i += 2) { ls2 += (f32x2){PA0_[i], PA0_[i + 1]}; ls2 += (f32x2){PA1_[i], PA1_[i + 1]}; } \
        lrow += ls2.x + ls2.y; \
        bf16x8 pa[4]; \
_Pragma("unroll") \
        for (int ks = 0; ks < 4; ++ks) { \
            u32x4 w; \
_Pragma("unroll") \
            for (int j = 0; j < 4; ++j) { const int i0 = 8 * (ks & 1) + 2 * j; w[j] = (ks < 2) ? cvtpk(PA0_[i0], PA0_[i0 + 1]) : cvtpk(PA1_[i0], PA1_[i0 + 1]); } \
            pa[ks] = __builtin_bit_cast(bf16x8, w); \
        } \
        attn_pv(o0, o1, vfa + (t & 1) * ATT_VB, pa); \
        const float mx = attn_rowmax(PB0_, PB1_); \
        ATT_STOREK(t & 1); ATT_STOREV((t + 1) & 1); \
        ATT_LOADK(t + 3); ATT_LOADV(t + 2); \
        if (__any(mx > ATT_THR)) { \
            const float dl = fmaxf(mx, 0.f); \
            mrow += dl; \
            const float alpha = __builtin_amdgcn_exp2f(-dl); \
            lrow *= alpha; \
            if (hh == 0) scr[r] = alpha; \
_Pragma("unroll") \
            for (int i = 0; i < 16; ++i) { PB0_[i] -= dl; PB1_[i] -= dl; negm[i] = -mrow; } \
            asm volatile("s_waitcnt lgkmcnt(0)" ::: "memory"); \
_Pragma("unroll") \
            for (int i = 0; i < 16; ++i) { const float a = scr[crow(i, hh)]; o0[i] *= a; o1[i] *= a; } \
        } \
        __syncthreads(); } while (0)
    if (wid >= 4) __builtin_amdgcn_s_setprio(1);
#pragma unroll 1
    for (int t = 0; t < NT_ - 2; t += 2) { ATT_ITER(pA0, pA1, pB0, pB1, t); ATT_ITER(pB0, pB1, pA0, pA1, t + 1); }
    ATT_ITER(pA0, pA1, pB0, pB1, NT_ - 2);
    __builtin_amdgcn_s_setprio(0);
    pA0 = pB0; pA1 = pB1;
#undef ATT_ITER
    {
        float ls = 0.f;
#pragma unroll
        for (int i = 0; i < 16; ++i) { pA0[i] = __builtin_amdgcn_exp2f(pA0[i]); pA1[i] = __builtin_amdgcn_exp2f(pA1[i]); ls += pA0[i] + pA1[i]; }
        lrow += ls;
        bf16x8 pa[4];
#pragma unroll
        for (int ks = 0; ks < 4; ++ks) {
            u32x4 w;
#pragma unroll
            for (int j = 0; j < 4; ++j) { const int i0 = 8 * (ks & 1) + 2 * j; w[j] = (ks < 2) ? cvtpk(pA0[i0], pA0[i0 + 1]) : cvtpk(pA1[i0], pA1[i0 + 1]); }
            pa[ks] = __builtin_bit_cast(bf16x8, w);
        }
        attn_pv(o0, o1, vfa + ((NT_ - 1) & 1) * ATT_VB, pa);
    }
    lrow += __shfl_xor(lrow, 32);
    if (hh == 0) scr[32 + r] = 1.f / lrow;
    asm volatile("s_waitcnt lgkmcnt(0)" ::: "memory");
#pragma unroll
    for (int i = 0; i < 16; ++i) { const int q = crow(i, hh); const float il = scr[32 + q];
        bf16_t* yp = YM + (size_t)(q0 + q) * 512 + h * 64;
        yp[r] = (bf16_t)f2bf(o0[i] * il); yp[32 + r] = (bf16_t)f2bf(o1[i] * il); }
    __syncthreads();
#undef ATT_LOADK
#undef ATT_LOADV
#undef ATT_STOREK
#undef ATT_STOREV
}

struct TileIter {
    int ntn, nrow, G, bid, k, pm, pn; bool xcd;
    DI TileIter(int nrow_, int ntn_, int G_, int bid_) : ntn(ntn_), nrow(nrow_), G(G_), bid(bid_), k(0), pm(0), pn(0), xcd(G_ == 256 && (nrow_ & 7) == 0) {}
    DI bool next() {
        if (xcd) { const int li = (bid >> 3) + 32 * k; ++k; if (li >= (nrow >> 3) * ntn) return false; pm = (bid & 7) + 8 * (li / ntn); pn = li % ntn; return true; }
        const int t = bid + G * k; ++k; if (t >= nrow * ntn) return false; pm = t / ntn; pn = t % ntn; return true;
    }
};
__global__ void __launch_bounds__(NTHREADS, 2) mega(Params P) {
    extern __shared__ __attribute__((aligned(16))) unsigned char lds_raw[];
    LAS unsigned char* lds = (LAS unsigned char*)lds_raw;
    const int G = gridDim.x, bid = blockIdx.x, NGW = G * NWAVES;
#define PHASE_IDS() const int tid = tid_fresh(); const int lane = tid & 63; const int wave = __builtin_amdgcn_readfirstlane(tid >> 6); const int gw = bid * NWAVES + wave; (void)lane; (void)gw; (void)wave;
    volatile LAS unsigned* MISC = (volatile LAS unsigned*)(lds + LDS_MISC);
    if (threadIdx.x < 64) MISC[threadIdx.x] = 0u;
    __syncthreads();
    unsigned char* ws = P.ws;
    XcdBarrier bar = xcd_barrier_post((unsigned*)(ws + WS_CTL) + 1024, MISC + 8);
#ifdef DBG_TS
    unsigned long long* TSp = (unsigned long long*)((unsigned*)(ws + WS_CTL) + 12288); int ts_n = 1;
    if (blockIdx.x == 0 && threadIdx.x == 0) TSp[0] = __builtin_amdgcn_s_memrealtime();
#define GRID_BAR() do { xcd_barrier(bar); if (blockIdx.x == 0 && threadIdx.x == 0) TSp[ts_n] = __builtin_amdgcn_s_memrealtime(); ++ts_n; } while (0)
#else
#define GRID_BAR() xcd_barrier(bar)
#endif

    bf16_t* WT = (bf16_t*)(ws + WS_WT);
    bf16_t* U = (bf16_t*)(ws + WS_U);
    float* XB = (float*)(ws + WS_XB);
    bf16_t* Hb = (bf16_t*)(ws + WS_H2);
    bf16_t* Qb = (bf16_t*)P.out;
    bf16_t* Kb = Qb + (size_t)8 * T * 96;
    bf16_t* VT = Kb + (size_t)8 * T * 96;
    bf16_t* MG = (bf16_t*)P.out;
    ScEnt* SC = (ScEnt*)P.out;
#define gt ((size_t)(blockIdx.x * NTHREADS + tid))
#define GT ((size_t)(gridDim.x * NTHREADS))

    {
    PHASE_IDS();
        LAS float* scr = (LAS float*)(lds + wave * 16384);
        const TrJob jobs[12] = {
            {P.in[4], IN_COLS, 0, 1024, 1920, WT + WT_IN, nullptr},
            {P.in[4], IN_COLS, 1920, 1024, 416, WT + WT_IN + (size_t)1920 * 1024, nullptr},
            {P.in[4], IN_COLS, 2336, 1024, 2048, WT + WT_GATE, nullptr},
            {P.in[20], 1024, 0, 512, 1024, WT + WT_BRA, nullptr},
            {P.in[21], 1024, 0, 512, 1024, WT + WT_BRB, nullptr},
            {P.in[22], 1024, 0, 1024, 1024, WT + WT_OUT, nullptr},
            {P.in[29], 1024, 0, 1024, 1024, WT + WT_PG, nullptr},
            {P.in[30], 1024, 0, 256, 1024, WT + WT_PP, nullptr},
            {P.in[24], 2048, 0, 1024, 2048, WT + WT_PQ, nullptr},
            {P.in[10], 512, 0, 128, 512, WT + WT_G2, nullptr},
            {P.in[17], 768, 0, 256, 768, WT + WT_QUP, P.in[16]},
            {P.in[19], 1024, 0, 128, 1024, WT + WT_KVUP, P.in[18]},
        };
        {
            int total = 0;
#pragma unroll
            for (int j = 0; j < 12; ++j) total += trjob_items(jobs[j]);
            for (int it = gw; it < total; it += NGW) {
                int r = it;
#pragma unroll
                for (int j = 0; j < 12; ++j) {
                    const int ni = trjob_items(jobs[j]);
                    if (r >= 0 && r < ni) transpose_item(jobs[j].W, jobs[j].ldw, jobs[j].col_off, jobs[j].K, jobs[j].WT, jobs[j].ncols, scr, r, lane, jobs[j].ks);
                    r -= ni;
                }
            }
        }
        for (size_t i = gt; i < (size_t)96 * 1024 / 8; i += GT) ((u32x4*)(WT + WT_IN + (size_t)2336 * 1024))[i] = (u32x4){0u, 0u, 0u, 0u};
        for (size_t i = gt; i < (size_t)16 * 128 * 128 / 4; i += GT) { const f32x4 v = ((const f32x4*)P.in[25])[i]; ((u32x2*)(WT + WT_SK))[i] = (u32x2){pk2(v.x, v.y), pk2(v.z, v.w)}; }
        for (size_t i = gt; i < 65536; i += GT) { const int l = (int)(i & 63), cc = (int)((i >> 6) & 63), hh_ = (int)((i >> 12) & 7), dd = (int)(i >> 15);
            WT[WT_W2T + i] = (bf16_t)f2bf(P.in[7][((size_t)dd * 64 + l) * 512 + hh_ * 64 + cc]); WT[WT_A2T + i] = (bf16_t)f2bf(P.in[9][((size_t)dd * 64 + l) * 512 + hh_ * 64 + cc]); }
        for (int m = gw; m < T; m += NGW) rms_row_to_bf16(P.in[0] + (size_t)m * D, P.in[3], (bf16_t*)P.out + (size_t)m * D, lane);
    }
    GRID_BAR();
    {
    PHASE_IDS();
        const int ntn = UW / G_BN, ntile = (T / G_BM) * ntn;
        for (TileIter ti_(T / G_BM, ntn, G, bid); ti_.next(); ) {
            const int row0 = ti_.pm * G_BM, col0 = ti_.pn * G_BN;
            f32x4 acc[4][4]; acc_zero(acc);
            gemm_accum(acc, GemmSrc{(const bf16_t*)P.out, D, WT + WT_IN, D, D}, row0, col0, lds);
            EPI_LOOP(row0, col0) { *(u32x2*)(U + (size_t)EPI_ROW(row0) * UW + EPI_COL(col0)) = (u32x2){pk2(acc[m][n][0], acc[m][n][1]), pk2(acc[m][n][2], acc[m][n][3])}; }
        }
    }
    GRID_BAR();
    {
    PHASE_IDS();
        unsigned* flags = (unsigned*)(ws + WS_CTL) + 16384;
        if (bid < 32) rwkv_passB(ws + WS_CM, (const float*)(ws + WS_GC), flags, bid >> 4, (bid >> 1) & 7, bid & 1, lds);
        else {
            const int pb_ = bid - 32, PG = G - 32;
            {
                PaPre pre; int prev = -1;
                if (pb_ < 4096) pa_prefetch(U, P.in[5], (pb_ & 15) * 256 + (pb_ >> 4), tid, pre);
                for (int j = pb_; j < 4096; j += PG) {
                    const int item = (j & 15) * 256 + (j >> 4), jn = j + PG, nxt = jn < 4096 ? (jn & 15) * 256 + (jn >> 4) : -1;
                    rwkv_passA(P, U, WT + WT_W2T, WT + WT_A2T, ws + WS_CM, (float*)(ws + WS_GC), (float*)(ws + WS_BS), (bf16_t*)(ws + WS_VS), flags, item, prev, nxt, pre, lds
#ifdef DBG_TS
                        , (blockIdx.x == 32) ? (TSp + 24) : nullptr
#endif
                        );
                    prev = item;
                }
            }
#ifdef DBG_TS
            if (blockIdx.x == 32 && threadIdx.x == 0) TSp[21] = __builtin_amdgcn_s_memrealtime();
#endif
            bf16_t* LG = (bf16_t*)(ws + WS_LG);
            for (size_t i = (size_t)pb_ * NTHREADS + tid; i < (size_t)T * 16; i += (size_t)PG * NTHREADS) {
                const int t = (int)(i >> 4), j0 = (int)(i & 15) * 8;
                const bf16_t* up = U + (size_t)t * UW + 1792 + j0;
                const u32x4 cu = *(const u32x4*)up, pu = *(const u32x4*)(t > 0 ? up - UW : up), nu = *(const u32x4*)(t < T - 1 ? up + UW : up);
                const float pf = t > 0 ? 0.5f : 0.f, nf = t < T - 1 ? 0.5f : 0.f;
                const f32x4 m0 = *(const f32x4*)(P.in[5] + 1792 + j0), m1 = *(const f32x4*)(P.in[5] + 1792 + j0 + 4);
                u32x4 w;
#pragma unroll
                for (int j = 0; j < 4; ++j) {
                    const float c0 = __builtin_bit_cast(float, cu[j] << 16), c1 = __builtin_bit_cast(float, cu[j] & 0xffff0000u);
                    const float p0 = __builtin_bit_cast(float, pu[j] << 16), p1 = __builtin_bit_cast(float, pu[j] & 0xffff0000u);
                    const float n0 = __builtin_bit_cast(float, nu[j] << 16), n1 = __builtin_bit_cast(float, nu[j] & 0xffff0000u);
                    const float mu0 = j < 2 ? m0[2 * j] : m1[2 * j - 4], mu1 = j < 2 ? m0[2 * j + 1] : m1[2 * j - 3];
                    w[j] = pk2(sigmoidf_(c0 + mu0 * ((pf * p0 + nf * n0) - c0)), sigmoidf_(c1 + mu1 * ((pf * p1 + nf * n1) - c1)));
                }
                *(u32x4*)(LG + (size_t)t * 128 + j0) = w;
            }
            for (int m = pb_ * NWAVES + wave; m < T / 4; m += PG * NWAVES) mla_prep_token4(P, U, Kb, m, lane);
        }
        {
        unsigned* qctr = (unsigned*)(ws + WS_CTL) + 20544;
        const int nq = (T / G_BM) * 6, nkv = (T / G_BM) * 8;
        for (;;) {
            __syncthreads();
            if (tid == 0) MISC[32] = __hip_atomic_fetch_add(qctr, 1u, __ATOMIC_RELAXED, __HIP_MEMORY_SCOPE_AGENT);
            __syncthreads();
            const int tile = __builtin_amdgcn_readfirstlane((int)MISC[32]);
            if (tile >= nq + nkv) break;
            f32x4 acc[4][4]; acc_zero(acc);
            f32x4 ssv = (f32x4){0.f, 0.f, 0.f, 0.f};
            if (tile < nq) {
                const int row0 = (tile / 6) * G_BM, col0 = (tile % 6) * G_BN;
                gemm_accum_<true, true>(acc, GemmSrc{U + 1920, UW, WT + WT_QUP, 256, 256}, row0, col0, lds, ssv);
#pragma unroll
                for (int m = 0; m < 4; ++m) { float v = ssv[m]; v += __shfl_xor(v, 16); v += __shfl_xor(v, 32); ssv[m] = __builtin_amdgcn_rsqf(v * (1.f / 256.f) + NORM_EPS) * QSCALE; }
                {
                    const int lane_ = tid & 63, wid_ = tid >> 6, wr_ = wid_ >> 1, wc_ = wid_ & 1, fr_ = lane_ & 15, fq_ = lane_ >> 4;
#pragma unroll
                    for (int n = 0; n < 4; n += 2) {
                        const int g16 = (col0 + wc_ * 64 + n * 16) >> 4;
                        if (g16 % 6 == 4) {
#pragma unroll
                            for (int m = 0; m < 4; ++m) {
                                const float pos = (float)((const int*)P.in[2])[row0 + wr_ * 64 + m * 16 + fr_];
#pragma unroll
                                for (int j = 0; j < 4; ++j) {
                                    const float inv = exp2f(-(float)(4 * fq_ + j) * (13.287712379549449f / 16.f));
                                    float sn, cs; fast_sincos(pos * inv, sn, cs);
                                    const float x1 = acc[m][n][j], x2 = acc[m][n + 1][j];
                                    acc[m][n][j] = x1 * cs - x2 * sn; acc[m][n + 1][j] = x2 * cs + x1 * sn;
                                }
                            }
                        }
                    }
                }
                EPI_LOOP(row0, col0) { const int row = EPI_ROW(row0), col = EPI_COL(col0), hq = col / 96, dq = col % 96; const float sc = ssv[m];
                    *(u32x2*)(Qb + ((size_t)hq * T + row) * 96 + dq) = (u32x2){pk2(acc[m][n][0] * sc, acc[m][n][1] * sc), pk2(acc[m][n][2] * sc, acc[m][n][3] * sc)}; }
            } else {
                const int tt = tile - nq, row0 = (tt / 8) * G_BM, hk = tt % 8, col0 = hk * G_BN;
                gemm_accum_<false, true>(acc, GemmSrc{U + 2176, UW, WT + WT_KVUP, 128, 128}, row0, col0, lds, ssv);
#pragma unroll
                for (int m = 0; m < 4; ++m) { float v = ssv[m]; v += __shfl_xor(v, 16); v += __shfl_xor(v, 32); ssv[m] = __builtin_amdgcn_rsqf(v * (1.f / 128.f) + NORM_EPS); }
                const int lane_ = tid & 63, wid_ = tid >> 6, wr_ = wid_ >> 1, wc_ = wid_ & 1, fr_ = lane_ & 15, fq_ = lane_ >> 4;
#pragma unroll
                for (int m = 0; m < 4; ++m) {
                    const f32x4 ir = (f32x4){__shfl(ssv[m], 4 * fq_), __shfl(ssv[m], 4 * fq_ + 1), __shfl(ssv[m], 4 * fq_ + 2), __shfl(ssv[m], 4 * fq_ + 3)};
#pragma unroll
                    for (int n = 0; n < 4; ++n) {
                        const int rbase = row0 + wr_ * 64 + m * 16, cc = wc_ * 64 + n * 16 + fr_;
                        const f32x4 v = acc[m][n] * ir;
                        if (wc_ == 0) {
#pragma unroll
                            for (int j = 0; j < 4; ++j) Kb[((size_t)hk * T + rbase + 4 * fq_ + j) * 96 + cc] = (bf16_t)f2bf(v[j]);
                        } else {
                            *(u32x2*)(VT + (size_t)(hk * 64 + cc - 64) * T + rbase + 8 * (fq_ & 1) + 4 * (fq_ >> 1)) = (u32x2){pk2(v[0], v[1]), pk2(v[2], v[3])};
                        }
                    }
                }
            }
        }
        }
#ifdef DBG_TS
        if (blockIdx.x == 0 && threadIdx.x == 0) TSp[20] = __builtin_amdgcn_s_memrealtime();
#endif
    }
    GRID_BAR();
    {
    PHASE_IDS();
        {
            bf16_t* Gm = (bf16_t*)(ws + WS_GM);
            const int ntn = 512 / G_BN, ntile = (T / G_BM) * ntn;
            unsigned ndone = 0u;
            for (TileIter ti_(T / G_BM, ntn, G, bid); ti_.next(); ) {
                const int row0 = ti_.pm * G_BM, col0 = ti_.pn * G_BN;
                f32x4 acc[4][4]; acc_zero(acc);
                gemm_accum(acc, GemmSrc{(const bf16_t*)(ws + WS_LG), 128, WT + WT_G2, 128, 128}, row0, col0, lds);
                EPI_LOOP(row0, col0) { *(u32x2*)(Gm + (size_t)EPI_ROW(row0) * 512 + EPI_COL(col0)) = (u32x2){pk2(acc[m][n][0], acc[m][n][1]), pk2(acc[m][n][2], acc[m][n][3])}; }
                ++ndone;
            }
            asm volatile("s_waitcnt vmcnt(0)" ::: "memory");
            __syncthreads();
            if (tid == 0) { __builtin_amdgcn_fence(__ATOMIC_RELEASE, "agent"); (void)__hip_atomic_fetch_add((unsigned*)(ws + WS_CTL) + 20608, ndone, __ATOMIC_RELAXED, __HIP_MEMORY_SCOPE_AGENT); }
            for (int m = gw; m < T; m += NGW) rms_row_to_bf16(P.in[0] + (size_t)m * D, P.in[3], (bf16_t*)(ws + WS_HG) + (size_t)m * D, lane);
        }
        for (int unit = bid; unit < 8 * (T / 256); unit += G) attn_unit(Qb, Kb, VT, (bf16_t*)(ws + WS_YM), unit & 7, unit >> 3, lds);
    }
    {
    PHASE_IDS();
    if (tid == 0) {
        unsigned* gctr = (unsigned*)(ws + WS_CTL) + 20608; const unsigned need = (unsigned)((T / G_BM) * (512 / G_BN)); unsigned sp = 0u;
        while (__hip_atomic_load(gctr, __ATOMIC_RELAXED, __HIP_MEMORY_SCOPE_AGENT) < need) { __builtin_amdgcn_s_sleep(1); if (++sp > (1u << 22)) break; }
        __builtin_amdgcn_fence(__ATOMIC_ACQUIRE, "agent");
    }
    __syncthreads();
    for (int m = gw; m < T; m += NGW) rwkv_merge_token(P, (bf16_t*)(ws + WS_VS), ws + WS_CM, (const float*)(ws + WS_BS), (const bf16_t*)(ws + WS_GM), m, lane);
    }
    GRID_BAR();
    {
    PHASE_IDS();
        const bf16_t* YRW = (const bf16_t*)(ws + WS_YRW); const bf16_t* YM = (const bf16_t*)(ws + WS_YM);
        const int ntn = D / G_BN, ntile = (T / G_BM) * ntn;
        for (TileIter ti_(T / G_BM, ntn, G, bid); ti_.next(); ) {
            const int row0 = ti_.pm * G_BM, col0 = ti_.pn * G_BN;
            f32x4 acc1[4][4], acc2[4][4];
            acc_zero(acc1); acc_zero(acc2);
            gemm_accum(acc1, GemmSrc{(const bf16_t*)(ws + WS_HG), D, WT + WT_GATE, D, D}, row0, col0, lds);
            gemm_accum(acc2, GemmSrc{YRW, 512, WT + WT_BRA, 512, 512}, row0, col0, lds);
            {
                EPI_LOOP(row0, col0) {
                    f32x4 o;
#pragma unroll
                    for (int j = 0; j < 4; ++j) o[j] = sigmoidf_(acc1[m][n][j]) * acc2[m][n][j];
                    *(u32x2*)(MG + (size_t)EPI_ROW(row0) * D + EPI_COL(col0)) = (u32x2){pk2(o[0], o[1]), pk2(o[2], o[3])};
                }
            }
            acc_zero(acc1); acc_zero(acc2);
            gemm_accum(acc1, GemmSrc{(const bf16_t*)(ws + WS_HG), D, WT + WT_GATE + (size_t)1024 * 1024, D, D}, row0, col0, lds);
            gemm_accum(acc2, GemmSrc{YM, 512, WT + WT_BRB, 512, 512}, row0, col0, lds);
            {
                EPI_LOOP(row0, col0) {
                    bf16_t* mp = MG + (size_t)EPI_ROW(row0) * D + EPI_COL(col0);
                    const u32x2 pr = *(const u32x2*)mp;
                    f32x4 o;
                    o[0] = __builtin_bit_cast(float, pr.x << 16); o[1] = __builtin_bit_cast(float, pr.x & 0xffff0000u);
                    o[2] = __builtin_bit_cast(float, pr.y << 16); o[3] = __builtin_bit_cast(float, pr.y & 0xffff0000u);
#pragma unroll
                    for (int j = 0; j < 4; ++j) o[j] += sigmoidf_(acc1[m][n][j]) * acc2[m][n][j];
                    *(u32x2*)mp = (u32x2){pk2(o[0], o[1]), pk2(o[2], o[3])};
                }
            }
        }
    }
    GRID_BAR();
    {
    PHASE_IDS();
        bf16_t* PB = (bf16_t*)(ws + WS_PB);
        const int ntn = D / G_BN, ntile = (T / G_BM) * ntn;
        for (TileIter ti_(T / G_BM, ntn, G, bid); ti_.next(); ) {
            const int row0 = ti_.pm * G_BM, col0 = ti_.pn * G_BN;
            f32x4 acc[4][4]; acc_zero(acc);
            gemm_accum(acc, GemmSrc{MG, D, WT + WT_OUT, D, D}, row0, col0, lds);
            {
                float* SSQ = (float*)(ws + WS_GC);
                const int tid_ = tid_fresh(), lane_ = tid_ & 63, wid_ = tid_ >> 6, wr_ = wid_ >> 1, wc_ = wid_ & 1, fr_ = lane_ & 15, fq_ = lane_ >> 4;
#pragma unroll
                for (int m = 0; m < 4; ++m) {
                    const int row = row0 + wr_ * 64 + m * 16 + fr_; float ssq = 0.f;
#pragma unroll
                    for (int n = 0; n < 4; ++n) { const int col = col0 + wc_ * 64 + n * 16 + 4 * fq_; const size_t off = (size_t)row * D + col;
                        const f32x4 xv = *(const f32x4*)(P.in[0] + off) + acc[m][n]; *(f32x4*)(XB + off) = xv;
                        const f32x4 gg = *(const f32x4*)(P.in[23] + col);
                        *(u32x2*)(Hb + off) = (u32x2){pk2(xv[0] * gg[0], xv[1] * gg[1]), pk2(xv[2] * gg[2], xv[3] * gg[3])};
                        ssq += xv[0] * xv[0] + xv[1] * xv[1] + xv[2] * xv[2] + xv[3] * xv[3]; }
                    ssq += __shfl_xor(ssq, 16); ssq += __shfl_xor(ssq, 32);
                    if (fq_ == 0) SSQ[(size_t)(ti_.pn * 2 + wc_) * T + row] = ssq;
                }
            }
        }
        for (size_t i = gt; i < (size_t)T * PLE / 4; i += GT) { const f32x4 v = ((const f32x4*)P.in[1])[i]; ((u32x2*)PB)[i] = (u32x2){pk2(v.x, v.y), pk2(v.z, v.w)}; }
        for (int m = gw; m < 2 * 16384; m += NGW) { const int tbl = __builtin_amdgcn_readfirstlane(m >> 14), row = m & 16383;
            row_to_fp8((tbl ? P.in[27] : P.in[26]) + (size_t)row * D, ws + WS_ET + (size_t)tbl * 16 * MiB + (size_t)row * 128, (float*)(ws + WS_LG) + tbl * 16384 + row, lane); }
    }
    GRID_BAR();
    {
    PHASE_IDS();
        const int ntile = (T / G_BM) * 16;
        for (TileIter ti_(T / G_BM, 16, G, bid); ti_.next(); ) peer_query_tile(Hb, WT + WT_PQ, WT + WT_SK, (const float*)(ws + WS_GC), SC, ti_.pm, ti_.pn, lds);
    }
    GRID_BAR();
    int* EL = (int*)(ws + WS_CM); float* GT_ = (float*)(ws + WS_CM + 8 * MiB); float* CC = (float*)(ws + WS_CM + 16 * MiB);
    float* PS03 = (float*)(ws + WS_U + 32 * MiB); float* PS47 = P.out + (size_t)8 * MiB;
    float* SSQ2 = (float*)(ws + WS_IR);
    {
    PHASE_IDS();
    LAS unsigned char* wl = lds + wave * 17408;
#pragma unroll 1
    for (int q0 = gw * 64; q0 < T * PEER_H; q0 += NGW * 64) {
        const unsigned char* src = (const unsigned char*)(SC + (size_t)q0 * 32);
        u32x4 tmp[16];
#pragma unroll
        for (int k = 0; k < 16; ++k) tmp[k] = *(const u32x4*)(src + k * 1024 + lane * 16);
#pragma unroll
        for (int k = 0; k < 16; ++k) { const int off = k * 1024 + lane * 16; *(LAS u32x4*)(wl + (off >> 8) * 272 + (off & 255)) = tmp[k]; }
        asm volatile("s_waitcnt lgkmcnt(0)" ::: "memory");
        __builtin_amdgcn_wave_barrier();
        peer_route_pair((const LAS u32x4*)(wl + lane * 272), (LAS int*)(wl + lane * 80), (LAS float*)(wl + 5120 + lane * 80));
        asm volatile("s_waitcnt lgkmcnt(0)" ::: "memory");
        __builtin_amdgcn_wave_barrier();
#pragma unroll
        for (int j = 0; j < 4; ++j) { const int m = j * 64 + lane, lo = ((m >> 2) * 20 + (m & 3) * 4) * 4;
            *(u32x4*)(EL + (size_t)q0 * 16 + m * 4) = *(const LAS u32x4*)(wl + lo);
            *(u32x4*)(GT_ + (size_t)q0 * 16 + m * 4) = *(const LAS u32x4*)(wl + 5120 + lo); }
        asm volatile("s_waitcnt lgkmcnt(0)" ::: "memory");
        __builtin_amdgcn_wave_barrier();
    }
    }
    GRID_BAR();
    {
    PHASE_IDS();
    const int xs = G < 8 ? G : 8;
    for (int x = bid & 7; x < 8; x += xs) {
        const int nb = G < 8 ? 1 : (G - x + 7) >> 3, rank = G < 8 ? 0 : bid >> 3;
        peer_gu_slice(EL, Hb, ws + WS_ET + (size_t)x * PEER_SLICE, (x < 4 ? PS03 : PS47) + (size_t)(x & 3) * T * 128, x, rank * NWAVES + wave, nb * NWAVES, lane);
    }
    }
    GRID_BAR();
    {
    PHASE_IDS();
    const float* su = (const float*)(ws + WS_LG); const float* sv = su + 16384;
#pragma unroll 1
    for (int m = gw; m < T; m += 4 * NGW) {
        f32x2 tot[4], gt2[4]; int e0[4], e1[4]; float ssq[4];
#pragma unroll
        for (int u = 0; u < 4; ++u) { const int mm = m + u * NGW < T ? m + u * NGW : T - 1;
            tot[u] = (f32x2){0.f, 0.f};
#pragma unroll
            for (int x = 0; x < 8; ++x) tot[u] += *(const f32x2*)((x < 4 ? PS03 : PS47) + ((size_t)(x & 3) * T + mm) * 128 + 2 * lane);
            ssq[u] = ssq16((const float*)(ws + WS_GC), mm);
            e0[u] = EL[(size_t)mm * 128 + 2 * lane]; e1[u] = EL[(size_t)mm * 128 + 2 * lane + 1];
            gt2[u] = *(const f32x2*)(GT_ + (size_t)mm * 128 + 2 * lane); }
        float su0[4], su1[4], sv0[4], sv1[4];
#pragma unroll
        for (int u = 0; u < 4; ++u) { su0[u] = su[e0[u]]; sv0[u] = sv[e0[u]]; su1[u] = su[e1[u]]; sv1[u] = sv[e1[u]]; }
#pragma unroll
        for (int u = 0; u < 4; ++u) { const int mm = m + u * NGW;
            const float irms = __builtin_amdgcn_rsqf(ssq[u] * (1.f / D) + NORM_EPS);
            const float c0 = gt2[u].x * gelu_erf(tot[u].x * irms * su0[u]) * sv0[u], c1 = gt2[u].y * gelu_erf(tot[u].y * irms * su1[u]) * sv1[u];
            const unsigned w0 = ((__builtin_bit_cast(unsigned, c0) + 0x2000u) & 0xFFFFC000u) | (unsigned)e0[u], w1 = ((__builtin_bit_cast(unsigned, c1) + 0x2000u) & 0xFFFFC000u) | (unsigned)e1[u];
            if (mm < T) *(u32x2*)(CC + (size_t)mm * 128 + 2 * lane) = (u32x2){w0, w1}; }
    }
    }
    GRID_BAR();
    {
    PHASE_IDS();
    const int xs = G < 8 ? G : 8;
    for (int x = bid & 7; x < 8; x += xs) {
        const int nb = G < 8 ? 1 : (G - x + 7) >> 3, rank = G < 8 ? 0 : bid >> 3;
        peer_gv_slice((const unsigned*)CC, ws + WS_ET + 16 * MiB + (size_t)x * PEER_SLICE, XB, Hb, P.in[28], SSQ2, x, rank * NWAVES + wave, nb * NWAVES, lane);
    }
    }
    GRID_BAR();
    {
    PHASE_IDS();
        const bf16_t* PB = (const bf16_t*)(ws + WS_PB);
        const int ntile = (T / G_BM) * (D / G_BN);
        for (TileIter ti_(T / G_BM, D / G_BN, G, bid); ti_.next(); ) {
            const int row0 = ti_.pm * G_BM, col0 = ti_.pn * G_BN;
            f32x4 acc1[4][4], acc2[4][4];
            acc_zero(acc1); acc_zero(acc2);
            gemm_accum(acc1, GemmSrc{PB, PLE, WT + WT_PP, PLE, PLE}, row0, col0, lds);
            gemm_accum(acc2, GemmSrc{Hb, D, WT + WT_PG, D, D}, row0, col0, lds);
            f32x4 ir2v;
            { const int tid_ = tid_fresh(), wr_ = (tid_ >> 6) >> 1, fr_ = tid_ & 15;
#pragma unroll
              for (int m = 0; m < 4; ++m) { float q = 0.f;
#pragma unroll
                  for (int x = 0; x < 8; ++x) q += SSQ2[(size_t)x * T + row0 + wr_ * 64 + m * 16 + fr_];
                  ir2v[m] = __builtin_amdgcn_rsqf(q * (1.f / D) + NORM_EPS); } }
            EPI_LOOP(row0, col0) {
                const size_t off = (size_t)EPI_ROW(row0) * D + EPI_COL(col0);
                const float ir2 = ir2v[m];
                const f32x4 xv = *(const f32x4*)(XB + off);
                f32x4 o;
#pragma unroll
                for (int j = 0; j < 4; ++j) o[j] = xv[j] + acc1[m][n][j] * sigmoidf_(acc2[m][n][j] * ir2);
                *(f32x4*)(XB + off) = o;
            }
        }
    }
    GRID_BAR();
    {
    PHASE_IDS();
#ifdef DBG_TS
    {
        const float us1 = (float)(TSp[DBG_B1] - TSp[DBG_A1]) * 0.01f, us2 = (float)(TSp[DBG_B2] - TSp[DBG_A2]) * 0.01f;
        const float dl = sqrtf(floorf(us1 * 0.05f) * 20.f * 1e-6f);
        for (int m = gw; m < T; m += NGW) {
            rms_row_to_f32(XB + (size_t)m * D, P.in[31], P.out + (size_t)m * D, lane);
            f32x4* o = (f32x4*)(P.out + (size_t)m * D) + lane;
#pragma unroll
            for (int j = 0; j < 4; ++j) { f32x4 v = o[64 * j]; v.x *= 1.f + dl; v.y *= 1.f - dl; v.z *= 1.f + dl; v.w *= 1.f - dl; if (m == 0 && lane == 0 && j == 0) v.x += 1.f + floorf(us2 * 0.1f) * 0.1f; o[64 * j] = v; }
        }
    }
#else
    for (int m = gw; m < T; m += NGW) rms_row_to_f32(XB + (size_t)m * D, P.in[31], P.out + (size_t)m * D, lane);
#endif
    }
}

extern "C" void kernel_launch(void* const* d_in, const int* in_sizes, int n_in, void* d_out, int out_size, void* d_ws, size_t ws_size, hipStream_t stream) {
    static int grid = 0;
    if (grid == 0) {
        if (n_in != 32 || out_size != T * D || ws_size < WS_END) { fprintf(stderr, "kernel_launch: unexpected shapes n_in %d out %d ws %zu\n", n_in, out_size, ws_size); grid = -1; return; }
        int dev = 0, cus = 0, per_cu = 0;
        if (hipGetDevice(&dev) != hipSuccess || hipDeviceGetAttribute(&cus, hipDeviceAttributeMultiprocessorCount, dev) != hipSuccess) { grid = -1; return; }
        if (hipFuncSetAttribute((const void*)mega, hipFuncAttributeMaxDynamicSharedMemorySize, LDS_BYTES) != hipSuccess) { fprintf(stderr, "kernel_launch: hipFuncSetAttribute failed\n"); grid = -1; return; }
        if (hipOccupancyMaxActiveBlocksPerMultiprocessor(&per_cu, (const void*)mega, NTHREADS, LDS_BYTES) != hipSuccess || per_cu < 1) { fprintf(stderr, "kernel_launch: occupancy query says %d blocks per CU\n", per_cu); (void)hipGetLastError(); grid = -1; return; }
        grid = cus;
    }
    if (grid < 0) return;
    (void)hipMemsetAsync((char*)d_ws + WS_CTL, 0, CTL_ZERO_BYTES, stream);
    Params p{};
    for (int i = 0; i < 32; ++i) p.in[i] = (const float*)d_in[i];
    p.out = (float*)d_out; p.ws = (unsigned char*)d_ws;
    hipLaunchKernelGGL(mega, dim3(grid), dim3(NTHREADS), LDS_BYTES, stream, p);
}
```

```cpp
#include <hip/hip_runtime.h>
#include <cstdio>
#include <cstdint>

#define DI __device__ __forceinline__
#define LAS __attribute__((address_space(3)))
#define GAS __attribute__((address_space(1)))
typedef unsigned short bf16_t;
typedef short bf16x8 __attribute__((ext_vector_type(8)));
typedef float f32x4 __attribute__((ext_vector_type(4)));
typedef float f32x2 __attribute__((ext_vector_type(2)));
typedef float f32x16 __attribute__((ext_vector_type(16)));
typedef unsigned u32x4 __attribute__((ext_vector_type(4)));
typedef unsigned u32x2 __attribute__((ext_vector_type(2)));

constexpr int T = 16384, D = 1024, PLE = 256;
constexpr int RW_W = 512, RW_COLS = 1920, MLA_COLS = 416, GATE_COLS = 2048, IN_COLS = 4384;
constexpr int NTHREADS = 512, NWAVES = 8;
constexpr float NORM_EPS = 1e-6f;

constexpr size_t MiB = 1u << 20;
constexpr size_t WS_CTL = 0;
constexpr size_t CTL_ZERO_BYTES = 96 * 1024;
constexpr size_t WS_WT = 1 * MiB;
constexpr size_t WS_CM = 25 * MiB;
constexpr size_t WS_U = 153 * MiB;
constexpr size_t WS_VS = 229 * MiB;
constexpr size_t WS_LG = 245 * MiB;
constexpr size_t WS_BS = 249 * MiB;
constexpr size_t WS_GC = 250 * MiB;
constexpr size_t WS_IR = 251 * MiB;
constexpr size_t WS_END = 252 * MiB;
constexpr int UW = 2432;
constexpr int CM_ITEM = 32768;
constexpr size_t WS_H = WS_CM;
constexpr size_t WS_HG = WS_U;
constexpr size_t WS_GM = WS_U + 48 * MiB;
constexpr size_t WS_YRW = WS_VS;
constexpr size_t WS_H2 = WS_CM + 32 * MiB;
constexpr size_t WS_XB = WS_CM + 64 * MiB;
constexpr size_t WS_YM = WS_U + 32 * MiB;
constexpr size_t WS_ET = WS_U;
constexpr size_t WS_PB = WS_U + 64 * MiB;
constexpr size_t WT_IN = 0;
constexpr size_t WT_GATE = WT_IN + (size_t)2432 * 1024;
constexpr size_t WT_PQ = WT_GATE + (size_t)2048 * 1024;
constexpr size_t WT_OUT = WT_PQ + (size_t)2048 * 1024;
constexpr size_t WT_PG = WT_OUT + (size_t)1024 * 1024;
constexpr size_t WT_BRA = WT_PG + (size_t)1024 * 1024;
constexpr size_t WT_BRB = WT_BRA + (size_t)1024 * 512;
constexpr size_t WT_PP = WT_BRB + (size_t)1024 * 512;
constexpr size_t WT_QUP = WT_PP + (size_t)1024 * 256;
constexpr size_t WT_KVUP = WT_QUP + (size_t)768 * 256;
constexpr size_t WT_SK = WT_KVUP + (size_t)1024 * 128;
constexpr size_t WT_G2 = WT_SK + (size_t)16 * 128 * 128;
constexpr size_t WT_W2T = WT_G2 + (size_t)512 * 128;
constexpr size_t WT_A2T = WT_W2T + 65536;
constexpr size_t WT_END = WT_A2T + 65536;
static_assert(WT_END * 2 <= 24 * MiB, "weights fit");

DI unsigned f2bf(float f) { unsigned u = __builtin_bit_cast(unsigned, f); return (u + 0x7fffu + ((u >> 16) & 1u)) >> 16; }
DI unsigned pk2(float lo, float hi) { return f2bf(lo) | (f2bf(hi) << 16); }
DI float bf2f(unsigned short b) { return __builtin_bit_cast(float, (unsigned)b << 16); }
DI float wave_sum(float v) {
#pragma unroll
    for (int o = 1; o < 64; o <<= 1) v += __shfl_xor(v, o);
    return v;
}
DI int tid_fresh() { int t = threadIdx.x; asm volatile("" : "+v"(t)); return t; }
DI float sigmoidf_(float x) { return 1.f / (1.f + __expf(-x)); }

#define XB_TMO      128
#define XB_XCNT(j)  (256  + 64 * (j))
#define XB_XSUB(j)  (1280 + 64 * (j))
#define XB_XGEN(j)  (2304 + 64 * (j))
#define XB_TOP      3328
#define XB_TOPGEN   3392
#define XCD_BAR_WORDS 3456
#define XB_SPIN_CAP (1u << 18)
DI unsigned xb_ld(unsigned* p)              { return __hip_atomic_load(p, __ATOMIC_RELAXED, __HIP_MEMORY_SCOPE_AGENT); }
DI unsigned xb_add(unsigned* p, unsigned v) { return __hip_atomic_fetch_add(p, v, __ATOMIC_RELAXED, __HIP_MEMORY_SCOPE_AGENT); }
DI unsigned xb_xcc_id() { return (unsigned)__builtin_amdgcn_s_getreg((3 << 11) | 20) & 0xFu; }
#define XB_SPIN(cond, bar) do { unsigned _sp = 0; while (cond) { __builtin_amdgcn_s_sleep(1); \
    if ((++_sp & 255u) == 0u) { if (xb_ld(&(bar)[XB_TMO])) break; if (_sp > XB_SPIN_CAP) { atomicAdd(&(bar)[XB_TMO], 1u); break; } } } } while (0)
struct XcdBarrier { unsigned* bar; unsigned x; volatile LAS unsigned* st; };
DI XcdBarrier xcd_barrier_post(unsigned* bar, volatile LAS unsigned* st) {
    XcdBarrier b; b.bar = bar; b.x = xb_xcc_id(); b.st = st;
    if (threadIdx.x == 0) (void)xb_add(&bar[XB_XCNT(b.x)], 1u);
    return b;
}
DI void xcd_barrier_complete(unsigned* bar, unsigned x, unsigned& nloc, unsigned& nx) {
    const unsigned G = gridDim.x * gridDim.y * gridDim.z;
    unsigned sum, cnt, mine, sp = 0u;
    for (;;) {
        sum = 0u; cnt = 0u; mine = 0u;
#pragma unroll
        for (unsigned j = 0; j < 16; ++j) { const unsigned c = xb_ld(&bar[XB_XCNT(j)]); sum += c; cnt += (c > 0u) ? 1u : 0u; mine = (j == x) ? c : mine; }
        if (sum == G) break;
        __builtin_amdgcn_s_sleep(1);
        if ((++sp & 255u) == 0u) { if (xb_ld(&bar[XB_TMO])) break; if (sp > XB_SPIN_CAP) { atomicAdd(&bar[XB_TMO], 1u); break; } }
    }
    nloc = mine > 0u ? mine : 1u; nx = cnt > 0u ? cnt : 1u;
}
DI void xcd_barrier(const XcdBarrier& b) {
    asm volatile("s_waitcnt vmcnt(0)" ::: "memory");
    __syncthreads();
    if (threadIdx.x == 0) {
        unsigned* bar = b.bar;
        __builtin_amdgcn_s_waitcnt(0);
        unsigned nloc = b.st[0], nx = b.st[1];
        if (nloc == 0u) { xcd_barrier_complete(bar, b.x, nloc, nx); b.st[0] = nloc; b.st[1] = nx; }
        const unsigned old = xb_add(&bar[XB_XSUB(b.x)], 1u);
        const unsigned gen = old / nloc;
        if (old + 1u == (gen + 1u) * nloc) {
            __builtin_amdgcn_fence(__ATOMIC_RELEASE, "agent");
            asm volatile("s_waitcnt vmcnt(0)" ::: "memory");
            const unsigned og = xb_add(&bar[XB_TOP], 1u);
            const unsigned tg = og / nx;
            if (og + 1u == (tg + 1u) * nx) xb_add(&bar[XB_TOPGEN], 1u);
            else XB_SPIN(xb_ld(&bar[XB_TOPGEN]) == tg, bar);
            __builtin_amdgcn_fence(__ATOMIC_ACQUIRE, "agent");
            xb_add(&bar[XB_XGEN(b.x)], 1u);
            asm volatile("s_waitcnt vmcnt(0)" ::: "memory");
        } else {
            XB_SPIN(xb_ld(&bar[XB_XGEN(b.x)]) == gen, bar);
            __builtin_amdgcn_fence(__ATOMIC_ACQUIRE, "agent");
            asm volatile("s_waitcnt vmcnt(0)" ::: "memory");
        }
    }
    __syncthreads();
}

struct Params { const float* in[32]; float* out; unsigned char* ws; };

constexpr int LDS_MISC = 157952;
constexpr int LDS_BYTES = 158208;

DI void transpose_item(const float* W, int ldw, int col_off, int K, bf16_t* WT, int ncols, LAS float* scr, int item, int lane, const float* ks = nullptr) {
    const int nblk = ncols / 32, kb = item / nblk, nb = item % nblk, k0 = 64 * kb, n0 = 32 * nb;
#pragma unroll 8
    for (int i = 0; i < 32; ++i) { const int kk = 2 * i + (lane >> 5); scr[kk * 33 + (lane & 31)] = W[(size_t)(k0 + kk) * ldw + col_off + n0 + (lane & 31)] * (ks ? ks[k0 + kk] : 1.f); }
    asm volatile("s_waitcnt lgkmcnt(0)" ::: "memory");
    const int c = lane & 7;
#pragma unroll
    for (int j = 0; j < 4; ++j) { const int n = (lane >> 3) + 8 * j; const LAS float* s = scr + (8 * c) * 33 + n;
        u32x4 o; o.x = pk2(s[0 * 33], s[1 * 33]); o.y = pk2(s[2 * 33], s[3 * 33]); o.z = pk2(s[4 * 33], s[5 * 33]); o.w = pk2(s[6 * 33], s[7 * 33]);
        *(u32x4*)(WT + (size_t)(n0 + n) * K + k0 + 8 * c) = o; }
    asm volatile("s_waitcnt lgkmcnt(0)" ::: "memory");
}
struct TrJob { const float* W; int ldw, col_off, K, ncols; bf16_t* WT; const float* ks; };
DI int trjob_items(const TrJob& j) { return (j.K / 64) * (j.ncols / 32); }

DI void rms_row_to_bf16(const float* xrow, const float* g, bf16_t* orow, int lane) {
    const f32x4* xr = (const f32x4*)xrow + lane; const f32x4* gr = (const f32x4*)g + lane;
    f32x4 v[4]; float s = 0.f;
#pragma unroll
    for (int j = 0; j < 4; ++j) { v[j] = xr[64 * j]; s += (v[j].x * v[j].x + v[j].y * v[j].y) + (v[j].z * v[j].z + v[j].w * v[j].w); }
    const float r = 1.f / sqrtf(wave_sum(s) * (1.f / D) + NORM_EPS);
    unsigned long long* o8 = (unsigned long long*)orow + lane;
#pragma unroll
    for (int j = 0; j < 4; ++j) { const f32x4 gg = gr[64 * j];
        o8[64 * j] = (unsigned long long)pk2(v[j].x * r * gg.x, v[j].y * r * gg.y) | ((unsigned long long)pk2(v[j].z * r * gg.z, v[j].w * r * gg.w) << 32); }
}
DI void rms_row_to_f32(const float* xrow, const float* g, float* orow, int lane) {
    const f32x4* xr = (const f32x4*)xrow + lane; const f32x4* gr = (const f32x4*)g + lane;
    f32x4 v[4]; float s = 0.f;
#pragma unroll
    for (int j = 0; j < 4; ++j) { v[j] = xr[64 * j]; s += (v[j].x * v[j].x + v[j].y * v[j].y) + (v[j].z * v[j].z + v[j].w * v[j].w); }
    const float r = 1.f / sqrtf(wave_sum(s) * (1.f / D) + NORM_EPS);
    f32x4* o = (f32x4*)orow + lane;
#pragma unroll
    for (int j = 0; j < 4; ++j) { const f32x4 gg = gr[64 * j]; o[64 * j] = (f32x4){v[j].x * r * gg.x, v[j].y * r * gg.y, v[j].z * r * gg.z, v[j].w * r * gg.w}; }
}

struct GemmSrc { const bf16_t* A; int lda; const bf16_t* Bt; int ldb; int K; };
constexpr int G_BM = 256, G_BN = 128, G_BK = 64, G_STAGE = 49152;
#define GEMM_BAR() do { asm volatile("s_waitcnt lgkmcnt(0)" ::: "memory"); __builtin_amdgcn_s_barrier(); asm volatile("" ::: "memory"); } while (0)
template <bool SWAP = true, bool SSQ = false>
DI void gemm_accum_(f32x4 (&acc)[4][4], const GemmSrc s, int row0, int col0, LAS unsigned char* lds, f32x4& ssv) {
    const int tid = tid_fresh(), lane = tid & 63, wid = __builtin_amdgcn_readfirstlane(tid >> 6), wr = wid >> 1, wc = wid & 1, fr = lane & 15, fq = lane >> 4;
    const int nt = s.K / G_BK;
    const int prow = lane >> 3, pch = ((lane & 7) ^ prow) * 8;
    const bf16_t* src[6]; int dst[6];
#pragma unroll
    for (int q = 0; q < 6; ++q) { const int piece = wid * 6 + q;
        src[q] = (piece < 32) ? s.A + (size_t)(row0 + piece * 8 + prow) * s.lda + pch : s.Bt + (size_t)(col0 + (piece - 32) * 8 + prow) * s.ldb + pch;
        dst[q] = (piece < 32) ? piece * 1024 : 32768 + (piece - 32) * 1024; }
#define GEMM_ISSUE(t_, stg_) do { _Pragma("unroll") for (int q = 0; q < 6; ++q) \
        __builtin_amdgcn_global_load_lds((const unsigned*)(src[q] + (t_) * G_BK), (LAS unsigned*)(lds + (stg_) * G_STAGE + dst[q]), 16, 0, 0); } while (0)
    GEMM_ISSUE(0, 0);
    if (nt > 1) { GEMM_ISSUE(1, 1); asm volatile("s_waitcnt vmcnt(6)" ::: "memory"); } else asm volatile("s_waitcnt vmcnt(0)" ::: "memory");
    GEMM_BAR();
    const int aoff = (wr * 64 + fr) * 128, boff = 32768 + (wc * 64 + fr) * 128;
    int sc = 0, sn = 2;
#pragma unroll 1
    for (int t = 0; t < nt; ++t) {
        const LAS unsigned char* cur = lds + sc * G_STAGE;
#pragma unroll
        for (int kk = 0; kk < 2; ++kk) {
            const int ch = ((kk * 4 + fq) ^ (fr & 7)) << 4;
            bf16x8 a[4], b[4];
#pragma unroll
            for (int m = 0; m < 4; ++m) a[m] = *(const LAS bf16x8*)(cur + aoff + m * 2048 + ch);
#pragma unroll
            for (int n = 0; n < 4; ++n) b[n] = *(const LAS bf16x8*)(cur + boff + n * 2048 + ch);
            if constexpr (SSQ) {
#pragma unroll
                for (int m = 0; m < 4; ++m) { const u32x4 w = __builtin_bit_cast(u32x4, a[m]);
#pragma unroll
                    for (int j = 0; j < 4; ++j) { const float lo = __builtin_bit_cast(float, w[j] << 16), hi = __builtin_bit_cast(float, w[j] & 0xffff0000u); ssv[m] += lo * lo + hi * hi; } }
            }
#pragma unroll
            for (int m = 0; m < 4; ++m)
#pragma unroll
                for (int n = 0; n < 4; ++n) acc[m][n] = SWAP ? __builtin_amdgcn_mfma_f32_16x16x32_bf16(b[n], a[m], acc[m][n], 0, 0, 0)
                                                        : __builtin_amdgcn_mfma_f32_16x16x32_bf16(a[m], b[n], acc[m][n], 0, 0, 0);
        }
        if (t + 2 < nt) { GEMM_ISSUE(t + 2, sn); asm volatile("s_waitcnt vmcnt(6)" ::: "memory"); } else asm volatile("s_waitcnt vmcnt(0)" ::: "memory");
        GEMM_BAR();
        sc = (sc == 2) ? 0 : sc + 1; sn = (sn == 2) ? 0 : sn + 1;
    }
#undef GEMM_ISSUE
}
template <bool SWAP = true>
DI void gemm_accum(f32x4 (&acc)[4][4], const GemmSrc s, int row0, int col0, LAS unsigned char* lds) { f32x4 dummy; gemm_accum_<SWAP, false>(acc, s, row0, col0, lds, dummy); }
DI void acc_zero(f32x4 (&acc)[4][4]) {
#pragma unroll
    for (int m = 0; m < 4; ++m)
#pragma unroll
        for (int n = 0; n < 4; ++n) acc[m][n] = (f32x4){0.f, 0.f, 0.f, 0.f};
}
#define EPI_LOOP(row0, col0) \
    const int _tid = tid_fresh(); const int _lane = _tid & 63, _wid = _tid >> 6, _wr = _wid >> 1, _wc = _wid & 1, _fr = _lane & 15, _fq = _lane >> 4; \
    _Pragma("unroll") for (int m = 0; m < 4; ++m) _Pragma("unroll") for (int n = 0; n < 4; ++n)
#define EPI_ROW(row0) ((row0) + _wr * 64 + m * 16 + _fr)
#define EPI_COL(col0) ((col0) + _wc * 64 + n * 16 + 4 * _fq)


constexpr int PEER_H = 8, PEER_K = 16;
struct ScEnt { float v; int i; };
DI float gelu_erf(float x) { return 0.5f * x * (1.f + erff(x * 0.70710678118654752f)); }

DI void ce_desc(unsigned& a, unsigned& b) { const unsigned hi = a > b ? a : b, lo = a > b ? b : a; a = hi; b = lo; }
DI void bitonic_merge16_desc(unsigned (&k)[16]) {
#pragma unroll
    for (int st = 8; st > 0; st >>= 1)
#pragma unroll
        for (int i = 0; i < 16; ++i) if ((i & st) == 0) ce_desc(k[i], k[i | st]);
}
DI void bitonic_sort16_desc(unsigned (&k)[16]) {
#pragma unroll
    for (int size = 2; size <= 16; size <<= 1)
#pragma unroll
        for (int st = size >> 1; st > 0; st >>= 1)
#pragma unroll
            for (int i = 0; i < 16; ++i) if ((i & st) == 0) { if ((i & size) == 0 || size == 16) ce_desc(k[i], k[i | st]); else ce_desc(k[i | st], k[i]); }
}
DI void top16_merge(unsigned (&a)[16], const unsigned (&b)[16]) {
#pragma unroll
    for (int i = 0; i < 16; ++i) a[i] = a[i] > b[15 - i] ? a[i] : b[15 - i];
    bitonic_merge16_desc(a);
}
DI unsigned score_key(float f, int idx) { const unsigned u = __builtin_bit_cast(unsigned, f); const unsigned m = (u & 0x80000000u) ? ~u : (u | 0x80000000u); return (m & ~127u) | (unsigned)(127 - idx); }
DI float key_score(unsigned key) { const unsigned k = key & ~127u; return __builtin_bit_cast(float, (k & 0x80000000u) ? (k & 0x7fffffffu) : ~k); }
DI float ssq16(const float* P16, int row) { float q = 0.f;
#pragma unroll
    for (int k = 0; k < 16; ++k) q += P16[(size_t)k * T + row];
    return q; }
DI void peer_query_tile(const bf16_t* Hb, const bf16_t* WTpq, const bf16_t* SK, const float* SSQ, ScEnt* SC, int pm, int pn, LAS unsigned char* lds) {
    const int tid = tid_fresh(), lane = tid & 63, wid = tid >> 6, wr = wid >> 1, wc = wid & 1, fr = lane & 15, fq = lane >> 4;
    const int row0 = pm * G_BM, col0 = pn * G_BN;
    f32x4 acc[4][4]; acc_zero(acc);
    gemm_accum(acc, GemmSrc{Hb, D, WTpq, D, D}, row0, col0, lds);
#pragma unroll
    for (int m = 0; m < 4; ++m)
#pragma unroll
        for (int n = 0; n < 4; ++n) {
            const int r = wr * 64 + m * 16 + fr, c = wc * 64 + n * 16 + 4 * fq;
            const int kt = c >> 6, ch = (c & 63) >> 3;
            *(LAS u32x2*)(lds + kt * 32768 + r * 128 + ((ch ^ (r & 7)) << 4) + (c & 7) * 2) = (u32x2){pk2(acc[m][n][0], acc[m][n][1]), pk2(acc[m][n][2], acc[m][n][3])};
        }
    {
        const bf16_t* sk = SK + (size_t)pn * 128 * 128;
#pragma unroll
        for (int i = 0; i < 4; ++i) { const int id = tid + i * 512, r = id >> 4, c16 = id & 15, kt = c16 >> 3, ch = c16 & 7;
            *(LAS u32x4*)(lds + 65536 + kt * 16384 + r * 128 + ((ch ^ (r & 7)) << 4)) = *(const u32x4*)(sk + (size_t)r * 128 + c16 * 8); }
    }
    __syncthreads();
    acc_zero(acc);
#pragma unroll
    for (int kt = 0; kt < 2; ++kt)
#pragma unroll
        for (int kk = 0; kk < 2; ++kk) {
            const int ch = ((kk * 4 + fq) ^ (fr & 7)) << 4;
            bf16x8 a[4], b[4];
#pragma unroll
            for (int m = 0; m < 4; ++m) a[m] = *(const LAS bf16x8*)(lds + kt * 32768 + (wr * 64 + m * 16 + fr) * 128 + ch);
#pragma unroll
            for (int n = 0; n < 4; ++n) b[n] = *(const LAS bf16x8*)(lds + 65536 + kt * 16384 + (wc * 64 + n * 16 + fr) * 128 + ch);
#pragma unroll
            for (int m = 0; m < 4; ++m)
#pragma unroll
                for (int n = 0; n < 4; ++n) acc[m][n] = __builtin_amdgcn_mfma_f32_16x16x32_bf16(b[n], a[m], acc[m][n], 0, 0, 0);
        }
    __syncthreads();
    LAS float* SS = (LAS float*)lds;
#pragma unroll
    for (int m = 0; m < 4; ++m)
#pragma unroll
        for (int n = 0; n < 4; ++n) {
            const int r = wr * 64 + m * 16 + fr, c = wc * 64 + n * 16 + 4 * fq;
            const float irms = __builtin_amdgcn_rsqf(ssq16(SSQ, row0 + r) * (1.f / D) + NORM_EPS);
#pragma unroll
            for (int j = 0; j < 4; ++j) SS[r * 129 + c + j] = acc[m][n][j] * irms;
        }
    __syncthreads();
    const int trow = tid & 255, half = tid >> 8;
    unsigned best[16];
#pragma unroll
    for (int g = 0; g < 4; ++g) {
        unsigned k[16];
#pragma unroll
        for (int i = 0; i < 16; ++i) k[i] = score_key(SS[trow * 129 + half * 64 + g * 16 + i], half * 64 + g * 16 + i);
        bitonic_sort16_desc(k);
        if (g == 0) {
#pragma unroll
            for (int i = 0; i < 16; ++i) best[i] = k[i];
        } else top16_merge(best, k);
    }
    __syncthreads();
    LAS unsigned* LK = (LAS unsigned*)lds;
#pragma unroll
    for (int i = 0; i < 16; i += 4) *(LAS u32x4*)(LK + (trow * 2 + half) * 16 + i) = (u32x4){best[i], best[i + 1], best[i + 2], best[i + 3]};
    __syncthreads();
    if (half == 0) {
        unsigned oth[16];
#pragma unroll
        for (int i = 0; i < 16; i += 4) { const u32x4 t = *(const LAS u32x4*)(LK + (trow * 2 + 1) * 16 + i); oth[i] = t[0]; oth[i + 1] = t[1]; oth[i + 2] = t[2]; oth[i + 3] = t[3]; }
        top16_merge(best, oth);
        ScEnt* dst = SC + ((size_t)(row0 + trow) * 16 + pn) * 16;
#pragma unroll
        for (int r = 0; r < 16; r += 2) { u32x4 o; o[0] = __builtin_bit_cast(unsigned, key_score(best[r])); o[1] = 127u - (best[r] & 127u);
            o[2] = __builtin_bit_cast(unsigned, key_score(best[r + 1])); o[3] = 127u - (best[r + 1] & 127u); *(u32x4*)(dst + r) = o; }
    }
    __syncthreads();
}

typedef __bf16 bf16x2p __attribute__((ext_vector_type(2)));
DI float dot2bf(unsigned a, unsigned b, float acc) { return __builtin_amdgcn_fdot2_f32_bf16(__builtin_bit_cast(bf16x2p, a), __builtin_bit_cast(bf16x2p, b), acc, false); }
DI float reduce8(const float (&d)[8], int lane) {
    const bool h32 = (lane & 32) != 0, h16 = (lane & 16) != 0, h8 = (lane & 8) != 0;
    float a[4], b[2], c;
#pragma unroll
    for (int i = 0; i < 4; ++i) { const float snd = h32 ? d[i] : d[4 + i]; const float rcv = __shfl_xor(snd, 32); a[i] = (h32 ? d[4 + i] : d[i]) + rcv; }
#pragma unroll
    for (int i = 0; i < 2; ++i) { const float snd = h16 ? a[i] : a[2 + i]; const float rcv = __shfl_xor(snd, 16); b[i] = (h16 ? a[2 + i] : a[i]) + rcv; }
    { const float snd = h8 ? b[0] : b[1]; const float rcv = __shfl_xor(snd, 8); c = (h8 ? b[1] : b[0]) + rcv; }
    c += __shfl_xor(c, 4); c += __shfl_xor(c, 2); c += __shfl_xor(c, 1);
    return c;
}
struct PeerTab { const unsigned char* U8; const unsigned char* V8; const float* su; const float* sv; };
DI void peer_load_group(const unsigned char* T8, int eslot, int g7, u32x4 (&rows)[8], int lane) {
#pragma unroll
    for (int j = 0; j < 8; ++j) { const int id = __shfl(eslot, g7 * 8 + j); rows[j] = *(const u32x4*)(T8 + (size_t)id * D + lane * 16); }
    __builtin_amdgcn_sched_barrier(0x4);
}
DI float peer_u_consume(const u32x4 (&ua)[8], float suslot, float svslot, float gslot, int g7, const float (&h)[16], int lane) {
    float dd[8];
#pragma unroll
    for (int j = 0; j < 8; ++j) { float a = 0.f, b = 0.f;
#pragma unroll
        for (int q = 0; q < 4; ++q) { const f32x2 lo = __builtin_amdgcn_cvt_pk_f32_fp8((int)ua[j][q], false), hi = __builtin_amdgcn_cvt_pk_f32_fp8((int)ua[j][q], true);
            a += lo.x * h[4 * q] + lo.y * h[4 * q + 1]; b += hi.x * h[4 * q + 2] + hi.y * h[4 * q + 3]; }
        dd[j] = a + b; }
    const float tot = reduce8(dd, lane);
    const int src = g7 * 8 + (lane >> 3);
    const float gt_ = __shfl(gslot, src), su_ = __shfl(suslot, src), sv_ = __shfl(svslot, src);
    return gt_ * gelu_erf(tot * su_) * sv_;
}
DI void peer_v_consume(const u32x4 (&va)[8], float cslot, int g7, float (&o)[16], int lane) {
#pragma unroll
    for (int j = 0; j < 8; ++j) { const float cf = __shfl(cslot, g7 * 8 + j);
#pragma unroll
        for (int q = 0; q < 4; ++q) { const f32x2 lo = __builtin_amdgcn_cvt_pk_f32_fp8((int)va[j][q], false), hi = __builtin_amdgcn_cvt_pk_f32_fp8((int)va[j][q], true);
            o[4 * q] += cf * lo.x; o[4 * q + 1] += cf * lo.y; o[4 * q + 2] += cf * hi.x; o[4 * q + 3] += cf * hi.y; } }
}
constexpr size_t PEER_SLICE_B = (size_t)16384 * 128;
DI void row_to_fp8(const float* src, unsigned char* dst, float* inv_scale, int lane) {
    const f32x4* xr = (const f32x4*)src + lane;
    f32x4 v[4]; float am = 0.f;
#pragma unroll
    for (int j = 0; j < 4; ++j) { v[j] = xr[64 * j]; am = fmaxf(am, fmaxf(fmaxf(fabsf(v[j].x), fabsf(v[j].y)), fmaxf(fabsf(v[j].z), fabsf(v[j].w)))); }
#pragma unroll
    for (int o = 1; o < 64; o <<= 1) am = fmaxf(am, __shfl_xor(am, o));
    am = fmaxf(am, 1e-20f);
    const float sc = 256.f / am;
#pragma unroll
    for (int j = 0; j < 4; ++j) { int t = 0; t = __builtin_amdgcn_cvt_pk_fp8_f32(v[j].x * sc, v[j].y * sc, t, false); t = __builtin_amdgcn_cvt_pk_fp8_f32(v[j].z * sc, v[j].w * sc, t, true);
        *(unsigned*)(dst + (size_t)(2 * j + (lane >> 5)) * PEER_SLICE_B + 4 * (lane & 31)) = (unsigned)t; }
    if (lane == 0) *inv_scale = am * (1.f / 256.f);
}
DI void peer_token(const float* x1row, float* x2row, bf16_t* hrow, const ScEnt* SCt, const PeerTab& tb, const float* g_ple, float irms, int lane) {
    int ci = 0, st = 0;
    { const int th[15] = {16, 24, 29, 33, 36, 38, 40, 42, 43, 44, 45, 46, 47, 48, 49};
#pragma unroll
      for (int k = 0; k < 15; ++k) { const bool ge = lane >= th[k]; ci += ge ? 1 : 0; st = ge ? th[k] : st; } }
    const int cj = lane - st;
    int es0 = 0, es1 = 0; float gs0 = 0.f, gs1 = 0.f;
#pragma unroll 1
    for (int hd = 0; hd < PEER_H; ++hd) {
        const ScEnt* L0 = SCt + (hd * 2) * 16; const ScEnt* L1 = SCt + (hd * 2 + 1) * 16;
        float v = -INFINITY; int p = 1024 + lane;
        if (lane < 50) { v = L0[ci].v + L1[cj].v; p = ci * 16 + cj; }
#pragma unroll
        for (int k = 2; k <= 64; k <<= 1)
#pragma unroll
            for (int j = k >> 1; j > 0; j >>= 1) {
                const float ov = __shfl_xor(v, j); const int op = __shfl_xor(p, j);
                const bool lower = (lane & j) == 0, desc = (lane & k) == 0 || k == 64;
                const bool og = (ov > v) || (ov == v && op < p);
                const bool sw = (lower == desc) ? og : !og;
                v = sw ? ov : v; p = sw ? op : p;
            }
        const float mx = __shfl(v, 0);
        const float e = (lane < 16) ? __expf(v - mx) : 0.f;
        const float gate = e / wave_sum(e);
        int eidx = 0;
        if (lane < 16) eidx = L0[p >> 4].i * 128 + L1[p & 15].i;
        const int te = __shfl(eidx, lane & 15); const float tg = __shfl(gate, lane & 15);
        if ((lane >> 4) == (hd & 3)) { if (hd < 4) { es0 = te; gs0 = tg; } else { es1 = te; gs1 = tg; } }
    }
    float h[16];
    { const u32x4 ha = *(const u32x4*)(hrow + lane * 16), hb = *(const u32x4*)(hrow + lane * 16 + 8);
#pragma unroll
      for (int j = 0; j < 4; ++j) { h[2 * j] = __builtin_bit_cast(float, ha[j] << 16); h[2 * j + 1] = __builtin_bit_cast(float, ha[j] & 0xffff0000u); h[8 + 2 * j] = __builtin_bit_cast(float, hb[j] << 16); h[8 + 2 * j + 1] = __builtin_bit_cast(float, hb[j] & 0xffff0000u); }
#pragma unroll
      for (int j = 0; j < 16; ++j) h[j] *= irms; }
    const float sus0 = tb.su[es0], svs0 = tb.sv[es0], sus1 = tb.su[es1], svs1 = tb.sv[es1];
    float cs0 = 0.f, cs1 = 0.f;
    float o[16];
#pragma unroll
    for (int j = 0; j < 16; ++j) o[j] = 0.f;
    {
        u32x4 ra[8], rb[8];
        peer_load_group(tb.U8, es0, 0, ra, lane);
#define PEER_PUT(cs, gg, cf) do { const float tmp_ = __shfl(cf, (lane & 7) * 8); if ((lane >> 3) == (gg)) cs = tmp_; } while (0)
#pragma unroll 1
        for (int g = 0; g < 8; g += 2) {
            peer_load_group(tb.U8, es0, g + 1, rb, lane);
            { const float cf = peer_u_consume(ra, sus0, svs0, gs0, g, h, lane); PEER_PUT(cs0, g, cf); }
            peer_load_group(tb.U8, g + 2 < 8 ? es0 : es1, (g + 2) & 7, ra, lane);
            { const float cf = peer_u_consume(rb, sus0, svs0, gs0, g + 1, h, lane); PEER_PUT(cs0, g + 1, cf); }
        }
#pragma unroll 1
        for (int g = 0; g < 8; g += 2) {
            peer_load_group(tb.U8, es1, g + 1, rb, lane);
            { const float cf = peer_u_consume(ra, sus1, svs1, gs1, g, h, lane); PEER_PUT(cs1, g, cf); }
            peer_load_group(g + 2 < 8 ? tb.U8 : tb.V8, g + 2 < 8 ? es1 : es0, (g + 2) & 7, ra, lane);
            { const float cf = peer_u_consume(rb, sus1, svs1, gs1, g + 1, h, lane); PEER_PUT(cs1, g + 1, cf); }
        }
#pragma unroll 1
        for (int g = 0; g < 8; g += 2) {
            peer_load_group(tb.V8, es0, g + 1, rb, lane);
            peer_v_consume(ra, cs0, g, o, lane);
            peer_load_group(tb.V8, g + 2 < 8 ? es0 : es1, (g + 2) & 7, ra, lane);
            peer_v_consume(rb, cs0, g + 1, o, lane);
        }
#pragma unroll 1
        for (int g = 0; g < 8; g += 2) {
            peer_load_group(tb.V8, es1, g + 1, rb, lane);
            peer_v_consume(ra, cs1, g, o, lane);
            if (g + 2 < 8) peer_load_group(tb.V8, es1, g + 2, ra, lane);
            peer_v_consume(rb, cs1, g + 1, o, lane);
        }
#undef PEER_PUT
    }
    float ss = 0.f;
#pragma unroll
    for (int j = 0; j < 4; ++j) { const f32x4 xv = *(const f32x4*)(x1row + lane * 16 + 4 * j);
        o[4 * j] += xv.x; o[4 * j + 1] += xv.y; o[4 * j + 2] += xv.z; o[4 * j + 3] += xv.w;
        *(f32x4*)(x2row + lane * 16 + 4 * j) = (f32x4){o[4 * j], o[4 * j + 1], o[4 * j + 2], o[4 * j + 3]};
        ss += o[4 * j] * o[4 * j] + o[4 * j + 1] * o[4 * j + 1] + o[4 * j + 2] * o[4 * j + 2] + o[4 * j + 3] * o[4 * j + 3]; }
    const float rr = 1.f / sqrtf(wave_sum(ss) * (1.f / D) + NORM_EPS);
    u32x4 w0, w1;
#pragma unroll
    for (int j = 0; j < 4; ++j) { const f32x4 g0 = *(const f32x4*)(g_ple + lane * 16 + 4 * j);
        const unsigned lo = pk2(o[4 * j] * rr * g0.x, o[4 * j + 1] * rr * g0.y), hi = pk2(o[4 * j + 2] * rr * g0.z, o[4 * j + 3] * rr * g0.w);
        if (j < 2) { w0[2 * j] = lo; w0[2 * j + 1] = hi; } else { w1[2 * (j - 2)] = lo; w1[2 * (j - 2) + 1] = hi; } }
    *(u32x4*)(hrow + lane * 16) = w0; *(u32x4*)(hrow + lane * 16 + 8) = w1;
}


DI void peer_route_cand(int lane, int& ci, int& cj) {
    int c_ = 0, st = 0;
    { const int th[15] = {16, 24, 29, 33, 36, 38, 40, 42, 43, 44, 45, 46, 47, 48, 49};
#pragma unroll
      for (int k = 0; k < 15; ++k) { const bool ge = lane >= th[k]; c_ += ge ? 1 : 0; st = ge ? th[k] : st; } }
    ci = c_; cj = lane - st;
}
DI void peer_route_load(const ScEnt* SCt, int ci, int cj, u32x2 (&l0)[8], u32x2 (&l1)[8]) {
#pragma unroll
    for (int hd = 0; hd < 8; ++hd) { l0[hd] = *(const u32x2*)(SCt + hd * 32 + ci); l1[hd] = *(const u32x2*)(SCt + hd * 32 + 16 + cj); }
    __builtin_amdgcn_sched_barrier(0x4);
}
DI void peer_route_compute(const u32x2 (&l0)[8], const u32x2 (&l1)[8], int* ELt, float* GTt, int lane) {
    int es0 = 0, es1 = 0; float gs0 = 0.f, gs1 = 0.f;
#pragma unroll
    for (int h4 = 0; h4 < 8; h4 += 4) {
        float v[4]; unsigned key[4]; int rank[4];
#pragma unroll
        for (int u = 0; u < 4; ++u) { const float vs = __builtin_bit_cast(float, l0[h4 + u].x) + __builtin_bit_cast(float, l1[h4 + u].x); v[u] = lane < 50 ? vs : -INFINITY;
            const unsigned x = __builtin_bit_cast(unsigned, v[u]); const unsigned k = x ^ ((unsigned)((int)x >> 31) | 0x80000000u);
            key[u] = (k & ~63u) | (unsigned)(63 - lane); rank[u] = 0; }
#pragma unroll
        for (int c = 0; c < 50; ++c) {
            unsigned s0, s1, s2, s3;
            asm volatile("v_readlane_b32 %4, %8, %12\n\tv_readlane_b32 %5, %9, %12\n\tv_readlane_b32 %6, %10, %12\n\tv_readlane_b32 %7, %11, %12\n\t"
                         "v_cmp_gt_u32 vcc, %4, %8\n\tv_addc_co_u32 %0, vcc, 0, %0, vcc\n\t"
                         "v_cmp_gt_u32 vcc, %5, %9\n\tv_addc_co_u32 %1, vcc, 0, %1, vcc\n\t"
                         "v_cmp_gt_u32 vcc, %6, %10\n\tv_addc_co_u32 %2, vcc, 0, %2, vcc\n\t"
                         "v_cmp_gt_u32 vcc, %7, %11\n\tv_addc_co_u32 %3, vcc, 0, %3, vcc"
                         : "+v"(rank[0]), "+v"(rank[1]), "+v"(rank[2]), "+v"(rank[3]), "=&s"(s0), "=&s"(s1), "=&s"(s2), "=&s"(s3)
                         : "v"(key[0]), "v"(key[1]), "v"(key[2]), "v"(key[3]), "i"(c) : "vcc");
        }
#pragma unroll
        for (int u = 0; u < 4; ++u) {
            const int eidx = (int)l0[h4 + u].y * 128 + (int)l1[h4 + u].y;
            const float mx = __builtin_bit_cast(float, __builtin_amdgcn_readlane(__builtin_bit_cast(int, v[u]), 0));
            const float e = rank[u] < 16 ? __expf(v[u] - mx) : 0.f;
            const float gate = e / wave_sum(e);
            const int dst = (rank[u] < 16 ? u * 16 + rank[u] : (u ^ 1) * 16) * 4;
            const int te = __builtin_amdgcn_ds_permute(dst, eidx); const float tg = __builtin_bit_cast(float, __builtin_amdgcn_ds_permute(dst, __builtin_bit_cast(int, gate)));
            if ((lane >> 4) == u) { if (h4 == 0) { es0 = te; gs0 = tg; } else { es1 = te; gs1 = tg; } }
        }
    }
    ELt[lane] = es0; ELt[64 + lane] = es1; GTt[lane] = gs0; GTt[64 + lane] = gs1;
}
DI constexpr int cand_ci(int c) { const int th[15] = {16, 24, 29, 33, 36, 38, 40, 42, 43, 44, 45, 46, 47, 48, 49}; int ci = 0; for (int k = 0; k < 15; ++k) if (c >= th[k]) ci = k + 1; return ci; }
DI constexpr int cand_cj(int c) { const int st[16] = {0, 16, 24, 29, 33, 36, 38, 40, 42, 43, 44, 45, 46, 47, 48, 49}; return c - st[cand_ci(c)]; }
DI void peer_route_pair(const LAS u32x4* SCq, LAS int* ELq, LAS float* GTq) {
    u32x4 raw[16];
#pragma unroll
    for (int k = 0; k < 16; ++k) raw[k] = SCq[k];
    asm volatile("s_waitcnt lgkmcnt(0)" : "+v"(raw[0]), "+v"(raw[1]), "+v"(raw[2]), "+v"(raw[3]), "+v"(raw[4]), "+v"(raw[5]), "+v"(raw[6]), "+v"(raw[7]) :: "memory");
    asm volatile("" : "+v"(raw[8]), "+v"(raw[9]), "+v"(raw[10]), "+v"(raw[11]), "+v"(raw[12]), "+v"(raw[13]), "+v"(raw[14]), "+v"(raw[15]) :: "memory");
    __builtin_amdgcn_wave_barrier();
    float v[50]; int L[50];
#pragma unroll
    for (int c = 0; c < 50; ++c) { constexpr int dummy = 0; (void)dummy;
        const int ci = cand_ci(c), cj = cand_cj(c);
        const float a = __builtin_bit_cast(float, (ci & 1) ? raw[ci >> 1].z : raw[ci >> 1].x), b = __builtin_bit_cast(float, (cj & 1) ? raw[8 + (cj >> 1)].z : raw[8 + (cj >> 1)].x);
        v[c] = a + b; L[c] = (ci + 1) * (cj + 1) - 1; }
#pragma unroll
    for (int a = 0; a < 50; ++a) {
        int W = 0, nl = 0;
#pragma unroll
        for (int b = a + 1; b < 50; ++b) {
            if (cand_ci(a) <= cand_ci(b) && cand_cj(a) <= cand_cj(b)) continue;
            const int ge = v[a] >= v[b] ? 1 : 0;
            L[b] += ge; W += ge; ++nl;
        }
        L[a] += nl - W;
    }
    const float mx = v[0];
    float sum = 0.f;
#pragma unroll
    for (int c = 0; c < 50; ++c) { v[c] = L[c] < 16 ? __expf(v[c] - mx) : 0.f; sum += v[c]; }
    const float inv = 1.f / sum;
#pragma unroll
    for (int c = 0; c < 50; ++c) {
        const int ci = cand_ci(c), cj = cand_cj(c);
        if (L[c] < 16) {
            const int i0 = (int)((ci & 1) ? raw[ci >> 1].w : raw[ci >> 1].y), i1 = (int)((cj & 1) ? raw[8 + (cj >> 1)].w : raw[8 + (cj >> 1)].y);
            ELq[L[c]] = i0 * 128 + i1; GTq[L[c]] = v[c] * inv;
        }
    }
}
constexpr size_t PEER_SLICE = (size_t)16384 * 128;
DI void psl_ids(const int* ELt, int g, u32x4 (&id)[4]) {
#pragma unroll
    for (int q = 0; q < 4; ++q) id[q] = *(const u32x4*)(ELt + 16 * g + 4 * q);
    __builtin_amdgcn_sched_barrier(0x4);
}
DI void psl_rows(const unsigned char* sl, const u32x4 (&id)[4], int i, u32x4 (&rows)[16]) {
#pragma unroll
    for (int k = 0; k < 16; ++k) rows[k] = *(const u32x4*)(sl + (size_t)id[k >> 2][k & 3] * 128 + i * 16);
    __builtin_amdgcn_sched_barrier(0x4);
}
DI void psl_u_consume(const u32x4 (&rows)[16], const u32x4 (&hraw)[2], float* Pt, int lane, bool valid) {
    f32x2 hp[8];
#pragma unroll
    for (int j = 0; j < 4; ++j) { hp[j] = (f32x2){__builtin_bit_cast(float, hraw[0][j] << 16), __builtin_bit_cast(float, hraw[0][j] & 0xffff0000u)};
                                  hp[4 + j] = (f32x2){__builtin_bit_cast(float, hraw[1][j] << 16), __builtin_bit_cast(float, hraw[1][j] & 0xffff0000u)}; }
    float d[16];
#pragma unroll
    for (int k = 0; k < 16; ++k) { f32x2 a = (f32x2){0.f, 0.f};
#pragma unroll
        for (int q = 0; q < 4; ++q) { const f32x2 lo = __builtin_amdgcn_cvt_pk_f32_fp8((int)rows[k][q], false), hi = __builtin_amdgcn_cvt_pk_f32_fp8((int)rows[k][q], true);
            a += lo * hp[2 * q]; a += hi * hp[2 * q + 1]; }
        d[k] = a.x + a.y; }
    const bool s4 = (lane & 4) != 0, s2 = (lane & 2) != 0, s1 = (lane & 1) != 0;
    float a[8], b[4], c[2];
#pragma unroll
    for (int j = 0; j < 8; ++j) { const float snd = s4 ? d[j] : d[8 + j]; const float rcv = __shfl_xor(snd, 4); a[j] = (s4 ? d[8 + j] : d[j]) + rcv; }
#pragma unroll
    for (int j = 0; j < 4; ++j) { const float snd = s2 ? a[j] : a[4 + j]; const float rcv = __shfl_xor(snd, 2); b[j] = (s2 ? a[4 + j] : a[j]) + rcv; }
#pragma unroll
    for (int j = 0; j < 2; ++j) { const float snd = s1 ? b[j] : b[2 + j]; const float rcv = __shfl_xor(snd, 1); c[j] = (s1 ? b[2 + j] : b[j]) + rcv; }
    if (valid) *(f32x2*)(Pt + 2 * lane) = (f32x2){c[0], c[1]};
}
DI void peer_gu_slice(const int* EL, const bf16_t* Hb, const unsigned char* sl, float* Px, int x, int w0, int nw, int lane) {
    const int g = lane >> 3, i = lane & 7;
    const int cnt = (T - w0 + nw - 1) / nw;
    if (w0 >= T) return;
#define PSL_TOK(n_) ({ const int t_ = w0 + (n_) * nw; t_ < T ? t_ : T - 1; })
#define PSL_H(hv_, t_) do { const bf16_t* hp_ = Hb + (size_t)(t_) * D + x * 128 + i * 16; hv_[0] = *(const u32x4*)hp_; hv_[1] = *(const u32x4*)(hp_ + 8); } while (0)
    u32x4 ia[4], ib[4], ra[16], rb[16], ha[2], hb[2];
    psl_ids(EL + (size_t)PSL_TOK(0) * 128, g, ia);
    psl_ids(EL + (size_t)PSL_TOK(1) * 128, g, ib);
    PSL_H(ha, PSL_TOK(0)); psl_rows(sl, ia, i, ra);
#pragma unroll 1
    for (int n = 0; n < cnt; n += 2) {
        const int t0 = PSL_TOK(n), t1 = PSL_TOK(n + 1), t2 = PSL_TOK(n + 2), t3 = PSL_TOK(n + 3);
        psl_ids(EL + (size_t)t2 * 128, g, ia);
        PSL_H(hb, t1); psl_rows(sl, ib, i, rb);
        psl_u_consume(ra, ha, Px + (size_t)t0 * 128, lane, true);
        psl_ids(EL + (size_t)t3 * 128, g, ib);
        PSL_H(ha, t2); psl_rows(sl, ia, i, ra);
        psl_u_consume(rb, hb, Px + (size_t)t1 * 128, lane, n + 1 < cnt);
    }
#undef PSL_H
}
DI void psl_v_consume(const u32x4 (&rows)[16], const u32x4 (&cw)[4], f32x2 x1v, float* xrow, bf16_t* hrow, f32x2 gp, float* ssq, int lane, bool valid) {
    f32x2 o[8];
#pragma unroll
    for (int q = 0; q < 8; ++q) o[q] = (f32x2){0.f, 0.f};
#pragma unroll
    for (int k = 0; k < 16; ++k) { const float c1 = __builtin_bit_cast(float, cw[k >> 2][k & 3] & 0xFFFFC000u); const f32x2 c2 = (f32x2){c1, c1};
#pragma unroll
        for (int q = 0; q < 4; ++q) { const f32x2 lo = __builtin_amdgcn_cvt_pk_f32_fp8((int)rows[k][q], false), hi = __builtin_amdgcn_cvt_pk_f32_fp8((int)rows[k][q], true);
            o[2 * q] += c2 * lo; o[2 * q + 1] += c2 * hi; } }
    float d[16];
#pragma unroll
    for (int q = 0; q < 8; ++q) { d[2 * q] = o[q].x; d[2 * q + 1] = o[q].y; }
    const bool s4 = (lane & 32) != 0, s2 = (lane & 16) != 0, s1 = (lane & 8) != 0;
    float a[8], b[4], c[2];
#pragma unroll
    for (int j = 0; j < 8; ++j) { const float snd = s4 ? d[j] : d[8 + j]; const float rcv = __shfl_xor(snd, 32); a[j] = (s4 ? d[8 + j] : d[j]) + rcv; }
#pragma unroll
    for (int j = 0; j < 4; ++j) { const float snd = s2 ? a[j] : a[4 + j]; const float rcv = __shfl_xor(snd, 16); b[j] = (s2 ? a[4 + j] : a[j]) + rcv; }
#pragma unroll
    for (int j = 0; j < 2; ++j) { const float snd = s1 ? b[j] : b[2 + j]; const float rcv = __shfl_xor(snd, 8); c[j] = (s1 ? b[2 + j] : b[j]) + rcv; }
    const int tsrc = 8 * (lane & 7) + (lane >> 3);
    const f32x2 x2 = x1v + (f32x2){__shfl(c[0], tsrc), __shfl(c[1], tsrc)};
    const float ss = wave_sum(x2.x * x2.x + x2.y * x2.y);
    if (valid) {
        *(f32x2*)xrow = x2;
        *(unsigned*)hrow = pk2(x2.x * gp.x, x2.y * gp.y);
        if (lane == 0) *ssq = ss;
    }
}
DI void psl_rows_packed(const unsigned char* sl, const u32x4 (&cw)[4], int i, u32x4 (&rows)[16]) {
#pragma unroll
    for (int k = 0; k < 16; ++k) rows[k] = *(const u32x4*)(sl + (size_t)(cw[k >> 2][k & 3] & 0x3FFFu) * 128 + i * 16);
    __builtin_amdgcn_sched_barrier(0x4);
}
DI void peer_gv_slice(const unsigned* CW, const unsigned char* sl, float* XB, bf16_t* Hb, const float* g_ple, float* SSQ2, int x, int w0, int nw, int lane) {
    const int g = lane >> 3, i = lane & 7, col = x * 128 + 2 * lane;
    const int cnt = (T - w0 + nw - 1) / nw;
    if (w0 >= T) return;
    const f32x2 gp = *(const f32x2*)(g_ple + col);
    u32x4 ia[4], ib[4], ra[16], rb[16], ca[4], cb[4]; f32x2 xa, xb;
    psl_ids((const int*)CW + (size_t)PSL_TOK(0) * 128, g, ia);
    psl_ids((const int*)CW + (size_t)PSL_TOK(1) * 128, g, ib);
    xa = *(const f32x2*)(XB + (size_t)PSL_TOK(0) * D + col); psl_rows_packed(sl, ia, i, ra);
#pragma unroll
    for (int q = 0; q < 4; ++q) ca[q] = ia[q];
#pragma unroll 1
    for (int n = 0; n < cnt; n += 2) {
        const int t0 = PSL_TOK(n), t1 = PSL_TOK(n + 1), t2 = PSL_TOK(n + 2), t3 = PSL_TOK(n + 3);
        psl_ids((const int*)CW + (size_t)t2 * 128, g, ia);
        xb = *(const f32x2*)(XB + (size_t)t1 * D + col); psl_rows_packed(sl, ib, i, rb);
#pragma unroll
        for (int q = 0; q < 4; ++q) cb[q] = ib[q];
        psl_v_consume(ra, ca, xa, XB + (size_t)t0 * D + col, Hb + (size_t)t0 * D + col, gp, SSQ2 + (size_t)x * T + t0, lane, true);
        psl_ids((const int*)CW + (size_t)t3 * 128, g, ib);
        xa = *(const f32x2*)(XB + (size_t)t2 * D + col); psl_rows_packed(sl, ia, i, ra);
#pragma unroll
        for (int q = 0; q < 4; ++q) ca[q] = ia[q];
        psl_v_consume(rb, cb, xb, XB + (size_t)t1 * D + col, Hb + (size_t)t1 * D + col, gp, SSQ2 + (size_t)x * T + t1, lane, n + 1 < cnt);
    }
#undef PSL_TOK
}

DI float ushift(const bf16_t* U, int t, int col, float mu) {
    const float c = bf2f(U[(size_t)t * UW + col]);
    const float pv = t > 0 ? bf2f(U[(size_t)(t - 1) * UW + col]) : 0.f;
    const float nx = t < T - 1 ? bf2f(U[(size_t)(t + 1) * UW + col]) : 0.f;
    return c + mu * (0.5f * (pv + nx) - c);
}
DI void rwkv_scan_naive(const Params& P, const bf16_t* U, bf16_t* RO, float* BS, int d, int h, LAS unsigned char* lds) {
    const int tid = tid_fresh();
    LAS float* W2S = (LAS float*)lds;
    LAS float* A2S = W2S + 4096;
    LAS float* INB = A2S + 4096;
    LAS float* STP = INB + 5 * 2048;
    const float* mu = P.in[5];
    const float* w2 = P.in[7] + (size_t)d * 64 * 512;
    const float* a2 = P.in[9] + (size_t)d * 64 * 512;
    for (int i = tid; i < 4096; i += NTHREADS) { const int l = i >> 6, c = i & 63; W2S[i] = w2[l * 512 + h * 64 + c]; A2S[i] = a2[l * 512 + h * 64 + c]; }
    const int i2 = tid >> 4, c2 = (tid & 15) * 4;
    float w0c[4], a0c[4], kkc[4], kac[4], rkc[4];
#pragma unroll
    for (int j = 0; j < 4; ++j) { const int hc = h * 64 + c2 + j; w0c[j] = P.in[6][d * 512 + hc]; a0c[j] = P.in[8][d * 512 + hc]; kkc[j] = P.in[11][hc]; kac[j] = P.in[12][hc]; rkc[j] = P.in[13][hc]; }
    const int v3 = tid >> 3, q3 = tid & 7;
    float S[8];
#pragma unroll
    for (int j = 0; j < 8; ++j) S[j] = 0.f;
    __syncthreads();
    for (int ch = 0; ch < T / 32; ++ch) {
#pragma unroll 2
        for (int e = tid; e < 5 * 2048; e += NTHREADS) {
            const int grp = e >> 11, i = (e >> 6) & 31, c = e & 63;
            const int sidx = ch * 32 + i, t = d ? (T - 1 - sidx) : sidx;
            const int col = (grp < 3 ? grp * 512 + h * 64 : (grp == 3 ? 1536 : 1664) + d * 64) + c;
            float v = ushift(U, t, col, mu[col]);
            if (grp == 3) v = tanhf(v);
            INB[e] = v;
        }
        __syncthreads();
        {
            float wl[4], al[4];
#pragma unroll
            for (int j = 0; j < 4; ++j) { wl[j] = w0c[j]; al[j] = a0c[j]; }
#pragma unroll 4
            for (int l = 0; l < 64; ++l) {
                const float tw = INB[3 * 2048 + i2 * 64 + l], ta = INB[4 * 2048 + i2 * 64 + l];
                const f32x4 wv = *(const LAS f32x4*)(W2S + l * 64 + c2), av = *(const LAS f32x4*)(A2S + l * 64 + c2);
#pragma unroll
                for (int j = 0; j < 4; ++j) { wl[j] += tw * wv[j]; al[j] += ta * av[j]; }
            }
            float kk[4], ss = 0.f, bsum = 0.f, kd[4], alr[4], dec[4], rr[4];
#pragma unroll
            for (int j = 0; j < 4; ++j) {
                const float kv = INB[1 * 2048 + i2 * 64 + c2 + j]; rr[j] = INB[0 * 2048 + i2 * 64 + c2 + j];
                kk[j] = kv * kkc[j]; ss += kk[j] * kk[j];
                alr[j] = 1.f / (1.f + expf(-al[j]));
                const float wlog = -log1pf(expf(-wl[j])) - 0.5f;
                dec[j] = expf(-expf(wlog));
                kd[j] = kv * (1.f + (alr[j] - 1.f) * kac[j]);
                bsum += rr[j] * kd[j] * rkc[j];
            }
#pragma unroll
            for (int o = 1; o < 16; o <<= 1) { ss += __shfl_xor(ss, o); bsum += __shfl_xor(bsum, o); }
            const float inv = 1.f / fmaxf(sqrtf(ss), 1e-12f);
            const int sidx = ch * 32 + i2, t = d ? (T - 1 - sidx) : sidx;
            if ((tid & 15) == 0) BS[((size_t)d * T + t) * 8 + h] = bsum;
#pragma unroll
            for (int j = 0; j < 4; ++j) { const float k1 = kk[j] * inv;
                STP[(i2 * 5 + 0) * 64 + c2 + j] = -k1; STP[(i2 * 5 + 1) * 64 + c2 + j] = k1 * alr[j];
                STP[(i2 * 5 + 2) * 64 + c2 + j] = kd[j]; STP[(i2 * 5 + 3) * 64 + c2 + j] = dec[j]; STP[(i2 * 5 + 4) * 64 + c2 + j] = rr[j]; }
        }
        __syncthreads();
#pragma unroll 2
        for (int i = 0; i < 32; ++i) {
            const LAS float* sp = STP + i * 320 + q3 * 8;
            float av[8], bv[8], kv[8], wv[8], rv[8];
#pragma unroll
            for (int j = 0; j < 8; j += 4) {
                const f32x4 a4 = *(const LAS f32x4*)(sp + j), b4 = *(const LAS f32x4*)(sp + 64 + j), k4 = *(const LAS f32x4*)(sp + 128 + j), w4 = *(const LAS f32x4*)(sp + 192 + j), r4 = *(const LAS f32x4*)(sp + 256 + j);
#pragma unroll
                for (int u = 0; u < 4; ++u) { av[j + u] = a4[u]; bv[j + u] = b4[u]; kv[j + u] = k4[u]; wv[j + u] = w4[u]; rv[j + u] = r4[u]; }
            }
            const float vv = INB[2 * 2048 + i * 64 + v3];
            float sa = 0.f;
#pragma unroll
            for (int j = 0; j < 8; ++j) sa += S[j] * av[j];
            sa += __shfl_xor(sa, 1); sa += __shfl_xor(sa, 2); sa += __shfl_xor(sa, 4);
            float ov = 0.f;
#pragma unroll
            for (int j = 0; j < 8; ++j) { S[j] = S[j] * wv[j] + sa * bv[j] + vv * kv[j]; ov += S[j] * rv[j]; }
            ov += __shfl_xor(ov, 1); ov += __shfl_xor(ov, 2); ov += __shfl_xor(ov, 4);
            if (q3 == 0) { const int sidx = ch * 32 + i, t = d ? (T - 1 - sidx) : sidx; RO[((size_t)d * T + t) * 512 + h * 64 + v3] = (bf16_t)f2bf(ov); }
        }
        __syncthreads();
    }
}
DI void rwkv_merge_token(const Params& P, bf16_t* VSY, const unsigned char* CM, const float* BS, const bf16_t* Gm, int t, int lane) {
    const int c0 = lane * 8, h = lane >> 3, vhalf = (lane >> 2) & 1, ch32 = (lane & 3) * 8;
    const int s1 = T - 1 - t;
    const u32x4 o0 = *(const u32x4*)(CM + ((size_t)(h * 256 + (t >> 6))) * CM_ITEM + 16384 + vhalf * 4096 + (t & 63) * 64 + ch32 * 2);
    const u32x4 o1 = *(const u32x4*)(CM + ((size_t)((8 + h) * 256 + (s1 >> 6))) * CM_ITEM + 16384 + vhalf * 4096 + (s1 & 63) * 64 + ch32 * 2);
    float o[8]; float s = 0.f;
#pragma unroll
    for (int j = 0; j < 4; ++j) { o[2 * j] = __builtin_bit_cast(float, o0[j] << 16) + __builtin_bit_cast(float, o1[j] << 16);
        o[2 * j + 1] = __builtin_bit_cast(float, o0[j] & 0xffff0000u) + __builtin_bit_cast(float, o1[j] & 0xffff0000u); s += o[2 * j] + o[2 * j + 1]; }
    s += __shfl_xor(s, 1); s += __shfl_xor(s, 2); s += __shfl_xor(s, 4);
    const float mean = s * (1.f / 64.f); float q = 0.f;
#pragma unroll
    for (int j = 0; j < 8; ++j) { o[j] -= mean; q += o[j] * o[j]; }
    q += __shfl_xor(q, 1); q += __shfl_xor(q, 2); q += __shfl_xor(q, 4);
    const float rstd = 1.f / sqrtf(q * (1.f / 64.f) + 64e-5f);
    const float bonus = BS[(size_t)t * 8 + h] + BS[((size_t)T + t) * 8 + h];
    const u32x4 g4 = *(const u32x4*)(Gm + (size_t)t * 512 + c0);
    const u32x4 v4 = *(const u32x4*)(VSY + (size_t)t * 512 + c0);
    const f32x4 gw0 = *(const f32x4*)(P.in[14] + c0), gw1 = *(const f32x4*)(P.in[14] + c0 + 4), gb0 = *(const f32x4*)(P.in[15] + c0), gb1 = *(const f32x4*)(P.in[15] + c0 + 4);
    u32x4 w;
#pragma unroll
    for (int j = 0; j < 4; ++j) {
        float y[2];
#pragma unroll
        for (int u = 0; u < 2; ++u) { const int e = 2 * j + u;
            const float vs = u ? __builtin_bit_cast(float, v4[j] & 0xffff0000u) : __builtin_bit_cast(float, v4[j] << 16);
            const float gg = u ? __builtin_bit_cast(float, g4[j] & 0xffff0000u) : __builtin_bit_cast(float, g4[j] << 16);
            const float gnw = e < 4 ? gw0[e] : gw1[e - 4], gnb = e < 4 ? gb0[e] : gb1[e - 4];
            y[u] = (o[e] * rstd * gnw + gnb + bonus * vs) * gg; }
        w[j] = pk2(y[0], y[1]);
    }
    *(u32x4*)(VSY + (size_t)t * 512 + c0) = w;
}


constexpr int PA_RF = 0, PA_KF = 16384, PA_VF = 32768, PA_WL = 49152, PA_AL = 65536, PA_LW = 81920, PA_LA = 90112, PA_AR = 98304, PA_BK = 114688,
              PA_YG = 131072, PA_VT = 147456, PA_SEG = 155648, PA_GCL = 157696;
constexpr int PA_N = 0, PA_NT = 8192, PA_QRB = 16384, PA_QRK = 24576, PA_T0 = 32768, PA_T1 = 40960, PA_A0 = 49152, PA_AT0 = 57344, PA_A1 = 65536, PA_AT1 = 73728,
              PA_BT = 81920, PA_KT = 90112, PA_GT = 114688, PA_OK = 32768, PA_AT = PA_YG, PA_PAKT = PA_YG + 8192;
typedef __bf16 bf16x2_t __attribute__((ext_vector_type(2)));
DI unsigned cvtpk(float lo, float hi) { f32x2 v = {lo, hi}; bf16x2_t b = __builtin_convertvector(v, bf16x2_t); return __builtin_bit_cast(unsigned, b); }
DI int pswz(int row) { return (row ^ (row >> 3)) & 7; }
DI int lofs(int row, int col) { return row * 128 + ((((col >> 3) ^ pswz(row))) << 4) + (col & 7) * 2; }
DI bf16x8 lfrag(const LAS unsigned char* M, int row, int kk, int fq) { return *(const LAS bf16x8*)(M + row * 128 + (((kk * 4 + fq) ^ pswz(row)) << 4)); }
template <int NT, bool SWAP>
DI void mm16(f32x4 (&acc)[NT], const LAS unsigned char* X, int xrow0, const LAS unsigned char* Y, int yrow0, int fr, int fq) {
#pragma unroll
    for (int kk = 0; kk < 2; ++kk) {
        const bf16x8 xf = lfrag(X, xrow0 + fr, kk, fq);
#pragma unroll
        for (int n = 0; n < NT; ++n) {
            const bf16x8 yf = lfrag(Y, yrow0 + n * 16 + fr, kk, fq);
            acc[n] = SWAP ? __builtin_amdgcn_mfma_f32_16x16x32_bf16(yf, xf, acc[n], 0, 0, 0) : __builtin_amdgcn_mfma_f32_16x16x32_bf16(xf, yf, acc[n], 0, 0, 0);
        }
    }
}
DI void st4(LAS unsigned char* M, int row, int col, f32x4 v) { *(LAS u32x2*)(M + lofs(row, col)) = (u32x2){cvtpk(v[0], v[1]), cvtpk(v[2], v[3])}; }
DI f32x4 ld4(const LAS unsigned char* M, int row, int col) { const u32x2 p = *(const LAS u32x2*)(M + lofs(row, col));
    return (f32x4){__builtin_bit_cast(float, p.x << 16), __builtin_bit_cast(float, p.x & 0xffff0000u), __builtin_bit_cast(float, p.y << 16), __builtin_bit_cast(float, p.y & 0xffff0000u)}; }
DI void st1(LAS unsigned char* M, int row, int col, float v) { *(LAS bf16_t*)(M + lofs(row, col)) = (bf16_t)(cvtpk(v, 0.f) & 0xffffu); }

#define LDS_BAR() do { asm volatile("s_waitcnt lgkmcnt(0)" ::: "memory"); __builtin_amdgcn_s_barrier(); asm volatile("" ::: "memory"); } while (0)
struct PaPre { u32x4 cu[5], pu[5], nu[5]; f32x4 m0[5], m1[5]; };
DI void pa_prefetch(const bf16_t* U, const float* mu, int item, int tid, PaPre& pre) {
    const int c = item & 255, h = (item >> 8) & 7, d = item >> 11;
    const int i = tid >> 3, c8 = tid & 7;
    const int sidx = c * 64 + i, t = d ? (T - 1 - sidx) : sidx;
#pragma unroll
    for (int q = 0; q < 5; ++q) {
        const int col = (q < 3 ? q * 512 + h * 64 : (q == 3 ? 1536 : 1664) + d * 64) + c8 * 8;
        const bf16_t* up = U + (size_t)t * UW + col;
        pre.cu[q] = *(const u32x4*)up; pre.pu[q] = *(const u32x4*)(t > 0 ? up - UW : up); pre.nu[q] = *(const u32x4*)(t < T - 1 ? up + UW : up);
        pre.m0[q] = *(const f32x4*)(mu + col); pre.m1[q] = *(const f32x4*)(mu + col + 4);
    }
}
DI void rwkv_passA(const Params& P, const bf16_t* U, const bf16_t* W2T, const bf16_t* A2T, unsigned char* CM, float* GC, float* BS, bf16_t* VS, unsigned* flags, int item, int prev_item, int next_item, PaPre& pre, LAS unsigned char* lds, unsigned long long* tacc = nullptr) {
#ifdef DBG_TS
    unsigned long long t_prev = __builtin_amdgcn_s_memrealtime();
#define PA_MARK(k) do { if (tacc && threadIdx.x == 0) { const unsigned long long t_now = __builtin_amdgcn_s_memrealtime(); tacc[k] += t_now - t_prev; t_prev = t_now; } } while (0)
#else
#define PA_MARK(k) do {} while (0)
#endif
    const int tid = tid_fresh(), lane = tid & 63, wid = __builtin_amdgcn_readfirstlane(tid >> 6), fr = lane & 15, fq = lane >> 4;
    const int c = item & 255, h = (item >> 8) & 7, d = item >> 11;
    bf16x8 yfr[2][4];
    { const bf16_t* Yg = ((wid >> 2) ? A2T : W2T) + (size_t)(d * 8 + h) * 4096;
#pragma unroll
      for (int kk = 0; kk < 2; ++kk)
#pragma unroll
        for (int n = 0; n < 4; ++n) yfr[kk][n] = *(const bf16x8*)(Yg + (n * 16 + fr) * 64 + (kk * 4 + fq) * 8); }
    f32x4 b0c[4]; f32x4 kkc[2], kac[2], rkc[2];
    { const float* bp = ((wid >> 2) ? P.in[8] : P.in[6]) + d * 512 + h * 64 + 4 * fq;
#pragma unroll
      for (int n = 0; n < 4; ++n) b0c[n] = *(const f32x4*)(bp + n * 16);
      const int cc_ = (tid & 7) * 8;
      kkc[0] = *(const f32x4*)(P.in[11] + h * 64 + cc_); kkc[1] = *(const f32x4*)(P.in[11] + h * 64 + cc_ + 4);
      kac[0] = *(const f32x4*)(P.in[12] + h * 64 + cc_); kac[1] = *(const f32x4*)(P.in[12] + h * 64 + cc_ + 4);
      rkc[0] = *(const f32x4*)(P.in[13] + h * 64 + cc_); rkc[1] = *(const f32x4*)(P.in[13] + h * 64 + cc_ + 4); }
    {
        const int i = tid >> 3, c8 = tid & 7;
        const int sidx = c * 64 + i, t = d ? (T - 1 - sidx) : sidx;
        const float pf = t > 0 ? 0.5f : 0.f, nf = t < T - 1 ? 0.5f : 0.f;
#pragma unroll
        for (int q = 0; q < 5; ++q) {
            const int col = (q < 3 ? q * 512 + h * 64 : (q == 3 ? 1536 : 1664) + d * 64) + c8 * 8;
            const u32x4 cu = pre.cu[q], pu = pre.pu[q], nu = pre.nu[q];
            const f32x4 m0 = pre.m0[q], m1 = pre.m1[q];
            float v[8];
#pragma unroll
            for (int j = 0; j < 4; ++j) {
                const float c0 = __builtin_bit_cast(float, cu[j] << 16), c1 = __builtin_bit_cast(float, cu[j] & 0xffff0000u);
                const float p0 = __builtin_bit_cast(float, pu[j] << 16), p1 = __builtin_bit_cast(float, pu[j] & 0xffff0000u);
                const float n0 = __builtin_bit_cast(float, nu[j] << 16), n1 = __builtin_bit_cast(float, nu[j] & 0xffff0000u);
                const float mu0 = j < 2 ? m0[2 * j] : m1[2 * j - 4], mu1 = j < 2 ? m0[2 * j + 1] : m1[2 * j - 3];
                v[2 * j] = c0 + mu0 * ((pf * p0 + nf * n0) - c0); v[2 * j + 1] = c1 + mu1 * ((pf * p1 + nf * n1) - c1);
            }
            if (q < 3) {
                LAS float* dst = (LAS float*)(lds + q * 16384) + i * 64 + c8 * 8;
                *(LAS f32x4*)dst = (f32x4){v[0], v[1], v[2], v[3]}; *(LAS f32x4*)(dst + 4) = (f32x4){v[4], v[5], v[6], v[7]};
                if (q == 2) {
#pragma unroll
                    for (int j = 0; j < 8; ++j) st1(lds + PA_VT, c8 * 8 + j, i, v[j]);
                    if (d == 0) *(u32x4*)(VS + (size_t)t * 512 + h * 64 + c8 * 8) = (u32x4){cvtpk(v[0], v[1]), cvtpk(v[2], v[3]), cvtpk(v[4], v[5]), cvtpk(v[6], v[7])};
                }
            } else {
                if (q == 3) {
#pragma unroll
                    for (int j = 0; j < 8; ++j) v[j] = 1.f - 2.f * __builtin_amdgcn_rcpf(1.f + __expf(2.f * v[j]));
                }
                *(LAS u32x4*)(lds + (q == 3 ? PA_LW : PA_LA) + i * 128 + ((c8 ^ pswz(i)) << 4)) = (u32x4){cvtpk(v[0], v[1]), cvtpk(v[2], v[3]), cvtpk(v[4], v[5]), cvtpk(v[6], v[7])};
            }
        }
    }
    LDS_BAR();
    if (next_item >= 0) pa_prefetch(U, P.in[5], next_item, tid, pre);
    PA_MARK(0);
    {
        const int sel = wid >> 2, rb = wid & 3;
        const LAS unsigned char* X = lds + (sel ? PA_LA : PA_LW);
        f32x4 acc[4];
#pragma unroll
        for (int n = 0; n < 4; ++n) acc[n] = (f32x4){0.f, 0.f, 0.f, 0.f};
#pragma unroll
        for (int kk = 0; kk < 2; ++kk) {
            const bf16x8 xf = lfrag(X, rb * 16 + fr, kk, fq);
#pragma unroll
            for (int n = 0; n < 4; ++n) acc[n] = __builtin_amdgcn_mfma_f32_16x16x32_bf16(yfr[kk][n], xf, acc[n], 0, 0, 0);
        }
        const int i = rb * 16 + fr;
#pragma unroll
        for (int n = 0; n < 4; ++n) {
            const int cc = n * 16 + 4 * fq;
            const f32x4 b0 = b0c[n];
            f32x4 o;
#pragma unroll
            for (int j = 0; j < 4; ++j) { const float z = acc[n][j] + b0[j];
                const float sg = __builtin_amdgcn_rcpf(1.f + __expf(-z));
                o[j] = sel ? sg : -0.6065306597126334f * sg; }
            *(LAS f32x4*)((LAS float*)(lds + (sel ? PA_AL : PA_WL)) + i * 64 + cc) = o;
        }
    }
    LDS_BAR();
    PA_MARK(6);
    {
        const int k = tid & 63, seg = tid >> 6;
        LAS float* WL = (LAS float*)(lds + PA_WL); LAS float* SEG = (LAS float*)(lds + PA_SEG);
        float run = 0.f, tmp[8];
#pragma unroll
        for (int ii = 0; ii < 8; ++ii) { run += WL[(seg * 8 + ii) * 64 + k]; tmp[ii] = run; }
        SEG[seg * 64 + k] = run;
        LDS_BAR();
        float off = 0.f;
#pragma unroll
        for (int s = 0; s < 8; ++s) off += (s < seg) ? SEG[s * 64 + k] : 0.f;
#pragma unroll
        for (int ii = 0; ii < 8; ++ii) WL[(seg * 8 + ii) * 64 + k] = tmp[ii] + off;
    }
    LDS_BAR();
    PA_MARK(7);
    {
        const int i = tid >> 3, c8 = tid & 7, cc = c8 * 8;
        const LAS float* Rf = (const LAS float*)(lds + PA_RF) + i * 64 + cc; const LAS float* Kf = (const LAS float*)(lds + PA_KF) + i * 64 + cc;
        const LAS float* Lf = (const LAS float*)(lds + PA_WL) + i * 64 + cc; const LAS float* Af = (const LAS float*)(lds + PA_AL) + i * 64 + cc;
        float rr[8], kv[8], L[8], Lp[8], al[8];
#pragma unroll
        for (int j = 0; j < 8; j += 4) { const f32x4 a = *(const LAS f32x4*)(Rf + j), b = *(const LAS f32x4*)(Kf + j), l4 = *(const LAS f32x4*)(Lf + j), a4 = *(const LAS f32x4*)(Af + j);
            f32x4 lp = (f32x4){0.f, 0.f, 0.f, 0.f}; if (i > 0) lp = *(const LAS f32x4*)(Lf - 64 + j);
#pragma unroll
            for (int u = 0; u < 4; ++u) { rr[j + u] = a[u]; kv[j + u] = b[u]; L[j + u] = l4[u]; Lp[j + u] = lp[u]; al[j + u] = a4[u]; } }
        float kkp[8], kap[8], rkp[8];
#pragma unroll
        for (int j = 0; j < 8; ++j) { kkp[j] = kkc[j >> 2][j & 3]; kap[j] = kac[j >> 2][j & 3]; rkp[j] = rkc[j >> 2][j & 3]; }
        float kk[8], kd[8], ss = 0.f, bsum = 0.f;
#pragma unroll
        for (int j = 0; j < 8; ++j) { kk[j] = kv[j] * kkp[j]; ss += kk[j] * kk[j]; kd[j] = kv[j] * (1.f + (al[j] - 1.f) * kap[j]); bsum += rr[j] * kd[j] * rkp[j]; }
#pragma unroll
        for (int o = 1; o < 8; o <<= 1) { ss += __shfl_xor(ss, o); bsum += __shfl_xor(bsum, o); }
        const float inv = __builtin_amdgcn_rsqf(fmaxf(ss, 1e-24f));
        const int sidx = c * 64 + i, t = d ? (T - 1 - sidx) : sidx;
        if (c8 == 0) BS[((size_t)d * T + t) * 8 + h] = bsum;
        float ah[8], rh[8], bh[8], kh[8];
#pragma unroll
        for (int j = 0; j < 8; ++j) { const float k1 = kk[j] * inv, eL = __expf(L[j]), eLm = __expf(-L[j]), eP = __expf(Lp[j]);
            ah[j] = -k1 * eP; rh[j] = rr[j] * eL; bh[j] = k1 * al[j] * eLm; kh[j] = kd[j] * eLm;
            if (i == 63) { ((LAS float*)(lds + PA_GCL))[cc + j] = eL; __hip_atomic_store((unsigned*)(GC + (size_t)item * 64 + cc + j), __builtin_bit_cast(unsigned, eL), __ATOMIC_RELAXED, __HIP_MEMORY_SCOPE_AGENT); } }
        const int so = ((c8 ^ pswz(i)) << 4);
        *(LAS u32x4*)(lds + PA_AR + i * 128 + so) = (u32x4){cvtpk(ah[0], ah[1]), cvtpk(ah[2], ah[3]), cvtpk(ah[4], ah[5]), cvtpk(ah[6], ah[7])};
        *(LAS u32x4*)(lds + PA_AR + (64 + i) * 128 + so) = (u32x4){cvtpk(rh[0], rh[1]), cvtpk(rh[2], rh[3]), cvtpk(rh[4], rh[5]), cvtpk(rh[6], rh[7])};
        *(LAS u32x4*)(lds + PA_BK + i * 128 + so) = (u32x4){cvtpk(bh[0], bh[1]), cvtpk(bh[2], bh[3]), cvtpk(bh[4], bh[5]), cvtpk(bh[6], bh[7])};
        *(LAS u32x4*)(lds + PA_BK + (64 + i) * 128 + so) = (u32x4){cvtpk(kh[0], kh[1]), cvtpk(kh[2], kh[3]), cvtpk(kh[4], kh[5]), cvtpk(kh[6], kh[7])};
#pragma unroll
        for (int j = 0; j < 8; ++j) { st1(lds + PA_AT, cc + j, i, ah[j]); st1(lds + PA_BT, cc + j, i, bh[j]); st1(lds + PA_KT, cc + j, i, kh[j]); }
    }
    LDS_BAR();
    PA_MARK(1);
    {
        f32x4 acc[8];
#pragma unroll
        for (int n = 0; n < 8; ++n) acc[n] = (f32x4){0.f, 0.f, 0.f, 0.f};
        mm16<8, true>(acc, lds + PA_AR, wid * 16, lds + PA_BK, 0, fr, fq);
        const int t = (wid & 3) * 16 + fr; const bool isR = wid >= 4;
#pragma unroll
        for (int n = 0; n < 8; ++n) {
            const int j0 = (n & 3) * 16 + 4 * fq; const bool isK = n >= 4;
            f32x4 v = acc[n];
#pragma unroll
            for (int j = 0; j < 4; ++j) { const bool keep = isR ? (j0 + j <= t) : (j0 + j < t); v[j] = keep ? v[j] : 0.f; }
            if (!isR && !isK) {
                st4(lds + PA_N, t, j0, v);
#pragma unroll
                for (int j = 0; j < 4; ++j) st1(lds + PA_NT, j0 + j, t, v[j]);
                f32x4 tv = v;
#pragma unroll
                for (int j = 0; j < 4; ++j) tv[j] += (j0 + j == t) ? 1.f : 0.f;
                st4(lds + PA_T0, t, j0, tv);
            } else if (!isR && isK) {
#pragma unroll
                for (int j = 0; j < 4; ++j) st1(lds + PA_PAKT, j0 + j, t, v[j]);
            } else if (isR && !isK) st4(lds + PA_QRB, t, j0, v);
            else st4(lds + PA_QRK, t, j0, v);
        }
    }
    LDS_BAR();
    PA_MARK(2);
    {
        const int mt = wid >> 1, nt0 = (wid & 1) * 2, row = mt * 16 + fr;
#pragma unroll 1
        for (int s = 0; s < 6; ++s) {
            const LAS unsigned char* Ac = lds + (s == 0 ? PA_N : ((s & 1) ? PA_A0 : PA_A1));
            const LAS unsigned char* ATc = lds + (s == 0 ? PA_NT : ((s & 1) ? PA_AT0 : PA_AT1));
            LAS unsigned char* An = lds + ((s & 1) ? PA_A1 : PA_A0);
            LAS unsigned char* ATn = lds + ((s & 1) ? PA_AT1 : PA_AT0);
            const LAS unsigned char* To = lds + (((s - 1) & 1) ? PA_T1 : PA_T0);
            LAS unsigned char* Tn = lds + ((s & 1) ? PA_T1 : PA_T0);
            if (s < 5) {
                f32x4 aa[2] = {(f32x4){0.f, 0.f, 0.f, 0.f}, (f32x4){0.f, 0.f, 0.f, 0.f}};
                mm16<2, true>(aa, Ac, mt * 16, ATc, nt0 * 16, fr, fq);
#pragma unroll
                for (int n = 0; n < 2; ++n) { const int c0 = (nt0 + n) * 16 + 4 * fq; st4(An, row, c0, aa[n]);
#pragma unroll
                    for (int j = 0; j < 4; ++j) st1(ATn, c0 + j, row, aa[n][j]); }
            }
            if (s > 0) {
                f32x4 ta[2] = {(f32x4){0.f, 0.f, 0.f, 0.f}, (f32x4){0.f, 0.f, 0.f, 0.f}};
                mm16<2, true>(ta, To, mt * 16, ATc, nt0 * 16, fr, fq);
#pragma unroll
                for (int n = 0; n < 2; ++n) { const int c0 = (nt0 + n) * 16 + 4 * fq; const f32x4 o = ld4(To, row, c0) + ta[n]; st4(Tn, row, c0, o); }
            }
            LDS_BAR();
        }
    }
    PA_MARK(3);
    {
        const int mt = wid >> 1, nt0 = (wid & 1) * 4;
        f32x4 acc[4];
#pragma unroll
        for (int n = 0; n < 4; ++n) acc[n] = (f32x4){0.f, 0.f, 0.f, 0.f};
        mm16<4, false>(acc, lds + PA_T1, mt * 16, lds + PA_YG, nt0 * 16, fr, fq);
#pragma unroll
        for (int n = 0; n < 4; ++n) st4(lds + PA_GT, (nt0 + n) * 16 + fr, mt * 16 + 4 * fq, acc[n]);
    }
    asm volatile("s_waitcnt vmcnt(0)" ::: "memory");
    LDS_BAR();
    if (prev_item >= 0 && tid == 0) __hip_atomic_store(flags + prev_item, 1u, __ATOMIC_RELAXED, __HIP_MEMORY_SCOPE_AGENT);
    {
        const int sel = wid >> 2, mt = wid & 3, row = mt * 16 + fr;
        f32x4 acc[8];
#pragma unroll
        for (int n = 0; n < 8; ++n) acc[n] = (f32x4){0.f, 0.f, 0.f, 0.f};
        mm16<8, true>(acc, lds + (sel ? PA_BT : PA_QRB), mt * 16, lds + PA_GT, 0, fr, fq);
        const float gc = ((const LAS float*)(lds + PA_GCL))[row];
        bf16_t* gout = (bf16_t*)(CM + (size_t)item * CM_ITEM + (sel ? 8192 : 0));
#pragma unroll
        for (int n = 0; n < 8; ++n) {
            const int c0 = (n & 3) * 16 + 4 * fq;
            f32x4 v = acc[n];
            if (n < 4) {
                if (sel == 0) v = v + ld4(lds + PA_AR, 64 + row, c0); else v = v * gc;
                const int tb = row >> 5, lanep = (row & 31) + 32 * (fq & 1);
                __hip_atomic_store((unsigned long long*)(gout + (((tb * 4 + n) * 64 + lanep) * 8 + 4 * (fq >> 1))), (unsigned long long)cvtpk(v[0], v[1]) | ((unsigned long long)cvtpk(v[2], v[3]) << 32), __ATOMIC_RELAXED, __HIP_MEMORY_SCOPE_AGENT);
            } else {
                if (sel == 0) v = v + ld4(lds + PA_QRK, row, c0); else v = (v + ld4(lds + PA_KT, row, c0)) * gc;
                st4(lds + PA_OK, sel * 64 + row, c0, v);
            }
        }
    }
    LDS_BAR();
    PA_MARK(4);
    {
        f32x4 acc[4];
#pragma unroll
        for (int n = 0; n < 4; ++n) acc[n] = (f32x4){0.f, 0.f, 0.f, 0.f};
        mm16<4, false>(acc, lds + PA_OK, wid * 16, lds + PA_VT, 0, fr, fq);
        bf16_t* gout = (bf16_t*)(CM + (size_t)item * CM_ITEM + (wid < 4 ? 16384 : 24576));
        const int mt = wid & 3, blk = mt >> 1, reg0 = 4 * ((mt & 1) * 2 + (fq >> 1));
#pragma unroll
        for (int n = 0; n < 4; ++n) {
            const int vhalf = n >> 1, lanep = (n & 1) * 16 + fr + 32 * (fq & 1);
            __hip_atomic_store((unsigned long long*)(gout + (((vhalf * 2 + blk) * 64 + lanep) * 16 + reg0)), (unsigned long long)cvtpk(acc[n][0], acc[n][1]) | ((unsigned long long)cvtpk(acc[n][2], acc[n][3]) << 32), __ATOMIC_RELAXED, __HIP_MEMORY_SCOPE_AGENT);
        }
    }
    PA_MARK(5);
    if (next_item < 0) { asm volatile("s_waitcnt vmcnt(0)" ::: "memory"); LDS_BAR(); if (tid == 0) __hip_atomic_store(flags + item, 1u, __ATOMIC_RELAXED, __HIP_MEMORY_SCOPE_AGENT); }
    else LDS_BAR();
}

#undef PA_MARK
constexpr int PB_STAGE = 24576 + 256, PB_NST = 6, PB_XS = PB_NST * PB_STAGE, PB_XS_SZ = 4096;
DI void pb_out_chunk(const LAS unsigned char* st, const LAS unsigned char* xsb, unsigned char* ROitem, int vhalf, int tb, int lane) {
    const int r = lane & 31, hh = lane >> 5;
    bf16x8 xs[4];
#pragma unroll
    for (int s = 0; s < 4; ++s) xs[s] = *(const LAS bf16x8*)(xsb + (s * 64 + lane) * 16);
    const LAS unsigned char* op = st + 16384 + (tb * 64 + lane) * 32;
    const u32x4 a = *(const LAS u32x4*)op, b = *(const LAS u32x4*)(op + 16);
    f32x16 o;
#pragma unroll
    for (int j = 0; j < 4; ++j) { o[2 * j] = __builtin_bit_cast(float, a[j] << 16); o[2 * j + 1] = __builtin_bit_cast(float, a[j] & 0xffff0000u);
                                  o[8 + 2 * j] = __builtin_bit_cast(float, b[j] << 16); o[8 + 2 * j + 1] = __builtin_bit_cast(float, b[j] & 0xffff0000u); }
#pragma unroll
    for (int s = 0; s < 4; ++s) o = __builtin_amdgcn_mfma_f32_32x32x16_bf16(*(const LAS bf16x8*)(st + ((tb * 4 + s) * 64 + lane) * 16), xs[s], o, 0, 0, 0);
    bf16_t* rp = (bf16_t*)(ROitem + 16384 + vhalf * 4096) + (tb * 32 + 4 * hh) * 32 + r;
#pragma unroll
    for (int i = 0; i < 16; ++i) rp[((i & 3) + 8 * (i >> 2)) * 32] = (bf16_t)(cvtpk(o[i], 0.f) & 0xffffu);
}
DI void pb_state_chunk(const LAS unsigned char* st, const LAS unsigned char* xs_in, LAS unsigned char* xs_out, f32x16& S, int kb, int lane) {
    const int hh = lane >> 5;
    bf16x8 xs[4];
#pragma unroll
    for (int s = 0; s < 4; ++s) xs[s] = *(const LAS bf16x8*)(xs_in + (s * 64 + lane) * 16);
    f32x16 n;
    const LAS float* gcl = (const LAS float*)(st + 24576) + 32 * kb;
    const LAS unsigned char* hp = st + 20480 + (kb * 64 + lane) * 32;
    const u32x4 a0 = *(const LAS u32x4*)hp, b0 = *(const LAS u32x4*)(hp + 16);
#pragma unroll
    for (int j = 0; j < 4; ++j) { n[2 * j] = __builtin_bit_cast(float, a0[j] << 16); n[2 * j + 1] = __builtin_bit_cast(float, a0[j] & 0xffff0000u);
                                  n[8 + 2 * j] = __builtin_bit_cast(float, b0[j] << 16); n[8 + 2 * j + 1] = __builtin_bit_cast(float, b0[j] & 0xffff0000u); }
#pragma unroll
    for (int i = 0; i < 16; ++i) { const int kr = (i & 3) + 8 * (i >> 2) + 4 * hh; n[i] += gcl[kr] * S[i]; }
#pragma unroll
    for (int s = 0; s < 4; ++s) n = __builtin_amdgcn_mfma_f32_32x32x16_bf16(*(const LAS bf16x8*)(st + 8192 + ((kb * 4 + s) * 64 + lane) * 16), xs[s], n, 0, 0, 0);
    S = n;
    const u32x4 w0 = (u32x4){cvtpk(n[0], n[1]), cvtpk(n[2], n[3]), cvtpk(n[4], n[5]), cvtpk(n[6], n[7])};
    const u32x4 w1 = (u32x4){cvtpk(n[8], n[9]), cvtpk(n[10], n[11]), cvtpk(n[12], n[13]), cvtpk(n[14], n[15])};
    *(LAS u32x4*)(xs_out + ((2 * kb) * 64 + lane) * 16) = w0; *(LAS u32x4*)(xs_out + ((2 * kb + 1) * 64 + lane) * 16) = w1;
}
DI void pb_dma(const unsigned char* CM, const float* GC, unsigned* flags, size_t item0, int cc, int vhalf, LAS unsigned char* stg, int lw, int lane) {
    const int c_ = cc < 256 ? cc : 255;
    {
        unsigned sp = 0;
        while (__builtin_amdgcn_readfirstlane(__hip_atomic_load(flags + item0 + c_, __ATOMIC_RELAXED, __HIP_MEMORY_SCOPE_AGENT)) == 0u) { __builtin_amdgcn_s_sleep(4); if (++sp > (1u << 22)) break; }
        asm volatile("" ::: "memory");
    }
    const unsigned char* src = CM + (item0 + c_) * CM_ITEM;
#pragma unroll
    for (int q = 0; q < 6; ++q) {
        const int piece = lw * 6 + q;
        const int soff = piece < 16 ? piece * 1024 : (piece < 20 ? 16384 + vhalf * 4096 + (piece - 16) * 1024 : 24576 + vhalf * 4096 + (piece - 20) * 1024);
        __builtin_amdgcn_global_load_lds((const unsigned*)(src + soff + lane * 16), (LAS unsigned*)(stg + piece * 1024), 16, 0, 16);
    }
    __builtin_amdgcn_global_load_lds((const unsigned*)((const unsigned char*)(GC + (item0 + c_) * 64) + lane * 4), (LAS unsigned*)(stg + 24576), 4, 0, 16);
}
DI void rwkv_passB(unsigned char* CM, const float* GC, unsigned* flags, int d, int h, int vhalf, LAS unsigned char* lds) {
    const int tid = tid_fresh(), lane = tid & 63, wid = __builtin_amdgcn_readfirstlane(tid >> 6);
    const size_t item0 = (size_t)(d * 8 + h) * 256;
    const bool loader = (wid >= 4);
    if (loader) { pb_dma(CM, GC, flags, item0, 0, vhalf, lds + 0 * PB_STAGE, wid - 4, lane); pb_dma(CM, GC, flags, item0, 1, vhalf, lds + 1 * PB_STAGE, wid - 4, lane); pb_dma(CM, GC, flags, item0, 2, vhalf, lds + 2 * PB_STAGE, wid - 4, lane); pb_dma(CM, GC, flags, item0, 3, vhalf, lds + 3 * PB_STAGE, wid - 4, lane);
                  asm volatile("s_waitcnt vmcnt(21)" ::: "memory"); }
    else if (wid < 2) { *(LAS u32x4*)(lds + PB_XS + ((2 * wid) * 64 + lane) * 16) = (u32x4){0u, 0u, 0u, 0u}; *(LAS u32x4*)(lds + PB_XS + ((2 * wid + 1) * 64 + lane) * 16) = (u32x4){0u, 0u, 0u, 0u}; }
    LDS_BAR();
    f32x16 S;
#pragma unroll
    for (int i = 0; i < 16; ++i) S[i] = 0.f;
    int sc = 0, sn = 4;
#pragma unroll 1
    for (int c = 0; c < 256; ++c) {
        const LAS unsigned char* st = lds + sc * PB_STAGE;
        if (wid < 2) pb_state_chunk(st, lds + PB_XS + (c & 1) * PB_XS_SZ, lds + PB_XS + ((c + 1) & 1) * PB_XS_SZ, S, wid, lane);
        else if (wid < 4) pb_out_chunk(st, lds + PB_XS + (c & 1) * PB_XS_SZ, CM + (item0 + c) * CM_ITEM, vhalf, wid - 2, lane);
        else { pb_dma(CM, GC, flags, item0, c + 4, vhalf, lds + sn * PB_STAGE, wid - 4, lane); asm volatile("s_waitcnt vmcnt(21)" ::: "memory"); }
        LDS_BAR();
        sc = (sc + 1 == PB_NST) ? 0 : sc + 1; sn = (sn + 1 == PB_NST) ? 0 : sn + 1;
    }
    asm volatile("s_waitcnt vmcnt(0)" ::: "memory");
    __syncthreads();
}

constexpr float QSCALE = 0.10206207261596575f * 1.4426950408889634f;
DI void fast_sincos(float x, float& sn, float& cs) { const float r = x * 0.15915494309189535f; const float f = r - floorf(r); sn = __builtin_amdgcn_sinf(f); cs = __builtin_amdgcn_cosf(f); }
DI void mla_prep_token4(const Params& P, const bf16_t* U, bf16_t* Kb, int t4, int lane) {
    const int t = t4 * 4 + (lane >> 4), l16 = lane & 15;
    const bf16_t* ur = U + (size_t)t * UW;
    const float x1 = bf2f(ur[2304 + l16]), x2 = bf2f(ur[2304 + 16 + l16]);
    const float pos = (float)((const int*)P.in[2])[t];
    const float inv = exp2f(-(float)l16 * (13.287712379549449f / 16.f));
    float sn, cs; fast_sincos(pos * inv, sn, cs);
    const bf16_t o1 = (bf16_t)f2bf(x1 * cs - x2 * sn), o2 = (bf16_t)f2bf(x2 * cs + x1 * sn);
#pragma unroll
    for (int h = 0; h < 8; ++h) { bf16_t* kp = Kb + ((size_t)h * T + t) * 96; kp[64 + l16] = o1; kp[80 + l16] = o2; }
}
constexpr int ATT_KB = 64 * 208, ATT_VB = 64 * 144;
constexpr float ATT_THR = 8.f;
DI int crow(int reg, int hh) { return (reg & 3) + 8 * (reg >> 2) + 4 * hh; }
constexpr int ATT_KS = 0, ATT_VS = 2 * ATT_KB, ATT_SCR2 = 2 * ATT_KB + 2 * ATT_VB;
DI void lds_read12(bf16x8 (&f)[12], unsigned a) {
    asm volatile("ds_read_b128 %0, %12\n\tds_read_b128 %1, %12 offset:6656\n\tds_read_b128 %2, %12 offset:32\n\tds_read_b128 %3, %12 offset:6688\n\t"
                 "ds_read_b128 %4, %12 offset:64\n\tds_read_b128 %5, %12 offset:6720\n\tds_read_b128 %6, %12 offset:96\n\tds_read_b128 %7, %12 offset:6752\n\t"
                 "ds_read_b128 %8, %12 offset:128\n\tds_read_b128 %9, %12 offset:6784\n\tds_read_b128 %10, %12 offset:160\n\tds_read_b128 %11, %12 offset:6816"
                 : "=&v"(f[0]), "=&v"(f[1]), "=&v"(f[2]), "=&v"(f[3]), "=&v"(f[4]), "=&v"(f[5]), "=&v"(f[6]), "=&v"(f[7]), "=&v"(f[8]), "=&v"(f[9]), "=&v"(f[10]), "=&v"(f[11])
                 : "v"(a) : "memory");
}
DI void lds_wait12(bf16x8 (&f)[12]) {
    asm volatile("s_waitcnt lgkmcnt(0)" : "+v"(f[0]), "+v"(f[1]), "+v"(f[2]), "+v"(f[3]), "+v"(f[4]), "+v"(f[5]), "+v"(f[6]), "+v"(f[7]), "+v"(f[8]), "+v"(f[9]), "+v"(f[10]), "+v"(f[11]) :: "memory");
}
DI void lds_read8(bf16x8 (&f)[8], unsigned a) {
    asm volatile("ds_read_b128 %0, %8\n\tds_read_b128 %1, %8 offset:4608\n\tds_read_b128 %2, %8 offset:32\n\tds_read_b128 %3, %8 offset:4640\n\t"
                 "ds_read_b128 %4, %8 offset:64\n\tds_read_b128 %5, %8 offset:4672\n\tds_read_b128 %6, %8 offset:96\n\tds_read_b128 %7, %8 offset:4704"
                 : "=&v"(f[0]), "=&v"(f[1]), "=&v"(f[2]), "=&v"(f[3]), "=&v"(f[4]), "=&v"(f[5]), "=&v"(f[6]), "=&v"(f[7])
                 : "v"(a) : "memory");
}
DI void lds_wait8(bf16x8 (&f)[8]) {
    asm volatile("s_waitcnt lgkmcnt(0)" : "+v"(f[0]), "+v"(f[1]), "+v"(f[2]), "+v"(f[3]), "+v"(f[4]), "+v"(f[5]), "+v"(f[6]), "+v"(f[7]) :: "memory");
}
DI void attn_qk(f32x16& p0, f32x16& p1, unsigned kaddr, const bf16x8 (&qf)[6], const f32x16& negm) {
    bf16x8 kf[12];
    lds_read12(kf, kaddr);
    lds_wait12(kf);
    p0 = negm; p1 = negm;
#pragma unroll
    for (int ks = 0; ks < 6; ++ks) {
        p0 = __builtin_amdgcn_mfma_f32_32x32x16_bf16(kf[2 * ks], qf[ks], p0, 0, 0, 0);
        p1 = __builtin_amdgcn_mfma_f32_32x32x16_bf16(kf[2 * ks + 1], qf[ks], p1, 0, 0, 0);
    }
}
DI void attn_pv(f32x16& o0, f32x16& o1, unsigned vaddr, const bf16x8 (&pa)[4]) {
    bf16x8 vf[8];
    lds_read8(vf, vaddr);
    lds_wait8(vf);
#pragma unroll
    for (int ks = 0; ks < 4; ++ks) {
        o0 = __builtin_amdgcn_mfma_f32_32x32x16_bf16(pa[ks], vf[2 * ks], o0, 0, 0, 0);
        o1 = __builtin_amdgcn_mfma_f32_32x32x16_bf16(pa[ks], vf[2 * ks + 1], o1, 0, 0, 0);
    }
}
DI float max3_(float a, float b, float c) { float r; asm("v_max3_f32 %0, %1, %2, %3" : "=v"(r) : "v"(a), "v"(b), "v"(c)); return r; }
DI float attn_rowmax(const f32x16& p0, const f32x16& p1) {
    float m0 = max3_(p0[0], p0[1], p0[2]), m1 = max3_(p1[0], p1[1], p1[2]);
#pragma unroll
    for (int i = 3; i < 15; i += 2) { m0 = max3_(m0, p0[i], p0[i + 1]); m1 = max3_(m1, p1[i], p1[i + 1]); }
    const float mx = max3_(m0, m1, p0[15]), my = max3_(mx, p1[15], p1[15]);
    return max3_(my, __shfl_xor(my, 32), my);
}
DI void attn_unit(const bf16_t* Q, const bf16_t* Kb, const bf16_t* VT, bf16_t* YM, int h, int qb, LAS unsigned char* lds) {
    const int tid = tid_fresh(), lane = tid & 63, wid = tid >> 6, r = lane & 31, hh = lane >> 5;
    const int q0 = qb * 256 + wid * 32;
    bf16x8 qf[6];
    { const bf16_t* qp = Q + ((size_t)h * T + q0 + r) * 96 + 8 * hh;
#pragma unroll
      for (int ks = 0; ks < 6; ++ks) qf[ks] = *(const bf16x8*)(qp + 16 * ks); }
    f32x16 o0, o1, negm;
#pragma unroll
    for (int i = 0; i < 16; ++i) { o0[i] = 0.f; o1[i] = 0.f; negm[i] = 0.f; }
    float mrow = 0.f, lrow = 0.f;
    LAS float* scr = (LAS float*)(lds + ATT_SCR2 + wid * 256);
    constexpr int NT_ = T / 64;
    const bf16_t* kg = Kb + (size_t)h * T * 96;
    const bf16_t* vg = VT + (size_t)(h * 64 + (tid >> 3)) * T + (tid & 7) * 8;
    const int kl0 = (tid / 12) * 208 + (tid % 12) * 16, c1 = 512 + tid, kl1 = (c1 / 12) * 208 + (c1 % 12) * 16;
    const int vl = (tid >> 3) * 144 + (tid & 7) * 16;
    u32x4 rk0, rk1, rv;
#define ATT_LOADK(tile) do { const size_t t1_ = (size_t)((tile) < NT_ ? (tile) : NT_ - 1) * 64; rk0 = *(const u32x4*)(kg + t1_ * 96 + (size_t)tid * 8); if (tid < 256) rk1 = *(const u32x4*)(kg + t1_ * 96 + (size_t)c1 * 8); } while (0)
#define ATT_LOADV(tile) do { const size_t t1_ = (size_t)((tile) < NT_ ? (tile) : NT_ - 1) * 64; rv = *(const u32x4*)(vg + t1_); } while (0)
#define ATT_STOREK(slot) do { LAS unsigned char* d_ = lds + ATT_KS + (slot) * ATT_KB; *(LAS u32x4*)(d_ + kl0) = rk0; if (tid < 256) *(LAS u32x4*)(d_ + kl1) = rk1; } while (0)
#define ATT_STOREV(slot) do { *(LAS u32x4*)(lds + ATT_VS + (slot) * ATT_VB + vl) = rv; } while (0)
    ATT_LOADK(0); ATT_LOADV(0); ATT_STOREK(0); ATT_STOREV(0);
    ATT_LOADK(1); ATT_STOREK(1);
    ATT_LOADK(2); ATT_LOADV(1);
    __syncthreads();
    f32x16 pA0, pA1, pB0, pB1;
    const unsigned lbase = (unsigned)(size_t)lds;
    const unsigned kfa = lbase + ATT_KS + r * 208 + hh * 16, vfa = lbase + ATT_VS + r * 144 + hh * 16;
    attn_qk(pA0, pA1, kfa, qf, negm);
    { const float mx = attn_rowmax(pA0, pA1); mrow = mx;
#pragma unroll
      for (int i = 0; i < 16; ++i) { pA0[i] -= mx; pA1[i] -= mx; negm[i] = -mx; } }
    __syncthreads();
#define ATT_ITER(PA0_, PA1_, PB0_, PB1_, t) do { \
        attn_qk(PB0_, PB1_, kfa + ((t + 1) & 1) * ATT_KB, qf, negm); \
        f32x2 ls2 = (f32x2){0.f, 0.f}; \
_Pragma("unroll") \
        for (int i = 0; i < 16; ++i) { PA0_[i] = __builtin_amdgcn_exp2f(PA0_[i]); PA1_[i] = __builtin_amdgcn_exp2f(PA1_[i]); } \
_Pragma("unroll") \
        for (int g_ = 0; g_ < 8; ++g_) { __builtin_amdgcn_sched_group_barrier(0x008, 1, 0); __builtin_amdgcn_sched_group_barrier(0x402, 3, 0); } \
_Pragma("unroll") \
        for (int g_ = 0; g_ < 4; ++g_) { __builtin_amdgcn_sched_group_barrier(0x008, 1, 0); __builtin_amdgcn_sched_group_barrier(0x402, 2, 0); } \
_Pragma("unroll") \
        for (int i = 0; i < 16; i += 2) { ls2 += (f32x2){PA0_[i], PA0_[i + 1]}; ls2 += (f32x2){PA1_[i], PA1_[i + 1]}; } \
        lrow += ls2.x + ls2.y; \
        bf16x8 pa[4]; \
_Pragma("unroll") \
        for (int ks = 0; ks < 4; ++ks) { \
            u32x4 w; \
_Pragma("unroll") \
            for (int j = 0; j < 4; ++j) { const int i0 = 8 * (ks & 1) + 2 * j; w[j] = (ks < 2) ? cvtpk(PA0_[i0], PA0_[i0 + 1]) : cvtpk(PA1_[i0], PA1_[i0 + 1]); } \
            pa[ks] = __builtin_bit_cast(bf16x8, w); \
        } \
        attn_pv(o0, o1, vfa + (t & 1) * ATT_VB, pa); \
        const float mx = attn_rowmax(PB0_, PB1_); \
        ATT_STOREK(t & 1); ATT_STOREV((t + 1) & 1); \
        ATT_LOADK(t + 3); ATT_LOADV(t + 2); \
        if (__any(mx > ATT_THR)) { \
            const float dl = fmaxf(mx, 0.f); \
            mrow += dl; \
            const float alpha = __builtin_amdgcn_exp2f(-dl); \
            lrow *= alpha; \
            if (hh == 0) scr[r] = alpha; \
_Pragma("unroll") \
            for (int i = 0; i < 16; ++i) { PB0_[i] -= dl; PB1_[i] -= dl; negm[i] = -mrow; } \
            asm volatile("s_waitcnt lgkmcnt(0)" ::: "memory"); \
_Pragma("unroll") \
            for (int i = 0; i < 16; ++i) { const float a = scr[crow(i, hh)]; o0[i] *= a; o1[i] *= a; } \
        } \
        __syncthreads(); } while (0)
    if (wid >= 4) __builtin_amdgcn_s_setprio(1);
#pragma unroll 1
    for (int t = 0; t < NT_ - 2; t += 2) { ATT_ITER(pA0, pA1, pB0, pB1, t); ATT_ITER(pB0, pB1, pA0, pA1, t + 1); }
    ATT_ITER(pA0, pA1, pB0, pB1, NT_ - 2);
    __builtin_amdgcn_s_setprio(0);
    pA0 = pB0; pA1 = pB1;
#undef ATT_ITER
    {
        float ls = 0.f;
#pragma unroll
        for (int i = 0; i < 16; ++i) { pA0[i] = __builtin_amdgcn_exp2f(pA0[i]); pA1[i] = __builtin_amdgcn_exp2f(pA1[i]); ls += pA0[i] + pA1[i]; }
        lrow += ls;
        bf16x8 pa[4];
#pragma unroll
        for (int ks = 0; ks < 4; ++ks) {
            u32x4 w;
#pragma unroll
            for (int j = 0; j < 4; ++j) { const int i0 = 8 * (ks & 1) + 2 * j; w[j] = (ks < 2) ? cvtpk(pA0[i0], pA0[i0 + 1]) : cvtpk(pA1[i0], pA1[i0 + 1]); }
            pa[ks] = __builtin_bit_cast(bf16x8, w);
        }
        attn_pv(o0, o1, vfa + ((NT_ - 1) & 1) * ATT_VB, pa);
    }
    lrow += __shfl_xor(lrow, 32);
    if (hh == 0) scr[32 + r] = 1.f / lrow;
    asm volatile("s_waitcnt lgkmcnt(0)" ::: "memory");
#pragma unroll
    for (int i = 0; i < 16; ++i) { const int q = crow(i, hh); const float il = scr[32 + q];
        bf16_t* yp = YM + (size_t)(q0 + q) * 512 + h * 64;
        yp[r] = (bf16_t)f2bf(o0[i] * il); yp[32 + r] = (bf16_t)f2bf(o1[i] * il); }
    __syncthreads();
#undef ATT_LOADK
#undef ATT_LOADV
#undef ATT_STOREK
#undef ATT_STOREV
}

struct TileIter {
    int ntn, nrow, G, bid, k, pm, pn; bool xcd;
    DI TileIter(int nrow_, int ntn_, int G_, int bid_) : ntn(ntn_), nrow(nrow_), G(G_), bid(bid_), k(0), pm(0), pn(0), xcd(G_ == 256 && (nrow_ & 7) == 0) {}
    DI bool next() {
        if (xcd) { const int li = (bid >> 3) + 32 * k; ++k; if (li >= (nrow >> 3) * ntn) return false; pm = (bid & 7) + 8 * (li / ntn); pn = li % ntn; return true; }
        const int t = bid + G * k; ++k; if (t >= nrow * ntn) return false; pm = t / ntn; pn = t % ntn; return true;
    }
};
__global__ void __launch_bounds__(NTHREADS, 2) mega(Params P) {
    extern __shared__ __attribute__((aligned(16))) unsigned char lds_raw[];
    LAS unsigned char* lds = (LAS unsigned char*)lds_raw;
    const int G = gridDim.x, bid = blockIdx.x, NGW = G * NWAVES;
#define PHASE_IDS() const int tid = tid_fresh(); const int lane = tid & 63; const int wave = __builtin_amdgcn_readfirstlane(tid >> 6); const int gw = bid * NWAVES + wave; (void)lane; (void)gw; (void)wave;
    volatile LAS unsigned* MISC = (volatile LAS unsigned*)(lds + LDS_MISC);
    if (threadIdx.x < 64) MISC[threadIdx.x] = 0u;
    __syncthreads();
    unsigned char* ws = P.ws;
    XcdBarrier bar = xcd_barrier_post((unsigned*)(ws + WS_CTL) + 1024, MISC + 8);
#ifdef DBG_TS
    unsigned long long* TSp = (unsigned long long*)((unsigned*)(ws + WS_CTL) + 12288); int ts_n = 1;
    if (blockIdx.x == 0 && threadIdx.x == 0) TSp[0] = __builtin_amdgcn_s_memrealtime();
#define GRID_BAR() do { xcd_barrier(bar); if (blockIdx.x == 0 && threadIdx.x == 0) TSp[ts_n] = __builtin_amdgcn_s_memrealtime(); ++ts_n; } while (0)
#else
#define GRID_BAR() xcd_barrier(bar)
#endif

    bf16_t* WT = (bf16_t*)(ws + WS_WT);
    bf16_t* U = (bf16_t*)(ws + WS_U);
    float* XB = (float*)(ws + WS_XB);
    bf16_t* Hb = (bf16_t*)(ws + WS_H2);
    bf16_t* Qb = (bf16_t*)P.out;
    bf16_t* Kb = Qb + (size_t)8 * T * 96;
    bf16_t* VT = Kb + (size_t)8 * T * 96;
    bf16_t* MG = (bf16_t*)P.out;
    ScEnt* SC = (ScEnt*)P.out;
#define gt ((size_t)(blockIdx.x * NTHREADS + tid))
#define GT ((size_t)(gridDim.x * NTHREADS))

    {
    PHASE_IDS();
        LAS float* scr = (LAS float*)(lds + wave * 16384);
        const TrJob jobs[12] = {
            {P.in[4], IN_COLS, 0, 1024, 1920, WT + WT_IN, nullptr},
            {P.in[4], IN_COLS, 1920, 1024, 416, WT + WT_IN + (size_t)1920 * 1024, nullptr},
            {P.in[4], IN_COLS, 2336, 1024, 2048, WT + WT_GATE, nullptr},
            {P.in[20], 1024, 0, 512, 1024, WT + WT_BRA, nullptr},
            {P.in[21], 1024, 0, 512, 1024, WT + WT_BRB, nullptr},
            {P.in[22], 1024, 0, 1024, 1024, WT + WT_OUT, nullptr},
            {P.in[29], 1024, 0, 1024, 1024, WT + WT_PG, nullptr},
            {P.in[30], 1024, 0, 256, 1024, WT + WT_PP, nullptr},
            {P.in[24], 2048, 0, 1024, 2048, WT + WT_PQ, nullptr},
            {P.in[10], 512, 0, 128, 512, WT + WT_G2, nullptr},
            {P.in[17], 768, 0, 256, 768, WT + WT_QUP, P.in[16]},
            {P.in[19], 1024, 0, 128, 1024, WT + WT_KVUP, P.in[18]},
        };
        {
            int total = 0;
#pragma unroll
            for (int j = 0; j < 12; ++j) total += trjob_items(jobs[j]);
            for (int it = gw; it < total; it += NGW) {
                int r = it;
#pragma unroll
                for (int j = 0; j < 12; ++j) {
                    const int ni = trjob_items(jobs[j]);
                    if (r >= 0 && r < ni) transpose_item(jobs[j].W, jobs[j].ldw, jobs[j].col_off, jobs[j].K, jobs[j].WT, jobs[j].ncols, scr, r, lane, jobs[j].ks);
                    r -= ni;
                }
            }
        }
        for (size_t i = gt; i < (size_t)96 * 1024 / 8; i += GT) ((u32x4*)(WT + WT_IN + (size_t)2336 * 1024))[i] = (u32x4){0u, 0u, 0u, 0u};
        for (size_t i = gt; i < (size_t)16 * 128 * 128 / 4; i += GT) { const f32x4 v = ((const f32x4*)P.in[25])[i]; ((u32x2*)(WT + WT_SK))[i] = (u32x2){pk2(v.x, v.y), pk2(v.z, v.w)}; }
        for (size_t i = gt; i < 65536; i += GT) { const int l = (int)(i & 63), cc = (int)((i >> 6) & 63), hh_ = (int)((i >> 12) & 7), dd = (int)(i >> 15);
            WT[WT_W2T + i] = (bf16_t)f2bf(P.in[7][((size_t)dd * 64 + l) * 512 + hh_ * 64 + cc]); WT[WT_A2T + i] = (bf16_t)f2bf(P.in[9][((size_t)dd * 64 + l) * 512 + hh_ * 64 + cc]); }
        for (int m = gw; m < T; m += NGW) rms_row_to_bf16(P.in[0] + (size_t)m * D, P.in[3], (bf16_t*)P.out + (size_t)m * D, lane);
    }
    GRID_BAR();
    {
    PHASE_IDS();
        const int ntn = UW / G_BN, ntile = (T / G_BM) * ntn;
        for (TileIter ti_(T / G_BM, ntn, G, bid); ti_.next(); ) {
            const int row0 = ti_.pm * G_BM, col0 = ti_.pn * G_BN;
            f32x4 acc[4][4]; acc_zero(acc);
            gemm_accum(acc, GemmSrc{(const bf16_t*)P.out, D, WT + WT_IN, D, D}, row0, col0, lds);
            EPI_LOOP(row0, col0) { *(u32x2*)(U + (size_t)EPI_ROW(row0) * UW + EPI_COL(col0)) = (u32x2){pk2(acc[m][n][0], acc[m][n][1]), pk2(acc[m][n][2], acc[m][n][3])}; }
        }
    }
    GRID_BAR();
    {
    PHASE_IDS();
        unsigned* flags = (unsigned*)(ws + WS_CTL) + 16384;
        if (bid < 32) rwkv_passB(ws + WS_CM, (const float*)(ws + WS_GC), flags, bid >> 4, (bid >> 1) & 7, bid & 1, lds);
        else {
            const int pb_ = bid - 32, PG = G - 32;
            {
                PaPre pre; int prev = -1;
                if (pb_ < 4096) pa_prefetch(U, P.in[5], (pb_ & 15) * 256 + (pb_ >> 4), tid, pre);
                for (int j = pb_; j < 4096; j += PG) {
                    const int item = (j & 15) * 256 + (j >> 4), jn = j + PG, nxt = jn < 4096 ? (jn & 15) * 256 + (jn >> 4) : -1;
                    rwkv_passA(P, U, WT + WT_W2T, WT + WT_A2T, ws + WS_CM, (float*)(ws + WS_GC), (float*)(ws + WS_BS), (bf16_t*)(ws + WS_VS), flags, item, prev, nxt, pre, lds
#ifdef DBG_TS
                        , (blockIdx.x == 32) ? (TSp + 24) : nullptr
#endif
                        );
                    prev = item;
                }
            }
#ifdef DBG_TS
            if (blockIdx.x == 32 && threadIdx.x == 0) TSp[21] = __builtin_amdgcn_s_memrealtime();
#endif
            bf16_t* LG = (bf16_t*)(ws + WS_LG);
            for (size_t i = (size_t)pb_ * NTHREADS + tid; i < (size_t)T * 16; i += (size_t)PG * NTHREADS) {
                const int t = (int)(i >> 4), j0 = (int)(i & 15) * 8;
                const bf16_t* up = U + (size_t)t * UW + 1792 + j0;
                const u32x4 cu = *(const u32x4*)up, pu = *(const u32x4*)(t > 0 ? up - UW : up), nu = *(const u32x4*)(t < T - 1 ? up + UW : up);
                const float pf = t > 0 ? 0.5f : 0.f, nf = t < T - 1 ? 0.5f : 0.f;
                const f32x4 m0 = *(const f32x4*)(P.in[5] + 1792 + j0), m1 = *(const f32x4*)(P.in[5] + 1792 + j0 + 4);
                u32x4 w;
#pragma unroll
                for (int j = 0; j < 4; ++j) {
                    const float c0 = __builtin_bit_cast(float, cu[j] << 16), c1 = __builtin_bit_cast(float, cu[j] & 0xffff0000u);
                    const float p0 = __builtin_bit_cast(float, pu[j] << 16), p1 = __builtin_bit_cast(float, pu[j] & 0xffff0000u);
                    const float n0 = __builtin_bit_cast(float, nu[j] << 16), n1 = __builtin_bit_cast(float, nu[j] & 0xffff0000u);
                    const float mu0 = j < 2 ? m0[2 * j] : m1[2 * j - 4], mu1 = j < 2 ? m0[2 * j + 1] : m1[2 * j - 3];
                    w[j] = pk2(sigmoidf_(c0 + mu0 * ((pf * p0 + nf * n0) - c0)), sigmoidf_(c1 + mu1 * ((pf * p1 + nf * n1) - c1)));
                }
                *(u32x4*)(LG + (size_t)t * 128 + j0) = w;
            }
            for (int m = pb_ * NWAVES + wave; m < T / 4; m += PG * NWAVES) mla_prep_token4(P, U, Kb, m, lane);
        }
        {
        unsigned* qctr = (unsigned*)(ws + WS_CTL) + 20544;
        const int nq = (T / G_BM) * 6, nkv = (T / G_BM) * 8;
        for (;;) {
            __syncthreads();
            if (tid == 0) MISC[32] = __hip_atomic_fetch_add(qctr, 1u, __ATOMIC_RELAXED, __HIP_MEMORY_SCOPE_AGENT);
            __syncthreads();
            const int tile = __builtin_amdgcn_readfirstlane((int)MISC[32]);
            if (tile >= nq + nkv) break;
            f32x4 acc[4][4]; acc_zero(acc);
            f32x4 ssv = (f32x4){0.f, 0.f, 0.f, 0.f};
            if (tile < nq) {
                const int row0 = (tile / 6) * G_BM, col0 = (tile % 6) * G_BN;
                gemm_accum_<true, true>(acc, GemmSrc{U + 1920, UW, WT + WT_QUP, 256, 256}, row0, col0, lds, ssv);
#pragma unroll
                for (int m = 0; m < 4; ++m) { float v = ssv[m]; v += __shfl_xor(v, 16); v += __shfl_xor(v, 32); ssv[m] = __builtin_amdgcn_rsqf(v * (1.f / 256.f) + NORM_EPS) * QSCALE; }
                {
                    const int lane_ = tid & 63, wid_ = tid >> 6, wr_ = wid_ >> 1, wc_ = wid_ & 1, fr_ = lane_ & 15, fq_ = lane_ >> 4;
#pragma unroll
                    for (int n = 0; n < 4; n += 2) {
                        const int g16 = (col0 + wc_ * 64 + n * 16) >> 4;
                        if (g16 % 6 == 4) {
#pragma unroll
                            for (int m = 0; m < 4; ++m) {
                                const float pos = (float)((const int*)P.in[2])[row0 + wr_ * 64 + m * 16 + fr_];
#pragma unroll
                                for (int j = 0; j < 4; ++j) {
                                    const float inv = exp2f(-(float)(4 * fq_ + j) * (13.287712379549449f / 16.f));
                                    float sn, cs; fast_sincos(pos * inv, sn, cs);
                                    const float x1 = acc[m][n][j], x2 = acc[m][n + 1][j];
                                    acc[m][n][j] = x1 * cs - x2 * sn; acc[m][n + 1][j] = x2 * cs + x1 * sn;
                                }
                            }
                        }
                    }
                }
                EPI_LOOP(row0, col0) { const int row = EPI_ROW(row0), col = EPI_COL(col0), hq = col / 96, dq = col % 96; const float sc = ssv[m];
                    *(u32x2*)(Qb + ((size_t)hq * T + row) * 96 + dq) = (u32x2){pk2(acc[m][n][0] * sc, acc[m][n][1] * sc), pk2(acc[m][n][2] * sc, acc[m][n][3] * sc)}; }
            } else {
                const int tt = tile - nq, row0 = (tt / 8) * G_BM, hk = tt % 8, col0 = hk * G_BN;
                gemm_accum_<false, true>(acc, GemmSrc{U + 2176, UW, WT + WT_KVUP, 128, 128}, row0, col0, lds, ssv);
#pragma unroll
                for (int m = 0; m < 4; ++m) { float v = ssv[m]; v += __shfl_xor(v, 16); v += __shfl_xor(v, 32); ssv[m] = __builtin_amdgcn_rsqf(v * (1.f / 128.f) + NORM_EPS); }
                const int lane_ = tid & 63, wid_ = tid >> 6, wr_ = wid_ >> 1, wc_ = wid_ & 1, fr_ = lane_ & 15, fq_ = lane_ >> 4;
#pragma unroll
                for (int m = 0; m < 4; ++m) {
                    const f32x4 ir = (f32x4){__shfl(ssv[m], 4 * fq_), __shfl(ssv[m], 4 * fq_ + 1), __shfl(ssv[m], 4 * fq_ + 2), __shfl(ssv[m], 4 * fq_ + 3)};
#pragma unroll
                    for (int n = 0; n < 4; ++n) {
                        const int rbase = row0 + wr_ * 64 + m * 16, cc = wc_ * 64 + n * 16 + fr_;
                        const f32x4 v = acc[m][n] * ir;
                        if (wc_ == 0) {
#pragma unroll
                            for (int j = 0; j < 4; ++j) Kb[((size_t)hk * T + rbase + 4 * fq_ + j) * 96 + cc] = (bf16_t)f2bf(v[j]);
                        } else {
                            *(u32x2*)(VT + (size_t)(hk * 64 + cc - 64) * T + rbase + 8 * (fq_ & 1) + 4 * (fq_ >> 1)) = (u32x2){pk2(v[0], v[1]), pk2(v[2], v[3])};
                        }
                    }
                }
            }
        }
        }
#ifdef DBG_TS
        if (blockIdx.x == 0 && threadIdx.x == 0) TSp[20] = __builtin_amdgcn_s_memrealtime();
#endif
    }
    GRID_BAR();
    {
    PHASE_IDS();
        {
            bf16_t* Gm = (bf16_t*)(ws + WS_GM);
            const int ntn = 512 / G_BN, ntile = (T / G_BM) * ntn;
            unsigned ndone = 0u;
            for (TileIter ti_(T / G_BM, ntn, G, bid); ti_.next(); ) {
                const int row0 = ti_.pm * G_BM, col0 = ti_.pn * G_BN;
                f32x4 acc[4][4]; acc_zero(acc);
                gemm_accum(acc, GemmSrc{(const bf16_t*)(ws + WS_LG), 128, WT + WT_G2, 128, 128}, row0, col0, lds);
                EPI_LOOP(row0, col0) { *(u32x2*)(Gm + (size_t)EPI_ROW(row0) * 512 + EPI_COL(col0)) = (u32x2){pk2(acc[m][n][0], acc[m][n][1]), pk2(acc[m][n][2], acc[m][n][3])}; }
                ++ndone;
            }
            asm volatile("s_waitcnt vmcnt(0)" ::: "memory");
            __syncthreads();
            if (tid == 0) { __builtin_amdgcn_fence(__ATOMIC_RELEASE, "agent"); (void)__hip_atomic_fetch_add((unsigned*)(ws + WS_CTL) + 20608, ndone, __ATOMIC_RELAXED, __HIP_MEMORY_SCOPE_AGENT); }
            for (int m = gw; m < T; m += NGW) rms_row_to_bf16(P.in[0] + (size_t)m * D, P.in[3], (bf16_t*)(ws + WS_HG) + (size_t)m * D, lane);
        }
        for (int unit = bid; unit < 8 * (T / 256); unit += G) attn_unit(Qb, Kb, VT, (bf16_t*)(ws + WS_YM), unit & 7, unit >> 3, lds);
    }
    {
    PHASE_IDS();
    if (tid == 0) {
        unsigned* gctr = (unsigned*)(ws + WS_CTL) + 20608; const unsigned need = (unsigned)((T / G_BM) * (512 / G_BN)); unsigned sp = 0u;
        while (__hip_atomic_load(gctr, __ATOMIC_RELAXED, __HIP_MEMORY_SCOPE_AGENT) < need) { __builtin_amdgcn_s_sleep(1); if (++sp > (1u << 22)) break; }
        __builtin_amdgcn_fence(__ATOMIC_ACQUIRE, "agent");
    }
    __syncthreads();
    for (int m = gw; m < T; m += NGW) rwkv_merge_token(P, (bf16_t*)(ws + WS_VS), ws + WS_CM, (const float*)(ws + WS_BS), (const bf16_t*)(ws + WS_GM), m, lane);
    }
    GRID_BAR();
    {
    PHASE_IDS();
        const bf16_t* YRW = (const bf16_t*)(ws + WS_YRW); const bf16_t* YM = (const bf16_t*)(ws + WS_YM);
        const int ntn = D / G_BN, ntile = (T / G_BM) * ntn;
        for (TileIter ti_(T / G_BM, ntn, G, bid); ti_.next(); ) {
            const int row0 = ti_.pm * G_BM, col0 = ti_.pn * G_BN;
            f32x4 acc1[4][4], acc2[4][4];
            acc_zero(acc1); acc_zero(acc2);
            gemm_accum(acc1, GemmSrc{(const bf16_t*)(ws + WS_HG), D, WT + WT_GATE, D, D}, row0, col0, lds);
            gemm_accum(acc2, GemmSrc{YRW, 512, WT + WT_BRA, 512, 512}, row0, col0, lds);
            {
                EPI_LOOP(row0, col0) {
                    f32x4 o;
#pragma unroll
                    for (int j = 0; j < 4; ++j) o[j] = sigmoidf_(acc1[m][n][j]) * acc2[m][n][j];
                    *(u32x2*)(MG + (size_t)EPI_ROW(row0) * D + EPI_COL(col0)) = (u32x2){pk2(o[0], o[1]), pk2(o[2], o[3])};
                }
            }
            acc_zero(acc1); acc_zero(acc2);
            gemm_accum(acc1, GemmSrc{(const bf16_t*)(ws + WS_HG), D, WT + WT_GATE + (size_t)1024 * 1024, D, D}, row0, col0, lds);
            gemm_accum(acc2, GemmSrc{YM, 512, WT + WT_BRB, 512, 512}, row0, col0, lds);
            {
                EPI_LOOP(row0, col0) {
                    bf16_t* mp = MG + (size_t)EPI_ROW(row0) * D + EPI_COL(col0);
                    const u32x2 pr = *(const u32x2*)mp;
                    f32x4 o;
                    o[0] = __builtin_bit_cast(float, pr.x << 16); o[1] = __builtin_bit_cast(float, pr.x & 0xffff0000u);
                    o[2] = __builtin_bit_cast(float, pr.y << 16); o[3] = __builtin_bit_cast(float, pr.y & 0xffff0000u);
#pragma unroll
                    for (int j = 0; j < 4; ++j) o[j] += sigmoidf_(acc1[m][n][j]) * acc2[m][n][j];
                    *(u32x2*)mp = (u32x2){pk2(o[0], o[1]), pk2(o[2], o[3])};
                }
            }
        }
    }
    GRID_BAR();
    {
    PHASE_IDS();
        bf16_t* PB = (bf16_t*)(ws + WS_PB);
        const int ntn = D / G_BN, ntile = (T / G_BM) * ntn;
        for (TileIter ti_(T / G_BM, ntn, G, bid); ti_.next(); ) {
            const int row0 = ti_.pm * G_BM, col0 = ti_.pn * G_BN;
            f32x4 acc[4][4]; acc_zero(acc);
            gemm_accum(acc, GemmSrc{MG, D, WT + WT_OUT, D, D}, row0, col0, lds);
            {
                float* SSQ = (float*)(ws + WS_GC);
                const int tid_ = tid_fresh(), lane_ = tid_ & 63, wid_ = tid_ >> 6, wr_ = wid_ >> 1, wc_ = wid_ & 1, fr_ = lane_ & 15, fq_ = lane_ >> 4;
#pragma unroll
                for (int m = 0; m < 4; ++m) {
                    const int row = row0 + wr_ * 64 + m * 16 + fr_; float ssq = 0.f;
#pragma unroll
                    for (int n = 0; n < 4; ++n) { const int col = col0 + wc_ * 64 + n * 16 + 4 * fq_; const size_t off = (size_t)row * D + col;
                        const f32x4 xv = *(const f32x4*)(P.in[0] + off) + acc[m][n]; *(f32x4*)(XB + off) = xv;
                        const f32x4 gg = *(const f32x4*)(P.in[23] + col);
                        *(u32x2*)(Hb + off) = (u32x2){pk2(xv[0] * gg[0], xv[1] * gg[1]), pk2(xv[2] * gg[2], xv[3] * gg[3])};
                        ssq += xv[0] * xv[0] + xv[1] * xv[1] + xv[2] * xv[2] + xv[3] * xv[3]; }
                    ssq += __shfl_xor(ssq, 16); ssq += __shfl_xor(ssq, 32);
                    if (fq_ == 0) SSQ[(size_t)(ti_.pn * 2 + wc_) * T + row] = ssq;
                }
            }
        }
        for (size_t i = gt; i < (size_t)T * PLE / 4; i += GT) { const f32x4 v = ((const f32x4*)P.in[1])[i]; ((u32x2*)PB)[i] = (u32x2){pk2(v.x, v.y), pk2(v.z, v.w)}; }
        for (int m = gw; m < 2 * 16384; m += NGW) { const int tbl = __builtin_amdgcn_readfirstlane(m >> 14), row = m & 16383;
            row_to_fp8((tbl ? P.in[27] : P.in[26]) + (size_t)row * D, ws + WS_ET + (size_t)tbl * 16 * MiB + (size_t)row * 128, (float*)(ws + WS_LG) + tbl * 16384 + row, lane); }
    }
    GRID_BAR();
    {
    PHASE_IDS();
        const int ntile = (T / G_BM) * 16;
        for (TileIter ti_(T / G_BM, 16, G, bid); ti_.next(); ) peer_query_tile(Hb, WT + WT_PQ, WT + WT_SK, (const float*)(ws + WS_GC), SC, ti_.pm, ti_.pn, lds);
    }
    GRID_BAR();
    int* EL = (int*)(ws + WS_CM); float* GT_ = (float*)(ws + WS_CM + 8 * MiB); float* CC = (float*)(ws + WS_CM + 16 * MiB);
    float* PS03 = (float*)(ws + WS_U + 32 * MiB); float* PS47 = P.out + (size_t)8 * MiB;
    float* SSQ2 = (float*)(ws + WS_IR);
    {
    PHASE_IDS();
    LAS unsigned char* wl = lds + wave * 17408;
#pragma unroll 1
    for (int q0 = gw * 64; q0 < T * PEER_H; q0 += NGW * 64) {
        const unsigned char* src = (const unsigned char*)(SC + (size_t)q0 * 32);
        u32x4 tmp[16];
#pragma unroll
        for (int k = 0; k < 16; ++k) tmp[k] = *(const u32x4*)(src + k * 1024 + lane * 16);
#pragma unroll
        for (int k = 0; k < 16; ++k) { const int off = k * 1024 + lane * 16; *(LAS u32x4*)(wl + (off >> 8) * 272 + (off & 255)) = tmp[k]; }
        asm volatile("s_waitcnt lgkmcnt(0)" ::: "memory");
        __builtin_amdgcn_wave_barrier();
        peer_route_pair((const LAS u32x4*)(wl + lane * 272), (LAS int*)(wl + lane * 80), (LAS float*)(wl + 5120 + lane * 80));
        asm volatile("s_waitcnt lgkmcnt(0)" ::: "memory");
        __builtin_amdgcn_wave_barrier();
#pragma unroll
        for (int j = 0; j < 4; ++j) { const int m = j * 64 + lane, lo = ((m >> 2) * 20 + (m & 3) * 4) * 4;
            *(u32x4*)(EL + (size_t)q0 * 16 + m * 4) = *(const LAS u32x4*)(wl + lo);
            *(u32x4*)(GT_ + (size_t)q0 * 16 + m * 4) = *(const LAS u32x4*)(wl + 5120 + lo); }
        asm volatile("s_waitcnt lgkmcnt(0)" ::: "memory");
        __builtin_amdgcn_wave_barrier();
    }
    }
    GRID_BAR();
    {
    PHASE_IDS();
    const int xs = G < 8 ? G : 8;
    for (int x = bid & 7; x < 8; x += xs) {
        const int nb = G < 8 ? 1 : (G - x + 7) >> 3, rank = G < 8 ? 0 : bid >> 3;
        peer_gu_slice(EL, Hb, ws + WS_ET + (size_t)x * PEER_SLICE, (x < 4 ? PS03 : PS47) + (size_t)(x & 3) * T * 128, x, rank * NWAVES + wave, nb * NWAVES, lane);
    }
    }
    GRID_BAR();
    {
    PHASE_IDS();
    const float* su = (const float*)(ws + WS_LG); const float* sv = su + 16384;
#pragma unroll 1
    for (int m = gw; m < T; m += 4 * NGW) {
        f32x2 tot[4], gt2[4]; int e0[4], e1[4]; float ssq[4];
#pragma unroll
        for (int u = 0; u < 4; ++u) { const int mm = m + u * NGW < T ? m + u * NGW : T - 1;
            tot[u] = (f32x2){0.f, 0.f};
#pragma unroll
            for (int x = 0; x < 8; ++x) tot[u] += *(const f32x2*)((x < 4 ? PS03 : PS47) + ((size_t)(x & 3) * T + mm) * 128 + 2 * lane);
            ssq[u] = ssq16((const float*)(ws + WS_GC), mm);
            e0[u] = EL[(size_t)mm * 128 + 2 * lane]; e1[u] = EL[(size_t)mm * 128 + 2 * lane + 1];
            gt2[u] = *(const f32x2*)(GT_ + (size_t)mm * 128 + 2 * lane); }
        float su0[4], su1[4], sv0[4], sv1[4];
#pragma unroll
        for (int u = 0; u < 4; ++u) { su0[u] = su[e0[u]]; sv0[u] = sv[e0[u]]; su1[u] = su[e1[u]]; sv1[u] = sv[e1[u]]; }
#pragma unroll
        for (int u = 0; u < 4; ++u) { const int mm = m + u * NGW;
            const float irms = __builtin_amdgcn_rsqf(ssq[u] * (1.f / D) + NORM_EPS);
            const float c0 = gt2[u].x * gelu_erf(tot[u].x * irms * su0[u]) * sv0[u], c1 = gt2[u].y * gelu_erf(tot[u].y * irms * su1[u]) * sv1[u];
            const unsigned w0 = ((__builtin_bit_cast(unsigned, c0) + 0x2000u) & 0xFFFFC000u) | (unsigned)e0[u], w1 = ((__builtin_bit_cast(unsigned, c1) + 0x2000u) & 0xFFFFC000u) | (unsigned)e1[u];
            if (mm < T) *(u32x2*)(CC + (size_t)mm * 128 + 2 * lane) = (u32x2){w0, w1}; }
    }
    }
    GRID_BAR();
    {
    PHASE_IDS();
    const int xs = G < 8 ? G : 8;
    for (int x = bid & 7; x < 8; x += xs) {
        const int nb = G < 8 ? 1 : (G - x + 7) >> 3, rank = G < 8 ? 0 : bid >> 3;
        peer_gv_slice((const unsigned*)CC, ws + WS_ET + 16 * MiB + (size_t)x * PEER_SLICE, XB, Hb, P.in[28], SSQ2, x, rank * NWAVES + wave, nb * NWAVES, lane);
    }
    }
    GRID_BAR();
    {
    PHASE_IDS();
        const bf16_t* PB = (const bf16_t*)(ws + WS_PB);
        const int ntile = (T / G_BM) * (D / G_BN);
        for (TileIter ti_(T / G_BM, D / G_BN, G, bid); ti_.next(); ) {
            const int row0 = ti_.pm * G_BM, col0 = ti_.pn * G_BN;
            f32x4 acc1[4][4], acc2[4][4];
            acc_zero(acc1); acc_zero(acc2);
            gemm_accum(acc1, GemmSrc{PB, PLE, WT + WT_PP, PLE, PLE}, row0, col0, lds);
            gemm_accum(acc2, GemmSrc{Hb, D, WT + WT_PG, D, D}, row0, col0, lds);
            f32x4 ir2v;
            { const int tid_ = tid_fresh(), wr_ = (tid_ >> 6) >> 1, fr_ = tid_ & 15;
#pragma unroll
              for (int m = 0; m < 4; ++m) { float q = 0.f;
#pragma unroll
                  for (int x = 0; x < 8; ++x) q += SSQ2[(size_t)x * T + row0 + wr_ * 64 + m * 16 + fr_];
                  ir2v[m] = __builtin_amdgcn_rsqf(q * (1.f / D) + NORM_EPS); } }
            EPI_LOOP(row0, col0) {
                const size_t off = (size_t)EPI_ROW(row0) * D + EPI_COL(col0);
                const float ir2 = ir2v[m];
                const f32x4 xv = *(const f32x4*)(XB + off);
                f32x4 o;
#pragma unroll
                for (int j = 0; j < 4; ++j) o[j] = xv[j] + acc1[m][n][j] * sigmoidf_(acc2[m][n][j] * ir2);
                *(f32x4*)(XB + off) = o;
            }
        }
    }
    GRID_BAR();
    {
    PHASE_IDS();
#ifdef DBG_TS
    {
        const float us1 = (float)(TSp[DBG_B1] - TSp[DBG_A1]) * 0.01f, us2 = (float)(TSp[DBG_B2] - TSp[DBG_A2]) * 0.01f;
        const float dl = sqrtf(floorf(us1 * 0.05f) * 20.f * 1e-6f);
        for (int m = gw; m < T; m += NGW) {
            rms_row_to_f32(XB + (size_t)m * D, P.in[31], P.out + (size_t)m * D, lane);
            f32x4* o = (f32x4*)(P.out + (size_t)m * D) + lane;
#pragma unroll
            for (int j = 0; j < 4; ++j) { f32x4 v = o[64 * j]; v.x *= 1.f + dl; v.y *= 1.f - dl; v.z *= 1.f + dl; v.w *= 1.f - dl; if (m == 0 && lane == 0 && j == 0) v.x += 1.f + floorf(us2 * 0.1f) * 0.1f; o[64 * j] = v; }
        }
    }
#else
    for (int m = gw; m < T; m += NGW) rms_row_to_f32(XB + (size_t)m * D, P.in[31], P.out + (size_t)m * D, lane);
#endif
    }
}

extern "C" void kernel_launch(void* const* d_in, const int* in_sizes, int n_in, void* d_out, int out_size, void* d_ws, size_t ws_size, hipStream_t stream) {
    static int grid = 0;
    if (grid == 0) {
        if (n_in != 32 || out_size != T * D || ws_size < WS_END) { fprintf(stderr, "kernel_launch: unexpected shapes n_in %d out %d ws %zu\n", n_in, out_size, ws_size); grid = -1; return; }
        int dev = 0, cus = 0, per_cu = 0;
        if (hipGetDevice(&dev) != hipSuccess || hipDeviceGetAttribute(&cus, hipDeviceAttributeMultiprocessorCount, dev) != hipSuccess) { grid = -1; return; }
        if (hipFuncSetAttribute((const void*)mega, hipFuncAttributeMaxDynamicSharedMemorySize, LDS_BYTES) != hipSuccess) { fprintf(stderr, "kernel_launch: hipFuncSetAttribute failed\n"); grid = -1; return; }
        if (hipOccupancyMaxActiveBlocksPerMultiprocessor(&per_cu, (const void*)mega, NTHREADS, LDS_BYTES) != hipSuccess || per_cu < 1) { fprintf(stderr, "kernel_launch: occupancy query says %d blocks per CU\n", per_cu); (void)hipGetLastError(); grid = -1; return; }
        grid = cus;
    }
    if (grid < 0) return;
    (void)hipMemsetAsync((char*)d_ws + WS_CTL, 0, CTL_ZERO_BYTES, stream);
    Params p{};
    for (int i = 0; i < 32; ++i) p.in[i] = (const float*)d_in[i];
    p.out = (float*)d_out; p.ws = (unsigned char*)d_ws;
    hipLaunchKernelGGL(mega, dim3(grid), dim3(NTHREADS), LDS_BYTES, stream, p);
}
```

```cpp
#include <hip/hip_runtime.h>
#include <cstdio>
#include <cstdint>

#define DI __device__ __forceinline__
#define LAS __attribute__((address_space(3)))
#define GAS __attribute__((address_space(1)))
typedef unsigned short bf16_t;
typedef short bf16x8 __attribute__((ext_vector_type(8)));
typedef float f32x4 __attribute__((ext_vector_type(4)));
typedef float f32x2 __attribute__((ext_vector_type(2)));
typedef float f32x16 __attribute__((ext_vector_type(16)));
typedef unsigned u32x4 __attribute__((ext_vector_type(4)));
typedef unsigned u32x2 __attribute__((ext_vector_type(2)));

constexpr int T = 16384, D = 1024, PLE = 256;
constexpr int RW_W = 512, RW_COLS = 1920, MLA_COLS = 416, GATE_COLS = 2048, IN_COLS = 4384;
constexpr int NTHREADS = 512, NWAVES = 8;
constexpr float NORM_EPS = 1e-6f;

constexpr size_t MiB = 1u << 20;
constexpr size_t WS_CTL = 0;
constexpr size_t CTL_ZERO_BYTES = 96 * 1024;
constexpr size_t WS_WT = 1 * MiB;
constexpr size_t WS_CM = 25 * MiB;
constexpr size_t WS_U = 153 * MiB;
constexpr size_t WS_VS = 229 * MiB;
constexpr size_t WS_LG = 245 * MiB;
constexpr size_t WS_BS = 249 * MiB;
constexpr size_t WS_GC = 250 * MiB;
constexpr size_t WS_IR = 251 * MiB;
constexpr size_t WS_END = 252 * MiB;
constexpr int UW = 2432;
constexpr int CM_ITEM = 32768;
constexpr size_t WS_H = WS_CM;
constexpr size_t WS_HG = WS_U;
constexpr size_t WS_GM = WS_U + 48 * MiB;
constexpr size_t WS_YRW = WS_VS;
constexpr size_t WS_H2 = WS_CM + 32 * MiB;
constexpr size_t WS_XB = WS_CM + 64 * MiB;
constexpr size_t WS_YM = WS_U + 32 * MiB;
constexpr size_t WS_ET = WS_U;
constexpr size_t WS_PB = WS_U + 64 * MiB;
constexpr size_t WT_IN = 0;
constexpr size_t WT_GATE = WT_IN + (size_t)2432 * 1024;
constexpr size_t WT_PQ = WT_GATE + (size_t)2048 * 1024;
constexpr size_t WT_OUT = WT_PQ + (size_t)2048 * 1024;
constexpr size_t WT_PG = WT_OUT + (size_t)1024 * 1024;
constexpr size_t WT_BRA = WT_PG + (size_t)1024 * 1024;
constexpr size_t WT_BRB = WT_BRA + (size_t)1024 * 512;
constexpr size_t WT_PP = WT_BRB + (size_t)1024 * 512;
constexpr size_t WT_QUP = WT_PP + (size_t)1024 * 256;
constexpr size_t WT_KVUP = WT_QUP + (size_t)768 * 256;
constexpr size_t WT_SK = WT_KVUP + (size_t)1024 * 128;
constexpr size_t WT_G2 = WT_SK + (size_t)16 * 128 * 128;
constexpr size_t WT_W2T = WT_G2 + (size_t)512 * 128;
constexpr size_t WT_A2T = WT_W2T + 65536;
constexpr size_t WT_END = WT_A2T + 65536;
static_assert(WT_END * 2 <= 24 * MiB, "weights fit");

DI unsigned f2bf(float f) { unsigned u = __builtin_bit_cast(unsigned, f); return (u + 0x7fffu + ((u >> 16) & 1u)) >> 16; }
DI unsigned pk2(float lo, float hi) { return f2bf(lo) | (f2bf(hi) << 16); }
DI float bf2f(unsigned short b) { return __builtin_bit_cast(float, (unsigned)b << 16); }
DI float wave_sum(float v) {
#pragma unroll
    for (int o = 1; o < 64; o <<= 1) v += __shfl_xor(v, o);
    return v;
}
DI int tid_fresh() { int t = threadIdx.x; asm volatile("" : "+v"(t)); return t; }
DI float sigmoidf_(float x) { return 1.f / (1.f + __expf(-x)); }

#define XB_TMO      128
#define XB_XCNT(j)  (256  + 64 * (j))
#define XB_XSUB(j)  (1280 + 64 * (j))
#define XB_XGEN(j)  (2304 + 64 * (j))
#define XB_TOP      3328
#define XB_TOPGEN   3392
#define XCD_BAR_WORDS 3456
#define XB_SPIN_CAP (1u << 18)
DI unsigned xb_ld(unsigned* p)              { return __hip_atomic_load(p, __ATOMIC_RELAXED, __HIP_MEMORY_SCOPE_AGENT); }
DI unsigned xb_add(unsigned* p, unsigned v) { return __hip_atomic_fetch_add(p, v, __ATOMIC_RELAXED, __HIP_MEMORY_SCOPE_AGENT); }
DI unsigned xb_xcc_id() { return (unsigned)__builtin_amdgcn_s_getreg((3 << 11) | 20) & 0xFu; }
#define XB_SPIN(cond, bar) do { unsigned _sp = 0; while (cond) { __builtin_amdgcn_s_sleep(1); \
    if ((++_sp & 255u) == 0u) { if (xb_ld(&(bar)[XB_TMO])) break; if (_sp > XB_SPIN_CAP) { atomicAdd(&(bar)[XB_TMO], 1u); break; } } } } while (0)
struct XcdBarrier { unsigned* bar; unsigned x; volatile LAS unsigned* st; };
DI XcdBarrier xcd_barrier_post(unsigned* bar, volatile LAS unsigned* st) {
    XcdBarrier b; b.bar = bar; b.x = xb_xcc_id(); b.st = st;
    if (threadIdx.x == 0) (void)xb_add(&bar[XB_XCNT(b.x)], 1u);
    return b;
}
DI void xcd_barrier_complete(unsigned* bar, unsigned x, unsigned& nloc, unsigned& nx) {
    const unsigned G = gridDim.x * gridDim.y * gridDim.z;
    unsigned sum, cnt, mine, sp = 0u;
    for (;;) {
        sum = 0u; cnt = 0u; mine = 0u;
#pragma unroll
        for (unsigned j = 0; j < 16; ++j) { const unsigned c = xb_ld(&bar[XB_XCNT(j)]); sum += c; cnt += (c > 0u) ? 1u : 0u; mine = (j == x) ? c : mine; }
        if (sum == G) break;
        __builtin_amdgcn_s_sleep(1);
        if ((++sp & 255u) == 0u) { if (xb_ld(&bar[XB_TMO])) break; if (sp > XB_SPIN_CAP) { atomicAdd(&bar[XB_TMO], 1u); break; } }
    }
    nloc = mine > 0u ? mine : 1u; nx = cnt > 0u ? cnt : 1u;
}
DI void xcd_barrier(const XcdBarrier& b) {
    asm volatile("s_waitcnt vmcnt(0)" ::: "memory");
    __syncthreads();
    if (threadIdx.x == 0) {
        unsigned* bar = b.bar;
        __builtin_amdgcn_s_waitcnt(0);
        unsigned nloc = b.st[0], nx = b.st[1];
        if (nloc == 0u) { xcd_barrier_complete(bar, b.x, nloc, nx); b.st[0] = nloc; b.st[1] = nx; }
        const unsigned old = xb_add(&bar[XB_XSUB(b.x)], 1u);
        const unsigned gen = old / nloc;
        if (old + 1u == (gen + 1u) * nloc) {
            __builtin_amdgcn_fence(__ATOMIC_RELEASE, "agent");
            asm volatile("s_waitcnt vmcnt(0)" ::: "memory");
            const unsigned og = xb_add(&bar[XB_TOP], 1u);
            const unsigned tg = og / nx;
            if (og + 1u == (tg + 1u) * nx) xb_add(&bar[XB_TOPGEN], 1u);
            else XB_SPIN(xb_ld(&bar[XB_TOPGEN]) == tg, bar);
            __builtin_amdgcn_fence(__ATOMIC_ACQUIRE, "agent");
            xb_add(&bar[XB_XGEN(b.x)], 1u);
            asm volatile("s_waitcnt vmcnt(0)" ::: "memory");
        } else {
            XB_SPIN(xb_ld(&bar[XB_XGEN(b.x)]) == gen, bar);
            __builtin_amdgcn_fence(__ATOMIC_ACQUIRE, "agent");
            asm volatile("s_waitcnt vmcnt(0)" ::: "memory");
        }
    }
    __syncthreads();
}

struct Params { const float* in[32]; float* out; unsigned char* ws; };

constexpr int LDS_MISC = 157952;
constexpr int LDS_BYTES = 158208;

DI void transpose_item(const float* W, int ldw, int col_off, int K, bf16_t* WT, int ncols, LAS float* scr, int item, int lane, const float* ks = nullptr) {
    const int nblk = ncols / 32, kb = item / nblk, nb = item % nblk, k0 = 64 * kb, n0 = 32 * nb;
#pragma unroll 8
    for (int i = 0; i < 32; ++i) { const int kk = 2 * i + (lane >> 5); scr[kk * 33 + (lane & 31)] = W[(size_t)(k0 + kk) * ldw + col_off + n0 + (lane & 31)] * (ks ? ks[k0 + kk] : 1.f); }
    asm volatile("s_waitcnt lgkmcnt(0)" ::: "memory");
    const int c = lane & 7;
#pragma unroll
    for (int j = 0; j < 4; ++j) { const int n = (lane >> 3) + 8 * j; const LAS float* s = scr + (8 * c) * 33 + n;
        u32x4 o; o.x = pk2(s[0 * 33], s[1 * 33]); o.y = pk2(s[2 * 33], s[3 * 33]); o.z = pk2(s[4 * 33], s[5 * 33]); o.w = pk2(s[6 * 33], s[7 * 33]);
        *(u32x4*)(WT + (size_t)(n0 + n) * K + k0 + 8 * c) = o; }
    asm volatile("s_waitcnt lgkmcnt(0)" ::: "memory");
}
struct TrJob { const float* W; int ldw, col_off, K, ncols; bf16_t* WT; const float* ks; };
DI int trjob_items(const TrJob& j) { return (j.K / 64) * (j.ncols / 32); }

DI void rms_row_to_bf16(const float* xrow, const float* g, bf16_t* orow, int lane) {
    const f32x4* xr = (const f32x4*)xrow + lane; const f32x4* gr = (const f32x4*)g + lane;
    f32x4 v[4]; float s = 0.f;
#pragma unroll
    for (int j = 0; j < 4; ++j) { v[j] = xr[64 * j]; s += (v[j].x * v[j].x + v[j].y * v[j].y) + (v[j].z * v[j].z + v[j].w * v[j].w); }
    const float r = 1.f / sqrtf(wave_sum(s) * (1.f / D) + NORM_EPS);
    unsigned long long* o8 = (unsigned long long*)orow + lane;
#pragma unroll
    for (int j = 0; j < 4; ++j) { const f32x4 gg = gr[64 * j];
        o8[64 * j] = (unsigned long long)pk2(v[j].x * r * gg.x, v[j].y * r * gg.y) | ((unsigned long long)pk2(v[j].z * r * gg.z, v[j].w * r * gg.w) << 32); }
}
DI void rms_row_to_f32(const float* xrow, const float* g, float* orow, int lane) {
    const f32x4* xr = (const f32x4*)xrow + lane; const f32x4* gr = (const f32x4*)g + lane;
    f32x4 v[4]; float s = 0.f;
#pragma unroll
    for (int j = 0; j < 4; ++j) { v[j] = xr[64 * j]; s += (v[j].x * v[j].x + v[j].y * v[j].y) + (v[j].z * v[j].z + v[j].w * v[j].w); }
    const float r = 1.f / sqrtf(wave_sum(s) * (1.f / D) + NORM_EPS);
    f32x4* o = (f32x4*)orow + lane;
#pragma unroll
    for (int j = 0; j < 4; ++j) { const f32x4 gg = gr[64 * j]; o[64 * j] = (f32x4){v[j].x * r * gg.x, v[j].y * r * gg.y, v[j].z * r * gg.z, v[j].w * r * gg.w}; }
}

struct GemmSrc { const bf16_t* A; int lda; const bf16_t* Bt; int ldb; int K; };
constexpr int G_BM = 256, G_BN = 128, G_BK = 64, G_STAGE = 49152;
#define GEMM_BAR() do { asm volatile("s_waitcnt lgkmcnt(0)" ::: "memory"); __builtin_amdgcn_s_barrier(); asm volatile("" ::: "memory"); } while (0)
template <bool SWAP = true, bool SSQ = false>
DI void gemm_accum_(f32x4 (&acc)[4][4], const GemmSrc s, int row0, int col0, LAS unsigned char* lds, f32x4& ssv) {
    const int tid = tid_fresh(), lane = tid & 63, wid = __builtin_amdgcn_readfirstlane(tid >> 6), wr = wid >> 1, wc = wid & 1, fr = lane & 15, fq = lane >> 4;
    const int nt = s.K / G_BK;
    const int prow = lane >> 3, pch = ((lane & 7) ^ prow) * 8;
    const bf16_t* src[6]; int dst[6];
#pragma unroll
    for (int q = 0; q < 6; ++q) { const int piece = wid * 6 + q;
        src[q] = (piece < 32) ? s.A + (size_t)(row0 + piece * 8 + prow) * s.lda + pch : s.Bt + (size_t)(col0 + (piece - 32) * 8 + prow) * s.ldb + pch;
        dst[q] = (piece < 32) ? piece * 1024 : 32768 + (piece - 32) * 1024; }
#define GEMM_ISSUE(t_, stg_) do { _Pragma("unroll") for (int q = 0; q < 6; ++q) \
        __builtin_amdgcn_global_load_lds((const unsigned*)(src[q] + (t_) * G_BK), (LAS unsigned*)(lds + (stg_) * G_STAGE + dst[q]), 16, 0, 0); } while (0)
    GEMM_ISSUE(0, 0);
    if (nt > 1) { GEMM_ISSUE(1, 1); asm volatile("s_waitcnt vmcnt(6)" ::: "memory"); } else asm volatile("s_waitcnt vmcnt(0)" ::: "memory");
    GEMM_BAR();
    const int aoff = (wr * 64 + fr) * 128, boff = 32768 + (wc * 64 + fr) * 128;
    int sc = 0, sn = 2;
#pragma unroll 1
    for (int t = 0; t < nt; ++t) {
        const LAS unsigned char* cur = lds + sc * G_STAGE;
#pragma unroll
        for (int kk = 0; kk < 2; ++kk) {
            const int ch = ((kk * 4 + fq) ^ (fr & 7)) << 4;
            bf16x8 a[4], b[4];
#pragma unroll
            for (int m = 0; m < 4; ++m) a[m] = *(const LAS bf16x8*)(cur + aoff + m * 2048 + ch);
#pragma unroll
            for (int n = 0; n < 4; ++n) b[n] = *(const LAS bf16x8*)(cur + boff + n * 2048 + ch);
            if constexpr (SSQ) {
#pragma unroll
                for (int m = 0; m < 4; ++m) { const u32x4 w = __builtin_bit_cast(u32x4, a[m]);
#pragma unroll
                    for (int j = 0; j < 4; ++j) { const float lo = __builtin_bit_cast(float, w[j] << 16), hi = __builtin_bit_cast(float, w[j] & 0xffff0000u); ssv[m] += lo * lo + hi * hi; } }
            }
#pragma unroll
            for (int m = 0; m < 4; ++m)
#pragma unroll
                for (int n = 0; n < 4; ++n) acc[m][n] = SWAP ? __builtin_amdgcn_mfma_f32_16x16x32_bf16(b[n], a[m], acc[m][n], 0, 0, 0)
                                                        : __builtin_amdgcn_mfma_f32_16x16x32_bf16(a[m], b[n], acc[m][n], 0, 0, 0);
        }
        if (t + 2 < nt) { GEMM_ISSUE(t + 2, sn); asm volatile("s_waitcnt vmcnt(6)" ::: "memory"); } else asm volatile("s_waitcnt vmcnt(0)" ::: "memory");
        GEMM_BAR();
        sc = (sc == 2) ? 0 : sc + 1; sn = (sn == 2) ? 0 : sn + 1;
    }
#undef GEMM_ISSUE
}
template <bool SWAP = true>
DI void gemm_accum(f32x4 (&acc)[4][4], const GemmSrc s, int row0, int col0, LAS unsigned char* lds) { f32x4 dummy; gemm_accum_<SWAP, false>(acc, s, row0, col0, lds, dummy); }
DI void acc_zero(f32x4 (&acc)[4][4]) {
#pragma unroll
    for (int m = 0; m < 4; ++m)
#pragma unroll
        for (int n = 0; n < 4; ++n) acc[m][n] = (f32x4){0.f, 0.f, 0.f, 0.f};
}
#define EPI_LOOP(row0, col0) \
    const int _tid = tid_fresh(); const int _lane = _tid & 63, _wid = _tid >> 6, _wr = _wid >> 1, _wc = _wid & 1, _fr = _lane & 15, _fq = _lane >> 4; \
    _Pragma("unroll") for (int m = 0; m < 4; ++m) _Pragma("unroll") for (int n = 0; n < 4; ++n)
#define EPI_ROW(row0) ((row0) + _wr * 64 + m * 16 + _fr)
#define EPI_COL(col0) ((col0) + _wc * 64 + n * 16 + 4 * _fq)


constexpr int PEER_H = 8, PEER_K = 16;
struct ScEnt { float v; int i; };
DI float gelu_erf(float x) { return 0.5f * x * (1.f + erff(x * 0.70710678118654752f)); }

DI void ce_desc(unsigned& a, unsigned& b) { const unsigned hi = a > b ? a : b, lo = a > b ? b : a; a = hi; b = lo; }
DI void bitonic_merge16_desc(unsigned (&k)[16]) {
#pragma unroll
    for (int st = 8; st > 0; st >>= 1)
#pragma unroll
        for (int i = 0; i < 16; ++i) if ((i & st) == 0) ce_desc(k[i], k[i | st]);
}
DI void bitonic_sort16_desc(unsigned (&k)[16]) {
#pragma unroll
    for (int size = 2; size <= 16; size <<= 1)
#pragma unroll
        for (int st = size >> 1; st > 0; st >>= 1)
#pragma unroll
            for (int i = 0; i < 16; ++i) if ((i & st) == 0) { if ((i & size) == 0 || size == 16) ce_desc(k[i], k[i | st]); else ce_desc(k[i | st], k[i]); }
}
DI void top16_merge(unsigned (&a)[16], const unsigned (&b)[16]) {
#pragma unroll
    for (int i = 0; i < 16; ++i) a[i] = a[i] > b[15 - i] ? a[i] : b[15 - i];
    bitonic_merge16_desc(a);
}
DI unsigned score_key(float f, int idx) { const unsigned u = __builtin_bit_cast(unsigned, f); const unsigned m = (u & 0x80000000u) ? ~u : (u | 0x80000000u); return (m & ~127u) | (unsigned)(127 - idx); }
DI float key_score(unsigned key) { const unsigned k = key & ~127u; return __builtin_bit_cast(float, (k & 0x80000000u) ? (k & 0x7fffffffu) : ~k); }
DI float ssq16(const float* P16, int row) { float q = 0.f;
#pragma unroll
    for (int k = 0; k < 16; ++k) q += P16[(size_t)k * T + row];
    return q; }
DI void peer_query_tile(const bf16_t* Hb, const bf16_t* WTpq, const bf16_t* SK, const float* SSQ, ScEnt* SC, int pm, int pn, LAS unsigned char* lds) {
    const int tid = tid_fresh(), lane = tid & 63, wid = tid >> 6, wr = wid >> 1, wc = wid & 1, fr = lane & 15, fq = lane >> 4;
    const int row0 = pm * G_BM, col0 = pn * G_BN;
    f32x4 acc[4][4]; acc_zero(acc);
    gemm_accum(acc, GemmSrc{Hb, D, WTpq, D, D}, row0, col0, lds);
#pragma unroll
    for (int m = 0; m < 4; ++m)
#pragma unroll
        for (int n = 0; n < 4; ++n) {
            const int r = wr * 64 + m * 16 + fr, c = wc * 64 + n * 16 + 4 * fq;
            const int kt = c >> 6, ch = (c & 63) >> 3;
            *(LAS u32x2*)(lds + kt * 32768 + r * 128 + ((ch ^ (r & 7)) << 4) + (c & 7) * 2) = (u32x2){pk2(acc[m][n][0], acc[m][n][1]), pk2(acc[m][n][2], acc[m][n][3])};
        }
    {
        const bf16_t* sk = SK + (size_t)pn * 128 * 128;
#pragma unroll
        for (int i = 0; i < 4; ++i) { const int id = tid + i * 512, r = id >> 4, c16 = id & 15, kt = c16 >> 3, ch = c16 & 7;
            *(LAS u32x4*)(lds + 65536 + kt * 16384 + r * 128 + ((ch ^ (r & 7)) << 4)) = *(const u32x4*)(sk + (size_t)r * 128 + c16 * 8); }
    }
    __syncthreads();
    acc_zero(acc);
#pragma unroll
    for (int kt = 0; kt < 2; ++kt)
#pragma unroll
        for (int kk = 0; kk < 2; ++kk) {
            const int ch = ((kk * 4 + fq) ^ (fr & 7)) << 4;
            bf16x8 a[4], b[4];
#pragma unroll
            for (int m = 0; m < 4; ++m) a[m] = *(const LAS bf16x8*)(lds + kt * 32768 + (wr * 64 + m * 16 + fr) * 128 + ch);
#pragma unroll
            for (int n = 0; n < 4; ++n) b[n] = *(const LAS bf16x8*)(lds + 65536 + kt * 16384 + (wc * 64 + n * 16 + fr) * 128 + ch);
#pragma unroll
            for (int m = 0; m < 4; ++m)
#pragma unroll
                for (int n = 0; n < 4; ++n) acc[m][n] = __builtin_amdgcn_mfma_f32_16x16x32_bf16(b[n], a[m], acc[m][n], 0, 0, 0);
        }
    __syncthreads();
    LAS float* SS = (LAS float*)lds;
#pragma unroll
    for (int m = 0; m < 4; ++m)
#pragma unroll
        for (int n = 0; n < 4; ++n) {
            const int r = wr * 64 + m * 16 + fr, c = wc * 64 + n * 16 + 4 * fq;
            const float irms = __builtin_amdgcn_rsqf(ssq16(SSQ, row0 + r) * (1.f / D) + NORM_EPS);
#pragma unroll
            for (int j = 0; j < 4; ++j) SS[r * 129 + c + j] = acc[m][n][j] * irms;
        }
    __syncthreads();
    const int trow = tid & 255, half = tid >> 8;
    unsigned best[16];
#pragma unroll
    for (int g = 0; g < 4; ++g) {
        unsigned k[16];
#pragma unroll
        for (int i = 0; i < 16; ++i) k[i] = score_key(SS[trow * 129 + half * 64 + g * 16 + i], half * 64 + g * 16 + i);
        bitonic_sort16_desc(k);
        if (g == 0) {
#pragma unroll
            for (int i = 0; i < 16; ++i) best[i] = k[i];
        } else top16_merge(best, k);
    }
    __syncthreads();
    LAS unsigned* LK = (LAS unsigned*)lds;
#pragma unroll
    for (int i = 0; i < 16; i += 4) *(LAS u32x4*)(LK + (trow * 2 + half) * 16 + i) = (u32x4){best[i], best[i + 1], best[i + 2], best[i + 3]};
    __syncthreads();
    if (half == 0) {
        unsigned oth[16];
#pragma unroll
        for (int i = 0; i < 16; i += 4) { const u32x4 t = *(const LAS u32x4*)(LK + (trow * 2 + 1) * 16 + i); oth[i] = t[0]; oth[i + 1] = t[1]; oth[i + 2] = t[2]; oth[i + 3] = t[3]; }
        top16_merge(best, oth);
        ScEnt* dst = SC + ((size_t)(row0 + trow) * 16 + pn) * 16;
#pragma unroll
        for (int r = 0; r < 16; r += 2) { u32x4 o; o[0] = __builtin_bit_cast(unsigned, key_score(best[r])); o[1] = 127u - (best[r] & 127u);
            o[2] = __builtin_bit_cast(unsigned, key_score(best[r + 1])); o[3] = 127u - (best[r + 1] & 127u); *(u32x4*)(dst + r) = o; }
    }
    __syncthreads();
}

typedef __bf16 bf16x2p __attribute__((ext_vector_type(2)));
DI float dot2bf(unsigned a, unsigned b, float acc) { return __builtin_amdgcn_fdot2_f32_bf16(__builtin_bit_cast(bf16x2p, a), __builtin_bit_cast(bf16x2p, b), acc, false); }
DI float reduce8(const float (&d)[8], int lane) {
    const bool h32 = (lane & 32) != 0, h16 = (lane & 16) != 0, h8 = (lane & 8) != 0;
    float a[4], b[2], c;
#pragma unroll
    for (int i = 0; i < 4; ++i) { const float snd = h32 ? d[i] : d[4 + i]; const float rcv = __shfl_xor(snd, 32); a[i] = (h32 ? d[4 + i] : d[i]) + rcv; }
#pragma unroll
    for (int i = 0; i < 2; ++i) { const float snd = h16 ? a[i] : a[2 + i]; const float rcv = __shfl_xor(snd, 16); b[i] = (h16 ? a[2 + i] : a[i]) + rcv; }
    { const float snd = h8 ? b[0] : b[1]; const float rcv = __shfl_xor(snd, 8); c = (h8 ? b[1] : b[0]) + rcv; }
    c += __shfl_xor(c, 4); c += __shfl_xor(c, 2); c += __shfl_xor(c, 1);
    return c;
}
struct PeerTab { const unsigned char* U8; const unsigned char* V8; const float* su; const float* sv; };
DI void peer_load_group(const unsigned char* T8, int eslot, int g7, u32x4 (&rows)[8], int lane) {
#pragma unroll
    for (int j = 0; j < 8; ++j) { const int id = __shfl(eslot, g7 * 8 + j); rows[j] = *(const u32x4*)(T8 + (size_t)id * D + lane * 16); }
    __builtin_amdgcn_sched_barrier(0x4);
}
DI float peer_u_consume(const u32x4 (&ua)[8], float suslot, float svslot, float gslot, int g7, const float (&h)[16], int lane) {
    float dd[8];
#pragma unroll
    for (int j = 0; j < 8; ++j) { float a = 0.f, b = 0.f;
#pragma unroll
        for (int q = 0; q < 4; ++q) { const f32x2 lo = __builtin_amdgcn_cvt_pk_f32_fp8((int)ua[j][q], false), hi = __builtin_amdgcn_cvt_pk_f32_fp8((int)ua[j][q], true);
            a += lo.x * h[4 * q] + lo.y * h[4 * q + 1]; b += hi.x * h[4 * q + 2] + hi.y * h[4 * q + 3]; }
        dd[j] = a + b; }
    const float tot = reduce8(dd, lane);
    const int src = g7 * 8 + (lane >> 3);
    const float gt_ = __shfl(gslot, src), su_ = __shfl(suslot, src), sv_ = __shfl(svslot, src);
    return gt_ * gelu_erf(tot * su_) * sv_;
}
DI void peer_v_consume(const u32x4 (&va)[8], float cslot, int g7, float (&o)[16], int lane) {
#pragma unroll
    for (int j = 0; j < 8; ++j) { const float cf = __shfl(cslot, g7 * 8 + j);
#pragma unroll
        for (int q = 0; q < 4; ++q) { const f32x2 lo = __builtin_amdgcn_cvt_pk_f32_fp8((int)va[j][q], false), hi = __builtin_amdgcn_cvt_pk_f32_fp8((int)va[j][q], true);
            o[4 * q] += cf * lo.x; o[4 * q + 1] += cf * lo.y; o[4 * q + 2] += cf * hi.x; o[4 * q + 3] += cf * hi.y; } }
}
constexpr size_t PEER_SLICE_B = (size_t)16384 * 128;
DI void row_to_fp8(const float* src, unsigned char* dst, float* inv_scale, int lane) {
    const f32x4* xr = (const f32x4*)src + lane;
    f32x4 v[4]; float am = 0.f;
#pragma unroll
    for (int j = 0; j < 4; ++j) { v[j] = xr[64 * j]; am = fmaxf(am, fmaxf(fmaxf(fabsf(v[j].x), fabsf(v[j].y)), fmaxf(fabsf(v[j].z), fabsf(v[j].w)))); }
#pragma unroll
    for (int o = 1; o < 64; o <<= 1) am = fmaxf(am, __shfl_xor(am, o));
    am = fmaxf(am, 1e-20f);
    const float sc = 256.f / am;
#pragma unroll
    for (int j = 0; j < 4; ++j) { int t = 0; t = __builtin_amdgcn_cvt_pk_fp8_f32(v[j].x * sc, v[j].y * sc, t, false); t = __builtin_amdgcn_cvt_pk_fp8_f32(v[j].z * sc, v[j].w * sc, t, true);
        *(unsigned*)(dst + (size_t)(2 * j + (lane >> 5)) * PEER_SLICE_B + 4 * (lane & 31)) = (unsigned)t; }
    if (lane == 0) *inv_scale = am * (1.f / 256.f);
}
DI void peer_token(const float* x1row, float* x2row, bf16_t* hrow, const ScEnt* SCt, const PeerTab& tb, const float* g_ple, float irms, int lane) {
    int ci = 0, st = 0;
    { const int th[15] = {16, 24, 29, 33, 36, 38, 40, 42, 43, 44, 45, 46, 47, 48, 49};
#pragma unroll
      for (int k = 0; k < 15; ++k) { const bool ge = lane >= th[k]; ci += ge ? 1 : 0; st = ge ? th[k] : st; } }
    const int cj = lane - st;
    int es0 = 0, es1 = 0; float gs0 = 0.f, gs1 = 0.f;
#pragma unroll 1
    for (int hd = 0; hd < PEER_H; ++hd) {
        const ScEnt* L0 = SCt + (hd * 2) * 16; const ScEnt* L1 = SCt + (hd * 2 + 1) * 16;
        float v = -INFINITY; int p = 1024 + lane;
        if (lane < 50) { v = L0[ci].v + L1[cj].v; p = ci * 16 + cj; }
#pragma unroll
        for (int k = 2; k <= 64; k <<= 1)
#pragma unroll
            for (int j = k >> 1; j > 0; j >>= 1) {
                const float ov = __shfl_xor(v, j); const int op = __shfl_xor(p, j);
                const bool lower = (lane & j) == 0, desc = (lane & k) == 0 || k == 64;
                const bool og = (ov > v) || (ov == v && op < p);
                const bool sw = (lower == desc) ? og : !og;
                v = sw ? ov : v; p = sw ? op : p;
            }
        const float mx = __shfl(v, 0);
        const float e = (lane < 16) ? __expf(v - mx) : 0.f;
        const float gate = e / wave_sum(e);
        int eidx = 0;
        if (lane < 16) eidx = L0[p >> 4].i * 128 + L1[p & 15].i;
        const int te = __shfl(eidx, lane & 15); const float tg = __shfl(gate, lane & 15);
        if ((lane >> 4) == (hd & 3)) { if (hd < 4) { es0 = te; gs0 = tg; } else { es1 = te; gs1 = tg; } }
    }
    float h[16];
    { const u32x4 ha = *(const u32x4*)(hrow + lane * 16), hb = *(const u32x4*)(hrow + lane * 16 + 8);
#pragma unroll
      for (int j = 0; j < 4; ++j) { h[2 * j] = __builtin_bit_cast(float, ha[j] << 16); h[2 * j + 1] = __builtin_bit_cast(float, ha[j] & 0xffff0000u); h[8 + 2 * j] = __builtin_bit_cast(float, hb[j] << 16); h[8 + 2 * j + 1] = __builtin_bit_cast(float, hb[j] & 0xffff0000u); }
#pragma unroll
      for (int j = 0; j < 16; ++j) h[j] *= irms; }
    const float sus0 = tb.su[es0], svs0 = tb.sv[es0], sus1 = tb.su[es1], svs1 = tb.sv[es1];
    float cs0 = 0.f, cs1 = 0.f;
    float o[16];
#pragma unroll
    for (int j = 0; j < 16; ++j) o[j] = 0.f;
    {
        u32x4 ra[8], rb[8];
        peer_load_group(tb.U8, es0, 0, ra, lane);
#define PEER_PUT(cs, gg, cf) do { const float tmp_ = __shfl(cf, (lane & 7) * 8); if ((lane >> 3) == (gg)) cs = tmp_; } while (0)
#pragma unroll 1
        for (int g = 0; g < 8; g += 2) {
            peer_load_group(tb.U8, es0, g + 1, rb, lane);
            { const float cf = peer_u_consume(ra, sus0, svs0, gs0, g, h, lane); PEER_PUT(cs0, g, cf); }
            peer_load_group(tb.U8, g + 2 < 8 ? es0 : es1, (g + 2) & 7, ra, lane);
            { const float cf = peer_u_consume(rb, sus0, svs0, gs0, g + 1, h, lane); PEER_PUT(cs0, g + 1, cf); }
        }
#pragma unroll 1
        for (int g = 0; g < 8; g += 2) {
            peer_load_group(tb.U8, es1, g + 1, rb, lane);
            { const float cf = peer_u_consume(ra, sus1, svs1, gs1, g, h, lane); PEER_PUT(cs1, g, cf); }
            peer_load_group(g + 2 < 8 ? tb.U8 : tb.V8, g + 2 < 8 ? es1 : es0, (g + 2) & 7, ra, lane);
            { const float cf = peer_u_consume(rb, sus1, svs1, gs1, g + 1, h, lane); PEER_PUT(cs1, g + 1, cf); }
        }
#pragma unroll 1
        for (int g = 0; g < 8; g += 2) {
            peer_load_group(tb.V8, es0, g + 1, rb, lane);
            peer_v_consume(ra, cs0, g, o, lane);
            peer_load_group(tb.V8, g + 2 < 8 ? es0 : es1, (g + 2) & 7, ra, lane);
            peer_v_consume(rb, cs0, g + 1, o, lane);
        }
#pragma unroll 1
        for (int g = 0; g < 8; g += 2) {
            peer_load_group(tb.V8, es1, g + 1, rb, lane);
            peer_v_consume(ra, cs1, g, o, lane);
            if (g + 2 < 8) peer_load_group(tb.V8, es1, g + 2, ra, lane);
            peer_v_consume(rb, cs1, g + 1, o, lane);
        }
#undef PEER_PUT
    }
    float ss = 0.f;
#pragma unroll
    for (int j = 0; j < 4; ++j) { const f32x4 xv = *(const f32x4*)(x1row + lane * 16 + 4 * j);
        o[4 * j] += xv.x; o[4 * j + 1] += xv.y; o[4 * j + 2] += xv.z; o[4 * j + 3] += xv.w;
        *(f32x4*)(x2row + lane * 16 + 4 * j) = (f32x4){o[4 * j], o[4 * j + 1], o[4 * j + 2], o[4 * j + 3]};
        ss += o[4 * j] * o[4 * j] + o[4 * j + 1] * o[4 * j + 1] + o[4 * j + 2] * o[4 * j + 2] + o[4 * j + 3] * o[4 * j + 3]; }
    const float rr = 1.f / sqrtf(wave_sum(ss) * (1.f / D) + NORM_EPS);
    u32x4 w0, w1;
#pragma unroll
    for (int j = 0; j < 4; ++j) { const f32x4 g0 = *(const f32x4*)(g_ple + lane * 16 + 4 * j);
        const unsigned lo = pk2(o[4 * j] * rr * g0.x, o[4 * j + 1] * rr * g0.y), hi = pk2(o[4 * j + 2] * rr * g0.z, o[4 * j + 3] * rr * g0.w);
        if (j < 2) { w0[2 * j] = lo; w0[2 * j + 1] = hi; } else { w1[2 * (j - 2)] = lo; w1[2 * (j - 2) + 1] = hi; } }
    *(u32x4*)(hrow + lane * 16) = w0; *(u32x4*)(hrow + lane * 16 + 8) = w1;
}


DI void peer_route_cand(int lane, int& ci, int& cj) {
    int c_ = 0, st = 0;
    { const int th[15] = {16, 24, 29, 33, 36, 38, 40, 42, 43, 44, 45, 46, 47, 48, 49};
#pragma unroll
      for (int k = 0; k < 15; ++k) { const bool ge = lane >= th[k]; c_ += ge ? 1 : 0; st = ge ? th[k] : st; } }
    ci = c_; cj = lane - st;
}
DI void peer_route_load(const ScEnt* SCt, int ci, int cj, u32x2 (&l0)[8], u32x2 (&l1)[8]) {
#pragma unroll
    for (int hd = 0; hd < 8; ++hd) { l0[hd] = *(const u32x2*)(SCt + hd * 32 + ci); l1[hd] = *(const u32x2*)(SCt + hd * 32 + 16 + cj); }
    __builtin_amdgcn_sched_barrier(0x4);
}
DI void peer_route_compute(const u32x2 (&l0)[8], const u32x2 (&l1)[8], int* ELt, float* GTt, int lane) {
    int es0 = 0, es1 = 0; float gs0 = 0.f, gs1 = 0.f;
#pragma unroll
    for (int h4 = 0; h4 < 8; h4 += 4) {
        float v[4]; unsigned key[4]; int rank[4];
#pragma unroll
        for (int u = 0; u < 4; ++u) { const float vs = __builtin_bit_cast(float, l0[h4 + u].x) + __builtin_bit_cast(float, l1[h4 + u].x); v[u] = lane < 50 ? vs : -INFINITY;
            const unsigned x = __builtin_bit_cast(unsigned, v[u]); const unsigned k = x ^ ((unsigned)((int)x >> 31) | 0x80000000u);
            key[u] = (k & ~63u) | (unsigned)(63 - lane); rank[u] = 0; }
#pragma unroll
        for (int c = 0; c < 50; ++c) {
            unsigned s0, s1, s2, s3;
            asm volatile("v_readlane_b32 %4, %8, %12\n\tv_readlane_b32 %5, %9, %12\n\tv_readlane_b32 %6, %10, %12\n\tv_readlane_b32 %7, %11, %12\n\t"
                         "v_cmp_gt_u32 vcc, %4, %8\n\tv_addc_co_u32 %0, vcc, 0, %0, vcc\n\t"
                         "v_cmp_gt_u32 vcc, %5, %9\n\tv_addc_co_u32 %1, vcc, 0, %1, vcc\n\t"
                         "v_cmp_gt_u32 vcc, %6, %10\n\tv_addc_co_u32 %2, vcc, 0, %2, vcc\n\t"
                         "v_cmp_gt_u32 vcc, %7, %11\n\tv_addc_co_u32 %3, vcc, 0, %3, vcc"
                         : "+v"(rank[0]), "+v"(rank[1]), "+v"(rank[2]), "+v"(rank[3]), "=&s"(s0), "=&s"(s1), "=&s"(s2), "=&s"(s3)
                         : "v"(key[0]), "v"(key[1]), "v"(key[2]), "v"(key[3]), "i"(c) : "vcc");
        }
#pragma unroll
        for (int u = 0; u < 4; ++u) {
            const int eidx = (int)l0[h4 + u].y * 128 + (int)l1[h4 + u].y;
            const float mx = __builtin_bit_cast(float, __builtin_amdgcn_readlane(__builtin_bit_cast(int, v[u]), 0));
            const float e = rank[u] < 16 ? __expf(v[u] - mx) : 0.f;
            const float gate = e / wave_sum(e);
            const int dst = (rank[u] < 16 ? u * 16 + rank[u] : (u ^ 1) * 16) * 4;
            const int te = __builtin_amdgcn_ds_permute(dst, eidx); const float tg = __builtin_bit_cast(float, __builtin_amdgcn_ds_permute(dst, __builtin_bit_cast(int, gate)));
            if ((lane >> 4) == u) { if (h4 == 0) { es0 = te; gs0 = tg; } else { es1 = te; gs1 = tg; } }
        }
    }
    ELt[lane] = es0; ELt[64 + lane] = es1; GTt[lane] = gs0; GTt[64 + lane] = gs1;
}
DI constexpr int cand_ci(int c) { const int th[15] = {16, 24, 29, 33, 36, 38, 40, 42, 43, 44, 45, 46, 47, 48, 49}; int ci = 0; for (int k = 0; k < 15; ++k) if (c >= th[k]) ci = k + 1; return ci; }
DI constexpr int cand_cj(int c) { const int st[16] = {0, 16, 24, 29, 33, 36, 38, 40, 42, 43, 44, 45, 46, 47, 48, 49}; return c - st[cand_ci(c)]; }
DI void peer_route_pair(const LAS u32x4* SCq, LAS int* ELq, LAS float* GTq) {
    u32x4 raw[16];
#pragma unroll
    for (int k = 0; k < 16; ++k) raw[k] = SCq[k];
    asm volatile("s_waitcnt lgkmcnt(0)" : "+v"(raw[0]), "+v"(raw[1]), "+v"(raw[2]), "+v"(raw[3]), "+v"(raw[4]), "+v"(raw[5]), "+v"(raw[6]), "+v"(raw[7]) :: "memory");
    asm volatile("" : "+v"(raw[8]), "+v"(raw[9]), "+v"(raw[10]), "+v"(raw[11]), "+v"(raw[12]), "+v"(raw[13]), "+v"(raw[14]), "+v"(raw[15]) :: "memory");
    __builtin_amdgcn_wave_barrier();
    float v[50]; int L[50];
#pragma unroll
    for (int c = 0; c < 50; ++c) { constexpr int dummy = 0; (void)dummy;
        const int ci = cand_ci(c), cj = cand_cj(c);
        const float a = __builtin_bit_cast(float, (ci & 1) ? raw[ci >> 1].z : raw[ci >> 1].x), b = __builtin_bit_cast(float, (cj & 1) ? raw[8 + (cj >> 1)].z : raw[8 + (cj >> 1)].x);
        v[c] = a + b; L[c] = (ci + 1) * (cj + 1) - 1; }
#pragma unroll
    for (int a = 0; a < 50; ++a) {
        int W = 0, nl = 0;
#pragma unroll
        for (int b = a + 1; b < 50; ++b) {
            if (cand_ci(a) <= cand_ci(b) && cand_cj(a) <= cand_cj(b)) continue;
            const int ge = v[a] >= v[b] ? 1 : 0;
            L[b] += ge; W += ge; ++nl;
        }
        L[a] += nl - W;
    }
    const float mx = v[0];
    float sum = 0.f;
#pragma unroll
    for (int c = 0; c < 50; ++c) { v[c] = L[c] < 16 ? __expf(v[c] - mx) : 0.f; sum += v[c]; }
    const float inv = 1.f / sum;
#pragma unroll
    for (int c = 0; c < 50; ++c) {
        const int ci = cand_ci(c), cj = cand_cj(c);
        if (L[c] < 16) {
            const int i0 = (int)((ci & 1) ? raw[ci >> 1].w : raw[ci >> 1].y), i1 = (int)((cj & 1) ? raw[8 + (cj >> 1)].w : raw[8 + (cj >> 1)].y);
            ELq[L[c]] = i0 * 128 + i1; GTq[L[c]] = v[c] * inv;
        }
    }
}
constexpr size_t PEER_SLICE = (size_t)16384 * 128;
DI void psl_ids(const int* ELt, int g, u32x4 (&id)[4]) {
#pragma unroll
    for (int q = 0; q < 4; ++q) id[q] = *(const u32x4*)(ELt + 16 * g + 4 * q);
    __builtin_amdgcn_sched_barrier(0x4);
}
DI void psl_rows(const unsigned char* sl, const u32x4 (&id)[4], int i, u32x4 (&rows)[16]) {
#pragma unroll
    for (int k = 0; k < 16; ++k) rows[k] = *(const u32x4*)(sl + (size_t)id[k >> 2][k & 3] * 128 + i * 16);
    __builtin_amdgcn_sched_barrier(0x4);
}
DI void psl_u_consume(const u32x4 (&rows)[16], const u32x4 (&hraw)[2], float* Pt, int lane, bool valid) {
    f32x2 hp[8];
#pragma unroll
    for (int j = 0; j < 4; ++j) { hp[j] = (f32x2){__builtin_bit_cast(float, hraw[0][j] << 16), __builtin_bit_cast(float, hraw[0][j] & 0xffff0000u)};
                                  hp[4 + j] = (f32x2){__builtin_bit_cast(float, hraw[1][j] << 16), __builtin_bit_cast(float, hraw[1][j] & 0xffff0000u)}; }
    float d[16];
#pragma unroll
    for (int k = 0; k < 16; ++k) { f32x2 a = (f32x2){0.f, 0.f};
#pragma unroll
        for (int q = 0; q < 4; ++q) { const f32x2 lo = __builtin_amdgcn_cvt_pk_f32_fp8((int)rows[k][q], false), hi = __builtin_amdgcn_cvt_pk_f32_fp8((int)rows[k][q], true);
            a += lo * hp[2 * q]; a += hi * hp[2 * q + 1]; }
        d[k] = a.x + a.y; }
    const bool s4 = (lane & 4) != 0, s2 = (lane & 2) != 0, s1 = (lane & 1) != 0;
    float a[8], b[4], c[2];
#pragma unroll
    for (int j = 0; j < 8; ++j) { const float snd = s4 ? d[j] : d[8 + j]; const float rcv = __shfl_xor(snd, 4); a[j] = (s4 ? d[8 + j] : d[j]) + rcv; }
#pragma unroll
    for (int j = 0; j < 4; ++j) { const float snd = s2 ? a[j] : a[4 + j]; const float rcv = __shfl_xor(snd, 2); b[j] = (s2 ? a[4 + j] : a[j]) + rcv; }
#pragma unroll
    for (int j = 0; j < 2; ++j) { const float snd = s1 ? b[j] : b[2 + j]; const float rcv = __shfl_xor(snd, 1); c[j] = (s1 ? b[2 + j] : b[j]) + rcv; }
    if (valid) *(f32x2*)(Pt + 2 * lane) = (f32x2){c[0], c[1]};
}
DI void peer_gu_slice(const int* EL, const bf16_t* Hb, const unsigned char* sl, float* Px, int x, int w0, int nw, int lane) {
    const int g = lane >> 3, i = lane & 7;
    const int cnt = (T - w0 + nw - 1) / nw;
    if (w0 >= T) return;
#define PSL_TOK(n_) ({ const int t_ = w0 + (n_) * nw; t_ < T ? t_ : T - 1; })
#define PSL_H(hv_, t_) do { const bf16_t* hp_ = Hb + (size_t)(t_) * D + x * 128 + i * 16; hv_[0] = *(const u32x4*)hp_; hv_[1] = *(const u32x4*)(hp_ + 8); } while (0)
    u32x4 ia[4], ib[4], ra[16], rb[16], ha[2], hb[2];
    psl_ids(EL + (size_t)PSL_TOK(0) * 128, g, ia);
    psl_ids(EL + (size_t)PSL_TOK(1) * 128, g, ib);
    PSL_H(ha, PSL_TOK(0)); psl_rows(sl, ia, i, ra);
#pragma unroll 1
    for (int n = 0; n < cnt; n += 2) {
        const int t0 = PSL_TOK(n), t1 = PSL_TOK(n + 1), t2 = PSL_TOK(n + 2), t3 = PSL_TOK(n + 3);
        psl_ids(EL + (size_t)t2 * 128, g, ia);
        PSL_H(hb, t1); psl_rows(sl, ib, i, rb);
        psl_u_consume(ra, ha, Px + (size_t)t0 * 128, lane, true);
        psl_ids(EL + (size_t)t3 * 128, g, ib);
        PSL_H(ha, t2); psl_rows(sl, ia, i, ra);
        psl_u_consume(rb, hb, Px + (size_t)t1 * 128, lane, n + 1 < cnt);
    }
#undef PSL_H
}
DI void psl_v_consume(const u32x4 (&rows)[16], const u32x4 (&cw)[4], f32x2 x1v, float* xrow, bf16_t* hrow, f32x2 gp, float* ssq, int lane, bool valid) {
    f32x2 o[8];
#pragma unroll
    for (int q = 0; q < 8; ++q) o[q] = (f32x2){0.f, 0.f};
#pragma unroll
    for (int k = 0; k < 16; ++k) { const float c1 = __builtin_bit_cast(float, cw[k >> 2][k & 3] & 0xFFFFC000u); const f32x2 c2 = (f32x2){c1, c1};
#pragma unroll
        for (int q = 0; q < 4; ++q) { const f32x2 lo = __builtin_amdgcn_cvt_pk_f32_fp8((int)rows[k][q], false), hi = __builtin_amdgcn_cvt_pk_f32_fp8((int)rows[k][q], true);
            o[2 * q] += c2 * lo; o[2 * q + 1] += c2 * hi; } }
    float d[16];
#pragma unroll
    for (int q = 0; q < 8; ++q) { d[2 * q] = o[q].x; d[2 * q + 1] = o[q].y; }
    const bool s4 = (lane & 32) != 0, s2 = (lane & 16) != 0, s1 = (lane & 8) != 0;
    float a[8], b[4], c[2];
#pragma unroll
    for (int j = 0; j < 8; ++j) { const float snd = s4 ? d[j] : d[8 + j]; const float rcv = __shfl_xor(snd, 32); a[j] = (s4 ? d[8 + j] : d[j]) + rcv; }
#pragma unroll
    for (int j = 0; j < 4; ++j) { const float snd = s2 ? a[j] : a[4 + j]; const float rcv = __shfl_xor(snd, 16); b[j] = (s2 ? a[4 + j] : a[j]) + rcv; }
#pragma unroll
    for (int j = 0; j < 2; ++j) { const float snd = s1 ? b[j] : b[2 + j]; const float rcv = __shfl_xor(snd, 8); c[j] = (s1 ? b[2 + j] : b[j]) + rcv; }
    const int tsrc = 8 * (lane & 7) + (lane >> 3);
    const f32x2 x2 = x1v + (f32x2){__shfl(c[0], tsrc), __shfl(c[1], tsrc)};
    const float ss = wave_sum(x2.x * x2.x + x2.y * x2.y);
    if (valid) {
        *(f32x2*)xrow = x2;
        *(unsigned*)hrow = pk2(x2.x * gp.x, x2.y * gp.y);
        if (lane == 0) *ssq = ss;
    }
}
DI void psl_rows_packed(const unsigned char* sl, const u32x4 (&cw)[4], int i, u32x4 (&rows)[16]) {
#pragma unroll
    for (int k = 0; k < 16; ++k) rows[k] = *(const u32x4*)(sl + (size_t)(cw[k >> 2][k & 3] & 0x3FFFu) * 128 + i * 16);
    __builtin_amdgcn_sched_barrier(0x4);
}
DI void peer_gv_slice(const unsigned* CW, const unsigned char* sl, float* XB, bf16_t* Hb, const float* g_ple, float* SSQ2, int x, int w0, int nw, int lane) {
    const int g = lane >> 3, i = lane & 7, col = x * 128 + 2 * lane;
    const int cnt = (T - w0 + nw - 1) / nw;
    if (w0 >= T) return;
    const f32x2 gp = *(const f32x2*)(g_ple + col);
    u32x4 ia[4], ib[4], ra[16], rb[16], ca[4], cb[4]; f32x2 xa, xb;
    psl_ids((const int*)CW + (size_t)PSL_TOK(0) * 128, g, ia);
    psl_ids((const int*)CW + (size_t)PSL_TOK(1) * 128, g, ib);
    xa = *(const f32x2*)(XB + (size_t)PSL_TOK(0) * D + col); psl_rows_packed(sl, ia, i, ra);
#pragma unroll
    for (int q = 0; q < 4; ++q) ca[q] = ia[q];
#pragma unroll 1
    for (int n = 0; n < cnt; n += 2) {
        const int t0 = PSL_TOK(n), t1 = PSL_TOK(n + 1), t2 = PSL_TOK(n + 2), t3 = PSL_TOK(n + 3);
        psl_ids((const int*)CW + (size_t)t2 * 128, g, ia);
        xb = *(const f32x2*)(XB + (size_t)t1 * D + col); psl_rows_packed(sl, ib, i, rb);
#pragma unroll
        for (int q = 0; q < 4; ++q) cb[q] = ib[q];
        psl_v_consume(ra, ca, xa, XB + (size_t)t0 * D + col, Hb + (size_t)t0 * D + col, gp, SSQ2 + (size_t)x * T + t0, lane, true);
        psl_ids((const int*)CW + (size_t)t3 * 128, g, ib);
        xa = *(const f32x2*)(XB + (size_t)t2 * D + col); psl_rows_packed(sl, ia, i, ra);
#pragma unroll
        for (int q = 0; q < 4; ++q) ca[q] = ia[q];
        psl_v_consume(rb, cb, xb, XB + (size_t)t1 * D + col, Hb + (size_t)t1 * D + col, gp, SSQ2 + (size_t)x * T + t1, lane, n + 1 < cnt);
    }
#undef PSL_TOK
}

DI float ushift(const bf16_t* U, int t, int col, float mu) {
    const float c = bf2f(U[(size_t)t * UW + col]);
    const float pv = t > 0 ? bf2f(U[(size_t)(t - 1) * UW + col]) : 0.f;
    const float nx = t < T - 1 ? bf2f(U[(size_t)(t + 1) * UW + col]) : 0.f;
    return c + mu * (0.5f * (pv + nx) - c);
}
DI void rwkv_scan_naive(const Params& P, const bf16_t* U, bf16_t* RO, float* BS, int d, int h, LAS unsigned char* lds) {
    const int tid = tid_fresh();
    LAS float* W2S = (LAS float*)lds;
    LAS float* A2S = W2S + 4096;
    LAS float* INB = A2S + 4096;
    LAS float* STP = INB + 5 * 2048;
    const float* mu = P.in[5];
    const float* w2 = P.in[7] + (size_t)d * 64 * 512;
    const float* a2 = P.in[9] + (size_t)d * 64 * 512;
    for (int i = tid; i < 4096; i += NTHREADS) { const int l = i >> 6, c = i & 63; W2S[i] = w2[l * 512 + h * 64 + c]; A2S[i] = a2[l * 512 + h * 64 + c]; }
    const int i2 = tid >> 4, c2 = (tid & 15) * 4;
    float w0c[4], a0c[4], kkc[4], kac[4], rkc[4];
#pragma unroll
    for (int j = 0; j < 4; ++j) { const int hc = h * 64 + c2 + j; w0c[j] = P.in[6][d * 512 + hc]; a0c[j] = P.in[8][d * 512 + hc]; kkc[j] = P.in[11][hc]; kac[j] = P.in[12][hc]; rkc[j] = P.in[13][hc]; }
    const int v3 = tid >> 3, q3 = tid & 7;
    float S[8];
#pragma unroll
    for (int j = 0; j < 8; ++j) S[j] = 0.f;
    __syncthreads();
    for (int ch = 0; ch < T / 32; ++ch) {
#pragma unroll 2
        for (int e = tid; e < 5 * 2048; e += NTHREADS) {
            const int grp = e >> 11, i = (e >> 6) & 31, c = e & 63;
            const int sidx = ch * 32 + i, t = d ? (T - 1 - sidx) : sidx;
            const int col = (grp < 3 ? grp * 512 + h * 64 : (grp == 3 ? 1536 : 1664) + d * 64) + c;
            float v = ushift(U, t, col, mu[col]);
            if (grp == 3) v = tanhf(v);
            INB[e] = v;
        }
        __syncthreads();
        {
            float wl[4], al[4];
#pragma unroll
            for (int j = 0; j < 4; ++j) { wl[j] = w0c[j]; al[j] = a0c[j]; }
#pragma unroll 4
            for (int l = 0; l < 64; ++l) {
                const float tw = INB[3 * 2048 + i2 * 64 + l], ta = INB[4 * 2048 + i2 * 64 + l];
                const f32x4 wv = *(const LAS f32x4*)(W2S + l * 64 + c2), av = *(const LAS f32x4*)(A2S + l * 64 + c2);
#pragma unroll
                for (int j = 0; j < 4; ++j) { wl[j] += tw * wv[j]; al[j] += ta * av[j]; }
            }
            float kk[4], ss = 0.f, bsum = 0.f, kd[4], alr[4], dec[4], rr[4];
#pragma unroll
            for (int j = 0; j < 4; ++j) {
                const float kv = INB[1 * 2048 + i2 * 64 + c2 + j]; rr[j] = INB[0 * 2048 + i2 * 64 + c2 + j];
                kk[j] = kv * kkc[j]; ss += kk[j] * kk[j];
                alr[j] = 1.f / (1.f + expf(-al[j]));
                const float wlog = -log1pf(expf(-wl[j])) - 0.5f;
                dec[j] = expf(-expf(wlog));
                kd[j] = kv * (1.f + (alr[j] - 1.f) * kac[j]);
                bsum += rr[j] * kd[j] * rkc[j];
            }
#pragma unroll
            for (int o = 1; o < 16; o <<= 1) { ss += __shfl_xor(ss, o); bsum += __shfl_xor(bsum, o); }
            const float inv = 1.f / fmaxf(sqrtf(ss), 1e-12f);
            const int sidx = ch * 32 + i2, t = d ? (T - 1 - sidx) : sidx;
            if ((tid & 15) == 0) BS[((size_t)d * T + t) * 8 + h] = bsum;
#pragma unroll
            for (int j = 0; j < 4; ++j) { const float k1 = kk[j] * inv;
                STP[(i2 * 5 + 0) * 64 + c2 + j] = -k1; STP[(i2 * 5 + 1) * 64 + c2 + j] = k1 * alr[j];
                STP[(i2 * 5 + 2) * 64 + c2 + j] = kd[j]; STP[(i2 * 5 + 3) * 64 + c2 + j] = dec[j]; STP[(i2 * 5 + 4) * 64 + c2 + j] = rr[j]; }
        }
        __syncthreads();
#pragma unroll 2
        for (int i = 0; i < 32; ++i) {
            const LAS float* sp = STP + i * 320 + q3 * 8;
            float av[8], bv[8], kv[8], wv[8], rv[8];
#pragma unroll
            for (int j = 0; j < 8; j += 4) {
                const f32x4 a4 = *(const LAS f32x4*)(sp + j), b4 = *(const LAS f32x4*)(sp + 64 + j), k4 = *(const LAS f32x4*)(sp + 128 + j), w4 = *(const LAS f32x4*)(sp + 192 + j), r4 = *(const LAS f32x4*)(sp + 256 + j);
#pragma unroll
                for (int u = 0; u < 4; ++u) { av[j + u] = a4[u]; bv[j + u] = b4[u]; kv[j + u] = k4[u]; wv[j + u] = w4[u]; rv[j + u] = r4[u]; }
            }
            const float vv = INB[2 * 2048 + i * 64 + v3];
            float sa = 0.f;
#pragma unroll
            for (int j = 0; j < 8; ++j) sa += S[j] * av[j];
            sa += __shfl_xor(sa, 1); sa += __shfl_xor(sa, 2); sa += __shfl_xor(sa, 4);
            float ov = 0.f;
#pragma unroll
            for (int j = 0; j < 8; ++j) { S[j] = S[j] * wv[j] + sa * bv[j] + vv * kv[j]; ov += S[j] * rv[j]; }
            ov += __shfl_xor(ov, 1); ov += __shfl_xor(ov, 2); ov += __shfl_xor(ov, 4);
            if (q3 == 0) { const int sidx = ch * 32 + i, t = d ? (T - 1 - sidx) : sidx; RO[((size_t)d * T + t) * 512 + h * 64 + v3] = (bf16_t)f2bf(ov); }
        }
        __syncthreads();
    }
}
DI void rwkv_merge_token(const Params& P, bf16_t* VSY, const unsigned char* CM, const float* BS, const bf16_t* Gm, int t, int lane) {
    const int c0 = lane * 8, h = lane >> 3, vhalf = (lane >> 2) & 1, ch32 = (lane & 3) * 8;
    const int s1 = T - 1 - t;
    const u32x4 o0 = *(const u32x4*)(CM + ((size_t)(h * 256 + (t >> 6))) * CM_ITEM + 16384 + vhalf * 4096 + (t & 63) * 64 + ch32 * 2);
    const u32x4 o1 = *(const u32x4*)(CM + ((size_t)((8 + h) * 256 + (s1 >> 6))) * CM_ITEM + 16384 + vhalf * 4096 + (s1 & 63) * 64 + ch32 * 2);
    float o[8]; float s = 0.f;
#pragma unroll
    for (int j = 0; j < 4; ++j) { o[2 * j] = __builtin_bit_cast(float, o0[j] << 16) + __builtin_bit_cast(float, o1[j] << 16);
        o[2 * j + 1] = __builtin_bit_cast(float, o0[j] & 0xffff0000u) + __builtin_bit_cast(float, o1[j] & 0xffff0000u); s += o[2 * j] + o[2 * j + 1]; }
    s += __shfl_xor(s, 1); s += __shfl_xor(s, 2); s += __shfl_xor(s, 4);
    const float mean = s * (1.f / 64.f); float q = 0.f;
#pragma unroll
    for (int j = 0; j < 8; ++j) { o[j] -= mean; q += o[j] * o[j]; }
    q += __shfl_xor(q, 1); q += __shfl_xor(q, 2); q += __shfl_xor(q, 4);
    const float rstd = 1.f / sqrtf(q * (1.f / 64.f) + 64e-5f);
    const float bonus = BS[(size_t)t * 8 + h] + BS[((size_t)T + t) * 8 + h];
    const u32x4 g4 = *(const u32x4*)(Gm + (size_t)t * 512 + c0);
    const u32x4 v4 = *(const u32x4*)(VSY + (size_t)t * 512 + c0);
    const f32x4 gw0 = *(const f32x4*)(P.in[14] + c0), gw1 = *(const f32x4*)(P.in[14] + c0 + 4), gb0 = *(const f32x4*)(P.in[15] + c0), gb1 = *(const f32x4*)(P.in[15] + c0 + 4);
    u32x4 w;
#pragma unroll
    for (int j = 0; j < 4; ++j) {
        float y[2];
#pragma unroll
        for (int u = 0; u < 2; ++u) { const int e = 2 * j + u;
            const float vs = u ? __builtin_bit_cast(float, v4[j] & 0xffff0000u) : __builtin_bit_cast(float, v4[j] << 16);
            const float gg = u ? __builtin_bit_cast(float, g4[j] & 0xffff0000u) : __builtin_bit_cast(float, g4[j] << 16);
            const float gnw = e < 4 ? gw0[e] : gw1[e - 4], gnb = e < 4 ? gb0[e] : gb1[e - 4];
            y[u] = (o[e] * rstd * gnw + gnb + bonus * vs) * gg; }
        w[j] = pk2(y[0], y[1]);
    }
    *(u32x4*)(VSY + (size_t)t * 512 + c0) = w;
}


constexpr int PA_RF = 0, PA_KF = 16384, PA_VF = 32768, PA_WL = 49152, PA_AL = 65536, PA_LW = 81920, PA_LA = 90112, PA_AR = 98304, PA_BK = 114688,
              PA_YG = 131072, PA_VT = 147456, PA_SEG = 155648, PA_GCL = 157696;
constexpr int PA_N = 0, PA_NT = 8192, PA_QRB = 16384, PA_QRK = 24576, PA_T0 = 32768, PA_T1 = 40960, PA_A0 = 49152, PA_AT0 = 57344, PA_A1 = 65536, PA_AT1 = 73728,
              PA_BT = 81920, PA_KT = 90112, PA_GT = 114688, PA_OK = 32768, PA_AT = PA_YG, PA_PAKT = PA_YG + 8192;
typedef __bf16 bf16x2_t __attribute__((ext_vector_type(2)));
DI unsigned cvtpk(float lo, float hi) { f32x2 v = {lo, hi}; bf16x2_t b = __builtin_convertvector(v, bf16x2_t); return __builtin_bit_cast(unsigned, b); }
DI int pswz(int row) { return (row ^ (row >> 3)) & 7; }
DI int lofs(int row, int col) { return row * 128 + ((((col >> 3) ^ pswz(row))) << 4) + (col & 7) * 2; }
DI bf16x8 lfrag(const LAS unsigned char* M, int row, int kk, int fq) { return *(const LAS bf16x8*)(M + row * 128 + (((kk * 4 + fq) ^ pswz(row)) << 4)); }
template <int NT, bool SWAP>
DI void mm16(f32x4 (&acc)[NT], const LAS unsigned char* X, int xrow0, const LAS unsigned char* Y, int yrow0, int fr, int fq) {
#pragma unroll
    for (int kk = 0; kk < 2; ++kk) {
        const bf16x8 xf = lfrag(X, xrow0 + fr, kk, fq);
#pragma unroll
        for (int n = 0; n < NT; ++n) {
            const bf16x8 yf = lfrag(Y, yrow0 + n * 16 + fr, kk, fq);
            acc[n] = SWAP ? __builtin_amdgcn_mfma_f32_16x16x32_bf16(yf, xf, acc[n], 0, 0, 0) : __builtin_amdgcn_mfma_f32_16x16x32_bf16(xf, yf, acc[n], 0, 0, 0);
        }
    }
}
DI void st4(LAS unsigned char* M, int row, int col, f32x4 v) { *(LAS u32x2*)(M + lofs(row, col)) = (u32x2){cvtpk(v[0], v[1]), cvtpk(v[2], v[3])}; }
DI f32x4 ld4(const LAS unsigned char* M, int row, int col) { const u32x2 p = *(const LAS u32x2*)(M + lofs(row, col));
    return (f32x4){__builtin_bit_cast(float, p.x << 16), __builtin_bit_cast(float, p.x & 0xffff0000u), __builtin_bit_cast(float, p.y << 16), __builtin_bit_cast(float, p.y & 0xffff0000u)}; }
DI void st1(LAS unsigned char* M, int row, int col, float v) { *(LAS bf16_t*)(M + lofs(row, col)) = (bf16_t)(cvtpk(v, 0.f) & 0xffffu); }

#define LDS_BAR() do { asm volatile("s_waitcnt lgkmcnt(0)" ::: "memory"); __builtin_amdgcn_s_barrier(); asm volatile("" ::: "memory"); } while (0)
struct PaPre { u32x4 cu[5], pu[5], nu[5]; f32x4 m0[5], m1[5]; };
DI void pa_prefetch(const bf16_t* U, const float* mu, int item, int tid, PaPre& pre) {
    const int c = item & 255, h = (item >> 8) & 7, d = item >> 11;
    const int i = tid >> 3, c8 = tid & 7;
    const int sidx = c * 64 + i, t = d ? (T - 1 - sidx) : sidx;
#pragma unroll
    for (int q = 0; q < 5; ++q) {
        const int col = (q < 3 ? q * 512 + h * 64 : (q == 3 ? 1536 : 1664) + d * 64) + c8 * 8;
        const bf16_t* up = U + (size_t)t * UW + col;
        pre.cu[q] = *(const u32x4*)up; pre.pu[q] = *(const u32x4*)(t > 0 ? up - UW : up); pre.nu[q] = *(const u32x4*)(t < T - 1 ? up + UW : up);
        pre.m0[q] = *(const f32x4*)(mu + col); pre.m1[q] = *(const f32x4*)(mu + col + 4);
    }
}
DI void rwkv_passA(const Params& P, const bf16_t* U, const bf16_t* W2T, const bf16_t* A2T, unsigned char* CM, float* GC, float* BS, bf16_t* VS, unsigned* flags, int item, int prev_item, int next_item, PaPre& pre, LAS unsigned char* lds, unsigned long long* tacc = nullptr) {
#ifdef DBG_TS
    unsigned long long t_prev = __builtin_amdgcn_s_memrealtime();
#define PA_MARK(k) do { if (tacc && threadIdx.x == 0) { const unsigned long long t_now = __builtin_amdgcn_s_memrealtime(); tacc[k] += t_now - t_prev; t_prev = t_now; } } while (0)
#else
#define PA_MARK(k) do {} while (0)
#endif
    const int tid = tid_fresh(), lane = tid & 63, wid = __builtin_amdgcn_readfirstlane(tid >> 6), fr = lane & 15, fq = lane >> 4;
    const int c = item & 255, h = (item >> 8) & 7, d = item >> 11;
    bf16x8 yfr[2][4];
    { const bf16_t* Yg = ((wid >> 2) ? A2T : W2T) + (size_t)(d * 8 + h) * 4096;
#pragma unroll
      for (int kk = 0; kk < 2; ++kk)
#pragma unroll
        for (int n = 0; n < 4; ++n) yfr[kk][n] = *(const bf16x8*)(Yg + (n * 16 + fr) * 64 + (kk * 4 + fq) * 8); }
    f32x4 b0c[4]; f32x4 kkc[2], kac[2], rkc[2];
    { const float* bp = ((wid >> 2) ? P.in[8] : P.in[6]) + d * 512 + h * 64 + 4 * fq;
#pragma unroll
      for (int n = 0; n < 4; ++n) b0c[n] = *(const f32x4*)(bp + n * 16);
      const int cc_ = (tid & 7) * 8;
      kkc[0] = *(const f32x4*)(P.in[11] + h * 64 + cc_); kkc[1] = *(const f32x4*)(P.in[11] + h * 64 + cc_ + 4);
      kac[0] = *(const f32x4*)(P.in[12] + h * 64 + cc_); kac[1] = *(const f32x4*)(P.in[12] + h * 64 + cc_ + 4);
      rkc[0] = *(const f32x4*)(P.in[13] + h * 64 + cc_); rkc[1] = *(const f32x4*)(P.in[13] + h * 64 + cc_ + 4); }
    {
        const int i = tid >> 3, c8 = tid & 7;
        const int sidx = c * 64 + i, t = d ? (T - 1 - sidx) : sidx;
        const float pf = t > 0 ? 0.5f : 0.f, nf = t < T - 1 ? 0.5f : 0.f;
#pragma unroll
        for (int q = 0; q < 5; ++q) {
            const int col = (q < 3 ? q * 512 + h * 64 : (q == 3 ? 1536 : 1664) + d * 64) + c8 * 8;
            const u32x4 cu = pre.cu[q], pu = pre.pu[q], nu = pre.nu[q];
            const f32x4 m0 = pre.m0[q], m1 = pre.m1[q];
            float v[8];
#pragma unroll
            for (int j = 0; j < 4; ++j) {
                const float c0 = __builtin_bit_cast(float, cu[j] << 16), c1 = __builtin_bit_cast(float, cu[j] & 0xffff0000u);
                const float p0 = __builtin_bit_cast(float, pu[j] << 16), p1 = __builtin_bit_cast(float, pu[j] & 0xffff0000u);
                const float n0 = __builtin_bit_cast(float, nu[j] << 16), n1 = __builtin_bit_cast(float, nu[j] & 0xffff0000u);
                const float mu0 = j < 2 ? m0[2 * j] : m1[2 * j - 4], mu1 = j < 2 ? m0[2 * j + 1] : m1[2 * j - 3];
                v[2 * j] = c0 + mu0 * ((pf * p0 + nf * n0) - c0); v[2 * j + 1] = c1 + mu1 * ((pf * p1 + nf * n1) - c1);
            }
            if (q < 3) {
                LAS float* dst = (LAS float*)(lds + q * 16384) + i * 64 + c8 * 8;
                *(LAS f32x4*)dst = (f32x4){v[0], v[1], v[2], v[3]}; *(LAS f32x4*)(dst + 4) = (f32x4){v[4], v[5], v[6], v[7]};
                if (q == 2) {
#pragma unroll
                    for (int j = 0; j < 8; ++j) st1(lds + PA_VT, c8 * 8 + j, i, v[j]);
                    if (d == 0) *(u32x4*)(VS + (size_t)t * 512 + h * 64 + c8 * 8) = (u32x4){cvtpk(v[0], v[1]), cvtpk(v[2], v[3]), cvtpk(v[4], v[5]), cvtpk(v[6], v[7])};
                }
            } else {
                if (q == 3) {
#pragma unroll
                    for (int j = 0; j < 8; ++j) v[j] = 1.f - 2.f * __builtin_amdgcn_rcpf(1.f + __expf(2.f * v[j]));
                }
                *(LAS u32x4*)(lds + (q == 3 ? PA_LW : PA_LA) + i * 128 + ((c8 ^ pswz(i)) << 4)) = (u32x4){cvtpk(v[0], v[1]), cvtpk(v[2], v[3]), cvtpk(v[4], v[5]), cvtpk(v[6], v[7])};
            }
        }
    }
    LDS_BAR();
    if (next_item >= 0) pa_prefetch(U, P.in[5], next_item, tid, pre);
    PA_MARK(0);
    {
        const int sel = wid >> 2, rb = wid & 3;
        const LAS unsigned char* X = lds + (sel ? PA_LA : PA_LW);
        f32x4 acc[4];
#pragma unroll
        for (int n = 0; n < 4; ++n) acc[n] = (f32x4){0.f, 0.f, 0.f, 0.f};
#pragma unroll
        for (int kk = 0; kk < 2; ++kk) {
            const bf16x8 xf = lfrag(X, rb * 16 + fr, kk, fq);
#pragma unroll
            for (int n = 0; n < 4; ++n) acc[n] = __builtin_amdgcn_mfma_f32_16x16x32_bf16(yfr[kk][n], xf, acc[n], 0, 0, 0);
        }
        const int i = rb * 16 + fr;
#pragma unroll
        for (int n = 0; n < 4; ++n) {
            const int cc = n * 16 + 4 * fq;
            const f32x4 b0 = b0c[n];
            f32x4 o;
#pragma unroll
            for (int j = 0; j < 4; ++j) { const float z = acc[n][j] + b0[j];
                const float sg = __builtin_amdgcn_rcpf(1.f + __expf(-z));
                o[j] = sel ? sg : -0.6065306597126334f * sg; }
            *(LAS f32x4*)((LAS float*)(lds + (sel ? PA_AL : PA_WL)) + i * 64 + cc) = o;
        }
    }
    LDS_BAR();
    PA_MARK(6);
    {
        const int k = tid & 63, seg = tid >> 6;
        LAS float* WL = (LAS float*)(lds + PA_WL); LAS float* SEG = (LAS float*)(lds + PA_SEG);
        float run = 0.f, tmp[8];
#pragma unroll
        for (int ii = 0; ii < 8; ++ii) { run += WL[(seg * 8 + ii) * 64 + k]; tmp[ii] = run; }
        SEG[seg * 64 + k] = run;
        LDS_BAR();
        float off = 0.f;
#pragma unroll
        for (int s = 0; s < 8; ++s) off += (s < seg) ? SEG[s * 64 + k] : 0.f;
#pragma unroll
        for (int ii = 0; ii < 8; ++ii) WL[(seg * 8 + ii) * 64 + k] = tmp[ii] + off;
    }
    LDS_BAR();
    PA_MARK(7);
    {
        const int i = tid >> 3, c8 = tid & 7, cc = c8 * 8;
        const LAS float* Rf = (const LAS float*)(lds + PA_RF) + i * 64 + cc; const LAS float* Kf = (const LAS float*)(lds + PA_KF) + i * 64 + cc;
        const LAS float* Lf = (const LAS float*)(lds + PA_WL) + i * 64 + cc; const LAS float* Af = (const LAS float*)(lds + PA_AL) + i * 64 + cc;
        float rr[8], kv[8], L[8], Lp[8], al[8];
#pragma unroll
        for (int j = 0; j < 8; j += 4) { const f32x4 a = *(const LAS f32x4*)(Rf + j), b = *(const LAS f32x4*)(Kf + j), l4 = *(const LAS f32x4*)(Lf + j), a4 = *(const LAS f32x4*)(Af + j);
            f32x4 lp = (f32x4){0.f, 0.f, 0.f, 0.f}; if (i > 0) lp = *(const LAS f32x4*)(Lf - 64 + j);
#pragma unroll
            for (int u = 0; u < 4; ++u) { rr[j + u] = a[u]; kv[j + u] = b[u]; L[j + u] = l4[u]; Lp[j + u] = lp[u]; al[j + u] = a4[u]; } }
        float kkp[8], kap[8], rkp[8];
#pragma unroll
        for (int j = 0; j < 8; ++j) { kkp[j] = kkc[j >> 2][j & 3]; kap[j] = kac[j >> 2][j & 3]; rkp[j] = rkc[j >> 2][j & 3]; }
        float kk[8], kd[8], ss = 0.f, bsum = 0.f;
#pragma unroll
        for (int j = 0; j < 8; ++j) { kk[j] = kv[j] * kkp[j]; ss += kk[j] * kk[j]; kd[j] = kv[j] * (1.f + (al[j] - 1.f) * kap[j]); bsum += rr[j] * kd[j] * rkp[j]; }
#pragma unroll
        for (int o = 1; o < 8; o <<= 1) { ss += __shfl_xor(ss, o); bsum += __shfl_xor(bsum, o); }
        const float inv = __builtin_amdgcn_rsqf(fmaxf(ss, 1e-24f));
        const int sidx = c * 64 + i, t = d ? (T - 1 - sidx) : sidx;
        if (c8 == 0) BS[((size_t)d * T + t) * 8 + h] = bsum;
        float ah[8], rh[8], bh[8], kh[8];
#pragma unroll
        for (int j = 0; j < 8; ++j) { const float k1 = kk[j] * inv, eL = __expf(L[j]), eLm = __expf(-L[j]), eP = __expf(Lp[j]);
            ah[j] = -k1 * eP; rh[j] = rr[j] * eL; bh[j] = k1 * al[j] * eLm; kh[j] = kd[j] * eLm;
            if (i == 63) { ((LAS float*)(lds + PA_GCL))[cc + j] = eL; __hip_atomic_store((unsigned*)(GC + (size_t)item * 64 + cc + j), __builtin_bit_cast(unsigned, eL), __ATOMIC_RELAXED, __HIP_MEMORY_SCOPE_AGENT); } }
        const int so = ((c8 ^ pswz(i)) << 4);
        *(LAS u32x4*)(lds + PA_AR + i * 128 + so) = (u32x4){cvtpk(ah[0], ah[1]), cvtpk(ah[2], ah[3]), cvtpk(ah[4], ah[5]), cvtpk(ah[6], ah[7])};
        *(LAS u32x4*)(lds + PA_AR + (64 + i) * 128 + so) = (u32x4){cvtpk(rh[0], rh[1]), cvtpk(rh[2], rh[3]), cvtpk(rh[4], rh[5]), cvtpk(rh[6], rh[7])};
        *(LAS u32x4*)(lds + PA_BK + i * 128 + so) = (u32x4){cvtpk(bh[0], bh[1]), cvtpk(bh[2], bh[3]), cvtpk(bh[4], bh[5]), cvtpk(bh[6], bh[7])};
        *(LAS u32x4*)(lds + PA_BK + (64 + i) * 128 + so) = (u32x4){cvtpk(kh[0], kh[1]), cvtpk(kh[2], kh[3]), cvtpk(kh[4], kh[5]), cvtpk(kh[6], kh[7])};
#pragma unroll
        for (int j = 0; j < 8; ++j) { st1(lds + PA_AT, cc + j, i, ah[j]); st1(lds + PA_BT, cc + j, i, bh[j]); st1(lds + PA_KT, cc + j, i, kh[j]); }
    }
    LDS_BAR();
    PA_MARK(1);
    {
        f32x4 acc[8];
#pragma unroll
        for (int n = 0; n < 8; ++n) acc[n] = (f32x4){0.f, 0.f, 0.f, 0.f};
        mm16<8, true>(acc, lds + PA_AR, wid * 16, lds + PA_BK, 0, fr, fq);
        const int t = (wid & 3) * 16 + fr; const bool isR = wid >= 4;
#pragma unroll
        for (int n = 0; n < 8; ++n) {
            const int j0 = (n & 3) * 16 + 4 * fq; const bool isK = n >= 4;
            f32x4 v = acc[n];
#pragma unroll
            for (int j = 0; j < 4; ++j) { const bool keep = isR ? (j0 + j <= t) : (j0 + j < t); v[j] = keep ? v[j] : 0.f; }
            if (!isR && !isK) {
                st4(lds + PA_N, t, j0, v);
#pragma unroll
                for (int j = 0; j < 4; ++j) st1(lds + PA_NT, j0 + j, t, v[j]);
                f32x4 tv = v;
#pragma unroll
                for (int j = 0; j < 4; ++j) tv[j] += (j0 + j == t) ? 1.f : 0.f;
                st4(lds + PA_T0, t, j0, tv);
            } else if (!isR && isK) {
#pragma unroll
                for (int j = 0; j < 4; ++j) st1(lds + PA_PAKT, j0 + j, t, v[j]);
            } else if (isR && !isK) st4(lds + PA_QRB, t, j0, v);
            else st4(lds + PA_QRK, t, j0, v);
        }
    }
    LDS_BAR();
    PA_MARK(2);
    {
        const int mt = wid >> 1, nt0 = (wid & 1) * 2, row = mt * 16 + fr;
#pragma unroll 1
        for (int s = 0; s < 6; ++s) {
            const LAS unsigned char* Ac = lds + (s == 0 ? PA_N : ((s & 1) ? PA_A0 : PA_A1));
            const LAS unsigned char* ATc = lds + (s == 0 ? PA_NT : ((s & 1) ? PA_AT0 : PA_AT1));
            LAS unsigned char* An = lds + ((s & 1) ? PA_A1 : PA_A0);
            LAS unsigned char* ATn = lds + ((s & 1) ? PA_AT1 : PA_AT0);
            const LAS unsigned char* To = lds + (((s - 1) & 1) ? PA_T1 : PA_T0);
            LAS unsigned char* Tn = lds + ((s & 1) ? PA_T1 : PA_T0);
            if (s < 5) {
                f32x4 aa[2] = {(f32x4){0.f, 0.f, 0.f, 0.f}, (f32x4){0.f, 0.f, 0.f, 0.f}};
                mm16<2, true>(aa, Ac, mt * 16, ATc, nt0 * 16, fr, fq);
#pragma unroll
                for (int n = 0; n < 2; ++n) { const int c0 = (nt0 + n) * 16 + 4 * fq; st4(An, row, c0, aa[n]);
#pragma unroll
                    for (int j = 0; j < 4; ++j) st1(ATn, c0 + j, row, aa[n][j]); }
            }
            if (s > 0) {
                f32x4 ta[2] = {(f32x4){0.f, 0.f, 0.f, 0.f}, (f32x4){0.f, 0.f, 0.f, 0.f}};
                mm16<2, true>(ta, To, mt * 16, ATc, nt0 * 16, fr, fq);
#pragma unroll
                for (int n = 0; n < 2; ++n) { const int c0 = (nt0 + n) * 16 + 4 * fq; const f32x4 o = ld4(To, row, c0) + ta[n]; st4(Tn, row, c0, o); }
            }
            LDS_BAR();
        }
    }
    PA_MARK(3);
    {
        const int mt = wid >> 1, nt0 = (wid & 1) * 4;
        f32x4 acc[4];
#pragma unroll
        for (int n = 0; n < 4; ++n) acc[n] = (f32x4){0.f, 0.f, 0.f, 0.f};
        mm16<4, false>(acc, lds + PA_T1, mt * 16, lds + PA_YG, nt0 * 16, fr, fq);
#pragma unroll
        for (int n = 0; n < 4; ++n) st4(lds + PA_GT, (nt0 + n) * 16 + fr, mt * 16 + 4 * fq, acc[n]);
    }
    asm volatile("s_waitcnt vmcnt(0)" ::: "memory");
    LDS_BAR();
    if (prev_item >= 0 && tid == 0) __hip_atomic_store(flags + prev_item, 1u, __ATOMIC_RELAXED, __HIP_MEMORY_SCOPE_AGENT);
    {
        const int sel = wid >> 2, mt = wid & 3, row = mt * 16 + fr;
        f32x4 acc[8];
#pragma unroll
        for (int n = 0; n < 8; ++n) acc[n] = (f32x4){0.f, 0.f, 0.f, 0.f};
        mm16<8, true>(acc, lds + (sel ? PA_BT : PA_QRB), mt * 16, lds + PA_GT, 0, fr, fq);
        const float gc = ((const LAS float*)(lds + PA_GCL))[row];
        bf16_t* gout = (bf16_t*)(CM + (size_t)item * CM_ITEM + (sel ? 8192 : 0));
#pragma unroll
        for (int n = 0; n < 8; ++n) {
            const int c0 = (n & 3) * 16 + 4 * fq;
            f32x4 v = acc[n];
            if (n < 4) {
                if (sel == 0) v = v + ld4(lds + PA_AR, 64 + row, c0); else v = v * gc;
                const int tb = row >> 5, lanep = (row & 31) + 32 * (fq & 1);
                __hip_atomic_store((unsigned long long*)(gout + (((tb * 4 + n) * 64 + lanep) * 8 + 4 * (fq >> 1))), (unsigned long long)cvtpk(v[0], v[1]) | ((unsigned long long)cvtpk(v[2], v[3]) << 32), __ATOMIC_RELAXED, __HIP_MEMORY_SCOPE_AGENT);
            } else {
                if (sel == 0) v = v + ld4(lds + PA_QRK, row, c0); else v = (v + ld4(lds + PA_KT, row, c0)) * gc;
                st4(lds + PA_OK, sel * 64 + row, c0, v);
            }
        }
    }
    LDS_BAR();
    PA_MARK(4);
    {
        f32x4 acc[4];
#pragma unroll
        for (int n = 0; n < 4; ++n) acc[n] = (f32x4){0.f, 0.f, 0.f, 0.f};
        mm16<4, false>(acc, lds + PA_OK, wid * 16, lds + PA_VT, 0, fr, fq);
        bf16_t* gout = (bf16_t*)(CM + (size_t)item * CM_ITEM + (wid < 4 ? 16384 : 24576));
        const int mt = wid & 3, blk = mt >> 1, reg0 = 4 * ((mt & 1) * 2 + (fq >> 1));
#pragma unroll
        for (int n = 0; n < 4; ++n) {
            const int vhalf = n >> 1, lanep = (n & 1) * 16 + fr + 32 * (fq & 1);
            __hip_atomic_store((unsigned long long*)(gout + (((vhalf * 2 + blk) * 64 + lanep) * 16 + reg0)), (unsigned long long)cvtpk(acc[n][0], acc[n][1]) | ((unsigned long long)cvtpk(acc[n][2], acc[n][3]) << 32), __ATOMIC_RELAXED, __HIP_MEMORY_SCOPE_AGENT);
        }
    }
    PA_MARK(5);
    if (next_item < 0) { asm volatile("s_waitcnt vmcnt(0)" ::: "memory"); LDS_BAR(); if (tid == 0) __hip_atomic_store(flags + item, 1u, __ATOMIC_RELAXED, __HIP_MEMORY_SCOPE_AGENT); }
    else LDS_BAR();
}

#undef PA_MARK
constexpr int PB_STAGE = 24576 + 256, PB_NST = 6, PB_XS = PB_NST * PB_STAGE, PB_XS_SZ = 4096;
DI void pb_out_chunk(const LAS unsigned char* st, const LAS unsigned char* xsb, unsigned char* ROitem, int vhalf, int tb, int lane) {
    const int r = lane & 31, hh = lane >> 5;
    bf16x8 xs[4];
#pragma unroll
    for (int s = 0; s < 4; ++s) xs[s] = *(const LAS bf16x8*)(xsb + (s * 64 + lane) * 16);
    const LAS unsigned char* op = st + 16384 + (tb * 64 + lane) * 32;
    const u32x4 a = *(const LAS u32x4*)op, b = *(const LAS u32x4*)(op + 16);
    f32x16 o;
#pragma unroll
    for (int j = 0; j < 4; ++j) { o[2 * j] = __builtin_bit_cast(float, a[j] << 16); o[2 * j + 1] = __builtin_bit_cast(float, a[j] & 0xffff0000u);
                                  o[8 + 2 * j] = __builtin_bit_cast(float, b[j] << 16); o[8 + 2 * j + 1] = __builtin_bit_cast(float, b[j] & 0xffff0000u); }
#pragma unroll
    for (int s = 0; s < 4; ++s) o = __builtin_amdgcn_mfma_f32_32x32x16_bf16(*(const LAS bf16x8*)(st + ((tb * 4 + s) * 64 + lane) * 16), xs[s], o, 0, 0, 0);
    bf16_t* rp = (bf16_t*)(ROitem + 16384 + vhalf * 4096) + (tb * 32 + 4 * hh) * 32 + r;
#pragma unroll
    for (int i = 0; i < 16; ++i) rp[((i & 3) + 8 * (i >> 2)) * 32] = (bf16_t)(cvtpk(o[i], 0.f) & 0xffffu);
}
DI void pb_state_chunk(const LAS unsigned char* st, const LAS unsigned char* xs_in, LAS unsigned char* xs_out, f32x16& S, int kb, int lane) {
    const int hh = lane >> 5;
    bf16x8 xs[4];
#pragma unroll
    for (int s = 0; s < 4; ++s) xs[s] = *(const LAS bf16x8*)(xs_in + (s * 64 + lane) * 16);
    f32x16 n;
    const LAS float* gcl = (const LAS float*)(st + 24576) + 32 * kb;
    const LAS unsigned char* hp = st + 20480 + (kb * 64 + lane) * 32;
    const u32x4 a0 = *(const LAS u32x4*)hp, b0 = *(const LAS u32x4*)(hp + 16);
#pragma unroll
    for (int j = 0; j < 4; ++j) { n[2 * j] = __builtin_bit_cast(float, a0[j] << 16); n[2 * j + 1] = __builtin_bit_cast(float, a0[j] & 0xffff0000u);
                                  n[8 + 2 * j] = __builtin_bit_cast(float, b0[j] << 16); n[8 + 2 * j + 1] = __builtin_bit_cast(float, b0[j] & 0xffff0000u); }
#pragma unroll
    for (int i = 0; i < 16; ++i) { const int kr = (i & 3) + 8 * (i >> 2) + 4 * hh; n[i] += gcl[kr] * S[i]; }
#pragma unroll
    for (int s = 0; s < 4; ++s) n = __builtin_amdgcn_mfma_f32_32x32x16_bf16(*(const LAS bf16x8*)(st + 8192 + ((kb * 4 + s) * 64 + lane) * 16), xs[s], n, 0, 0, 0);
    S = n;
    const u32x4 w0 = (u32x4){cvtpk(n[0], n[1]), cvtpk(n[2], n[3]), cvtpk(n[4], n[5]), cvtpk(n[6], n[7])};
    const u32x4 w1 = (u32x4){cvtpk(n[8], n[9]), cvtpk(n[10], n[11]), cvtpk(n[12], n[13]), cvtpk(n[14], n[15])};
    *(LAS u32x4*)(xs_out + ((2 * kb) * 64 + lane) * 16) = w0; *(LAS u32x4*)(xs_out + ((2 * kb + 1) * 64 + lane) * 16) = w1;
}
DI void pb_dma(const unsigned char* CM, const float* GC, unsigned* flags, size_t item0, int cc, int vhalf, LAS unsigned char* stg, int lw, int lane) {
    const int c_ = cc < 256 ? cc : 255;
    {
        unsigned sp = 0;
        while (__builtin_amdgcn_readfirstlane(__hip_atomic_load(flags + item0 + c_, __ATOMIC_RELAXED, __HIP_MEMORY_SCOPE_AGENT)) == 0u) { __builtin_amdgcn_s_sleep(4); if (++sp > (1u << 22)) break; }
        asm volatile("" ::: "memory");
    }
    const unsigned char* src = CM + (item0 + c_) * CM_ITEM;
#pragma unroll
    for (int q = 0; q < 6; ++q) {
        const int piece = lw * 6 + q;
        const int soff = piece < 16 ? piece * 1024 : (piece < 20 ? 16384 + vhalf * 4096 + (piece - 16) * 1024 : 24576 + vhalf * 4096 + (piece - 20) * 1024);
        __builtin_amdgcn_global_load_lds((const unsigned*)(src + soff + lane * 16), (LAS unsigned*)(stg + piece * 1024), 16, 0, 16);
    }
    __builtin_amdgcn_global_load_lds((const unsigned*)((const unsigned char*)(GC + (item0 + c_) * 64) + lane * 4), (LAS unsigned*)(stg + 24576), 4, 0, 16);
}
DI void rwkv_passB(unsigned char* CM, const float* GC, unsigned* flags, int d, int h, int vhalf, LAS unsigned char* lds) {
    const int tid = tid_fresh(), lane = tid & 63, wid = __builtin_amdgcn_readfirstlane(tid >> 6);
    const size_t item0 = (size_t)(d * 8 + h) * 256;
    const bool loader = (wid >= 4);
    if (loader) { pb_dma(CM, GC, flags, item0, 0, vhalf, lds + 0 * PB_STAGE, wid - 4, lane); pb_dma(CM, GC, flags, item0, 1, vhalf, lds + 1 * PB_STAGE, wid - 4, lane); pb_dma(CM, GC, flags, item0, 2, vhalf, lds + 2 * PB_STAGE, wid - 4, lane); pb_dma(CM, GC, flags, item0, 3, vhalf, lds + 3 * PB_STAGE, wid - 4, lane);
                  asm volatile("s_waitcnt vmcnt(21)" ::: "memory"); }
    else if (wid < 2) { *(LAS u32x4*)(lds + PB_XS + ((2 * wid) * 64 + lane) * 16) = (u32x4){0u, 0u, 0u, 0u}; *(LAS u32x4*)(lds + PB_XS + ((2 * wid + 1) * 64 + lane) * 16) = (u32x4){0u, 0u, 0u, 0u}; }
    LDS_BAR();
    f32x16 S;
#pragma unroll
    for (int i = 0; i < 16; ++i) S[i] = 0.f;
    int sc = 0, sn = 4;
#pragma unroll 1
    for (int c = 0; c < 256; ++c) {
        const LAS unsigned char* st = lds + sc * PB_STAGE;
        if (wid < 2) pb_state_chunk(st, lds + PB_XS + (c & 1) * PB_XS_SZ, lds + PB_XS + ((c + 1) & 1) * PB_XS_SZ, S, wid, lane);
        else if (wid < 4) pb_out_chunk(st, lds + PB_XS + (c & 1) * PB_XS_SZ, CM + (item0 + c) * CM_ITEM, vhalf, wid - 2, lane);
        else { pb_dma(CM, GC, flags, item0, c + 4, vhalf, lds + sn * PB_STAGE, wid - 4, lane); asm volatile("s_waitcnt vmcnt(21)" ::: "memory"); }
        LDS_BAR();
        sc = (sc + 1 == PB_NST) ? 0 : sc + 1; sn = (sn + 1 == PB_NST) ? 0 : sn + 1;
    }
    asm volatile("s_waitcnt vmcnt(0)" ::: "memory");
    __syncthreads();
}

constexpr float QSCALE = 0.10206207261596575f * 1.4426950408889634f;
DI void fast_sincos(float x, float& sn, float& cs) { const float r = x * 0.15915494309189535f; const float f = r - floorf(r); sn = __builtin_amdgcn_sinf(f); cs = __builtin_amdgcn_cosf(f); }
DI void mla_prep_token4(const Params& P, const bf16_t* U, bf16_t* Kb, int t4, int lane) {
    const int t = t4 * 4 + (lane >> 4), l16 = lane & 15;
    const bf16_t* ur = U + (size_t)t * UW;
    const float x1 = bf2f(ur[2304 + l16]), x2 = bf2f(ur[2304 + 16 + l16]);
    const float pos = (float)((const int*)P.in[2])[t];
    const float inv = exp2f(-(float)l16 * (13.287712379549449f / 16.f));
    float sn, cs; fast_sincos(pos * inv, sn, cs);
    const bf16_t o1 = (bf16_t)f2bf(x1 * cs - x2 * sn), o2 = (bf16_t)f2bf(x2 * cs + x1 * sn);
#pragma unroll
    for (int h = 0; h < 8; ++h) { bf16_t* kp = Kb + ((size_t)h * T + t) * 96; kp[64 + l16] = o1; kp[80 + l16] = o2; }
}
constexpr int ATT_KB = 64 * 208, ATT_VB = 64 * 144;
constexpr float ATT_THR = 8.f;
DI int crow(int reg, int hh) { return (reg & 3) + 8 * (reg >> 2) + 4 * hh; }
constexpr int ATT_KS = 0, ATT_VS = 2 * ATT_KB, ATT_SCR2 = 2 * ATT_KB + 2 * ATT_VB;
DI void lds_read12(bf16x8 (&f)[12], unsigned a) {
    asm volatile("ds_read_b128 %0, %12\n\tds_read_b128 %1, %12 offset:6656\n\tds_read_b128 %2, %12 offset:32\n\tds_read_b128 %3, %12 offset:6688\n\t"
                 "ds_read_b128 %4, %12 offset:64\n\tds_read_b128 %5, %12 offset:6720\n\tds_read_b128 %6, %12 offset:96\n\tds_read_b128 %7, %12 offset:6752\n\t"
                 "ds_read_b128 %8, %12 offset:128\n\tds_read_b128 %9, %12 offset:6784\n\tds_read_b128 %10, %12 offset:160\n\tds_read_b128 %11, %12 offset:6816"
                 : "=&v"(f[0]), "=&v"(f[1]), "=&v"(f[2]), "=&v"(f[3]), "=&v"(f[4]), "=&v"(f[5]), "=&v"(f[6]), "=&v"(f[7]), "=&v"(f[8]), "=&v"(f[9]), "=&v"(f[10]), "=&v"(f[11])
                 : "v"(a) : "memory");
}
DI void lds_wait12(bf16x8 (&f)[12]) {
    asm volatile("s_waitcnt lgkmcnt(0)" : "+v"(f[0]), "+v"(f[1]), "+v"(f[2]), "+v"(f[3]), "+v"(f[4]), "+v"(f[5]), "+v"(f[6]), "+v"(f[7]), "+v"(f[8]), "+v"(f[9]), "+v"(f[10]), "+v"(f[11]) :: "memory");
}
DI void lds_read8(bf16x8 (&f)[8], unsigned a) {
    asm volatile("ds_read_b128 %0, %8\n\tds_read_b128 %1, %8 offset:4608\n\tds_read_b128 %2, %8 offset:32\n\tds_read_b128 %3, %8 offset:4640\n\t"
                 "ds_read_b128 %4, %8 offset:64\n\tds_read_b128 %5, %8 offset:4672\n\tds_read_b128 %6, %8 offset:96\n\tds_read_b128 %7, %8 offset:4704"
                 : "=&v"(f[0]), "=&v"(f[1]), "=&v"(f[2]), "=&v"(f[3]), "=&v"(f[4]), "=&v"(f[5]), "=&v"(f[6]), "=&v"(f[7])
                 : "v"(a) : "memory");
}
DI void lds_wait8(bf16x8 (&f)[8]) {
    asm volatile("s_waitcnt lgkmcnt(0)" : "+v"(f[0]), "+v"(f[1]), "+v"(f[2]), "+v"(f[3]), "+v"(f[4]), "+v"(f[5]), "+v"(f[6]), "+v"(f[7]) :: "memory");
}
DI void attn_qk(f32x16& p0, f32x16& p1, unsigned kaddr, const bf16x8 (&qf)[6], const f32x16& negm) {
    bf16x8 kf[12];
    lds_read12(kf, kaddr);
    lds_wait12(kf);
    p0 = negm; p1 = negm;
#pragma unroll
    for (int ks = 0; ks < 6; ++ks) {
        p0 = __builtin_amdgcn_mfma_f32_32x32x16_bf16(kf[2 * ks], qf[ks], p0, 0, 0, 0);
        p1 = __builtin_amdgcn_mfma_f32_32x32x16_bf16(kf[2 * ks + 1], qf[ks], p1, 0, 0, 0);
    }
}
DI void attn_pv(f32x16& o0, f32x16& o1, unsigned vaddr, const bf16x8 (&pa)[4]) {
    bf16x8 vf[8];
    lds_read8(vf, vaddr);
    lds_wait8(vf);
#pragma unroll
    for (int ks = 0; ks < 4; ++ks) {
        o0 = __builtin_amdgcn_mfma_f32_32x32x16_bf16(pa[ks], vf[2 * ks], o0, 0, 0, 0);
        o1 = __builtin_amdgcn_mfma_f32_32x32x16_bf16(pa[ks], vf[2 * ks + 1], o1, 0, 0, 0);
    }
}
DI float max3_(float a, float b, float c) { float r; asm("v_max3_f32 %0, %1, %2, %3" : "=v"(r) : "v"(a), "v"(b), "v"(c)); return r; }
DI float attn_rowmax(const f32x16& p0, const f32x16& p1) {
    float m0 = max3_(p0[0], p0[1], p0[2]), m1 = max3_(p1[0], p1[1], p1[2]);
#pragma unroll
    for (int i = 3; i < 15; i += 2) { m0 = max3_(m0, p0[i], p0[i + 1]); m1 = max3_(m1, p1[i], p1[i + 1]); }
    const float mx = max3_(m0, m1, p0[15]), my = max3_(mx, p1[15], p1[15]);
    return max3_(my, __shfl_xor(my, 32), my);
}
DI void attn_unit(const bf16_t* Q, const bf16_t* Kb, const bf16_t* VT, bf16_t* YM, int h, int qb, LAS unsigned char* lds) {
    const int tid = tid_fresh(), lane = tid & 63, wid = tid >> 6, r = lane & 31, hh = lane >> 5;
    const int q0 = qb * 256 + wid * 32;
    bf16x8 qf[6];
    { const bf16_t* qp = Q + ((size_t)h * T + q0 + r) * 96 + 8 * hh;
#pragma unroll
      for (int ks = 0; ks < 6; ++ks) qf[ks] = *(const bf16x8*)(qp + 16 * ks); }
    f32x16 o0, o1, negm;
#pragma unroll
    for (int i = 0; i < 16; ++i) { o0[i] = 0.f; o1[i] = 0.f; negm[i] = 0.f; }
    float mrow = 0.f, lrow = 0.f;
    LAS float* scr = (LAS float*)(lds + ATT_SCR2 + wid * 256);
    constexpr int NT_ = T / 64;
    const bf16_t* kg = Kb + (size_t)h * T * 96;
    const bf16_t* vg = VT + (size_t)(h * 64 + (tid >> 3)) * T + (tid & 7) * 8;
    const int kl0 = (tid / 12) * 208 + (tid % 12) * 16, c1 = 512 + tid, kl1 = (c1 / 12) * 208 + (c1 % 12) * 16;
    const int vl = (tid >> 3) * 144 + (tid & 7) * 16;
    u32x4 rk0, rk1, rv;
#define ATT_LOADK(tile) do { const size_t t1_ = (size_t)((tile) < NT_ ? (tile) : NT_ - 1) * 64; rk0 = *(const u32x4*)(kg + t1_ * 96 + (size_t)tid * 8); if (tid < 256) rk1 = *(const u32x4*)(kg + t1_ * 96 + (size_t)c1 * 8); } while (0)
#define ATT_LOADV(tile) do { const size_t t1_ = (size_t)((tile) < NT_ ? (tile) : NT_ - 1) * 64; rv = *(const u32x4*)(vg + t1_); } while (0)
#define ATT_STOREK(slot) do { LAS unsigned char* d_ = lds + ATT_KS + (slot) * ATT_KB; *(LAS u32x4*)(d_ + kl0) = rk0; if (tid < 256) *(LAS u32x4*)(d_ + kl1) = rk1; } while (0)
#define ATT_STOREV(slot) do { *(LAS u32x4*)(lds + ATT_VS + (slot) * ATT_VB + vl) = rv; } while (0)
    ATT_LOADK(0); ATT_LOADV(0); ATT_STOREK(0); ATT_STOREV(0);
    ATT_LOADK(1); ATT_STOREK(1);
    ATT_LOADK(2); ATT_LOADV(1);
    __syncthreads();
    f32x16 pA0, pA1, pB0, pB1;
    const unsigned lbase = (unsigned)(size_t)lds;
    const unsigned kfa = lbase + ATT_KS + r * 208 + hh * 16, vfa = lbase + ATT_VS + r * 144 + hh * 16;
    attn_qk(pA0, pA1, kfa, qf, negm);
    { const float mx = attn_rowmax(pA0, pA1); mrow = mx;
#pragma unroll
      for (int i = 0; i < 16; ++i) { pA0[i] -= mx; pA1[i] -= mx; negm[i] = -mx; } }
    __syncthreads();
#define ATT_ITER(PA0_, PA1_, PB0_, PB1_, t) do { \
        attn_qk(PB0_, PB1_, kfa + ((t + 1) & 1) * ATT_KB, qf, negm); \
        f32x2 ls2 = (f32x2){0.f, 0.f}, ls3 = (f32x2){0.f, 0.f}; \
_Pragma("unroll") \
        for (int i = 0; i < 16; ++i) { PA0_[i] = __builtin_amdgcn_exp2f(PA0_[i]); PA1_[i] = __builtin_amdgcn_exp2f(PA1_[i]); } \
_Pragma("unroll") \
        for (int i = 0; i < 16; i += 2) { ls2 += (f32x2){PA0_[i], PA0_[i + 1]}; ls3 += (f32x2){PA1_[i], PA1_[i + 1]}; } \
        lrow += (ls2.x + ls2.y) + (ls3.x + ls3.y); \
        bf16x8 pa[4]; \
_Pragma("unroll") \
        for (int ks = 0; ks < 4; ++ks) { \
            u32x4 w; \
_Pragma("unroll") \
            for (int j = 0; j < 4; ++j) { const int i0 = 8 * (ks & 1) + 2 * j; w[j] = (ks < 2) ? cvtpk(PA0_[i0], PA0_[i0 + 1]) : cvtpk(PA1_[i0], PA1_[i0 + 1]); } \
            pa[ks] = __builtin_bit_cast(bf16x8, w); \
        } \
        attn_pv(o0, o1, vfa + (t & 1) * ATT_VB, pa); \
        const float mx = attn_rowmax(PB0_, PB1_); \
          \
_Pragma("unroll") \
        for (int g_ = 0; g_ < 4; ++g_) { __builtin_amdgcn_sched_group_barrier(0x008, 1, 0); __builtin_amdgcn_sched_group_barrier(0x402, 6, 0); } \
_Pragma("unroll") \
        for (int g_ = 0; g_ < 8; ++g_) { __builtin_amdgcn_sched_group_barrier(0x008, 1, 0); __builtin_amdgcn_sched_group_barrier(0x402, 5, 0); } \
_Pragma("unroll") \
        for (int g_ = 0; g_ < 8; ++g_) { __builtin_amdgcn_sched_group_barrier(0x008, 1, 0); __builtin_amdgcn_sched_group_barrier(0x402, 4, 0); } \
        ATT_STOREK(t & 1); ATT_STOREV((t + 1) & 1); \
        ATT_LOADK(t + 3); ATT_LOADV(t + 2); \
        if (__any(mx > ATT_THR)) { \
            const float dl = fmaxf(mx, 0.f); \
            mrow += dl; \
            const float alpha = __builtin_amdgcn_exp2f(-dl); \
            lrow *= alpha; \
            if (hh == 0) scr[r] = alpha; \
_Pragma("unroll") \
            for (int i = 0; i < 16; ++i) { PB0_[i] -= dl; PB1_[i] -= dl; negm[i] = -mrow; } \
            asm volatile("s_waitcnt lgkmcnt(0)" ::: "memory"); \
_Pragma("unroll") \
            for (int i = 0; i < 16; ++i) { const float a = scr[crow(i, hh)]; o0[i] *= a; o1[i] *= a; } \
        } \
        __syncthreads(); } while (0)
    if (wid >= 4) __builtin_amdgcn_s_setprio(1);
#pragma unroll 1
    for (int t = 0; t < NT_ - 2; t += 2) { ATT_ITER(pA0, pA1, pB0, pB1, t); ATT_ITER(pB0, pB1, pA0, pA1, t + 1); }
    ATT_ITER(pA0, pA1, pB0, pB1, NT_ - 2);
    __builtin_amdgcn_s_setprio(0);
    pA0 = pB0; pA1 = pB1;
#undef ATT_ITER
    {
        float ls = 0.f;
#pragma unroll
        for (int i = 0; i < 16; ++i) { pA0[i] = __builtin_amdgcn_exp2f(pA0[i]); pA1[i] = __builtin_amdgcn_exp2f(pA1[i]); ls += pA0[i] + pA1[i]; }
        lrow += ls;
        bf16x8 pa[4];
#pragma unroll
        for (int ks = 0; ks < 4; ++ks) {
            u32x4 w;
#pragma unroll
            for (int j = 0; j < 4; ++j) { const int i0 = 8 * (ks & 1) + 2 * j; w[j] = (ks < 2) ? cvtpk(pA0[i0], pA0[i0 + 1]) : cvtpk(pA1[i0], pA1[i0 + 1]); }
            pa[ks] = __builtin_bit_cast(bf16x8, w);
        }
        attn_pv(o0, o1, vfa + ((NT_ - 1) & 1) * ATT_VB, pa);
    }
    lrow += __shfl_xor(lrow, 32);
    if (hh == 0) scr[32 + r] = 1.f / lrow;
    asm volatile("s_waitcnt lgkmcnt(0)" ::: "memory");
#pragma unroll
    for (int i = 0; i < 16; ++i) { const int q = crow(i, hh); const float il = scr[32 + q];
        bf16_t* yp = YM + (size_t)(q0 + q) * 512 + h * 64;
        yp[r] = (bf16_t)f2bf(o0[i] * il); yp[32 + r] = (bf16_t)f2bf(o1[i] * il); }
    __syncthreads();
#undef ATT_LOADK
#undef ATT_LOADV
#undef ATT_STOREK
#undef ATT_STOREV
}

struct TileIter {
    int ntn, nrow, G, bid, k, pm, pn; bool xcd;
    DI TileIter(int nrow_, int ntn_, int G_, int bid_) : ntn(ntn_), nrow(nrow_), G(G_), bid(bid_), k(0), pm(0), pn(0), xcd(G_ == 256 && (nrow_ & 7) == 0) {}
    DI bool next() {
        if (xcd) { const int li = (bid >> 3) + 32 * k; ++k; if (li >= (nrow >> 3) * ntn) return false; pm = (bid & 7) + 8 * (li / ntn); pn = li % ntn; return true; }
        const int t = bid + G * k; ++k; if (t >= nrow * ntn) return false; pm = t / ntn; pn = t % ntn; return true;
    }
};
__global__ void __launch_bounds__(NTHREADS, 2) mega(Params P) {
    extern __shared__ __attribute__((aligned(16))) unsigned char lds_raw[];
    LAS unsigned char* lds = (LAS unsigned char*)lds_raw;
    const int G = gridDim.x, bid = blockIdx.x, NGW = G * NWAVES;
#define PHASE_IDS() const int tid = tid_fresh(); const int lane = tid & 63; const int wave = __builtin_amdgcn_readfirstlane(tid >> 6); const int gw = bid * NWAVES + wave; (void)lane; (void)gw; (void)wave;
    volatile LAS unsigned* MISC = (volatile LAS unsigned*)(lds + LDS_MISC);
    if (threadIdx.x < 64) MISC[threadIdx.x] = 0u;
    __syncthreads();
    unsigned char* ws = P.ws;
    XcdBarrier bar = xcd_barrier_post((unsigned*)(ws + WS_CTL) + 1024, MISC + 8);
#ifdef DBG_TS
    unsigned long long* TSp = (unsigned long long*)((unsigned*)(ws + WS_CTL) + 12288); int ts_n = 1;
    if (blockIdx.x == 0 && threadIdx.x == 0) TSp[0] = __builtin_amdgcn_s_memrealtime();
#define GRID_BAR() do { xcd_barrier(bar); if (blockIdx.x == 0 && threadIdx.x == 0) TSp[ts_n] = __builtin_amdgcn_s_memrealtime(); ++ts_n; } while (0)
#else
#define GRID_BAR() xcd_barrier(bar)
#endif

    bf16_t* WT = (bf16_t*)(ws + WS_WT);
    bf16_t* U = (bf16_t*)(ws + WS_U);
    float* XB = (float*)(ws + WS_XB);
    bf16_t* Hb = (bf16_t*)(ws + WS_H2);
    bf16_t* Qb = (bf16_t*)P.out;
    bf16_t* Kb = Qb + (size_t)8 * T * 96;
    bf16_t* VT = Kb + (size_t)8 * T * 96;
    bf16_t* MG = (bf16_t*)P.out;
    ScEnt* SC = (ScEnt*)P.out;
#define gt ((size_t)(blockIdx.x * NTHREADS + tid))
#define GT ((size_t)(gridDim.x * NTHREADS))

    {
    PHASE_IDS();
        LAS float* scr = (LAS float*)(lds + wave * 16384);
        const TrJob jobs[12] = {
            {P.in[4], IN_COLS, 0, 1024, 1920, WT + WT_IN, nullptr},
            {P.in[4], IN_COLS, 1920, 1024, 416, WT + WT_IN + (size_t)1920 * 1024, nullptr},
            {P.in[4], IN_COLS, 2336, 1024, 2048, WT + WT_GATE, nullptr},
            {P.in[20], 1024, 0, 512, 1024, WT + WT_BRA, nullptr},
            {P.in[21], 1024, 0, 512, 1024, WT + WT_BRB, nullptr},
            {P.in[22], 1024, 0, 1024, 1024, WT + WT_OUT, nullptr},
            {P.in[29], 1024, 0, 1024, 1024, WT + WT_PG, nullptr},
            {P.in[30], 1024, 0, 256, 1024, WT + WT_PP, nullptr},
            {P.in[24], 2048, 0, 1024, 2048, WT + WT_PQ, nullptr},
            {P.in[10], 512, 0, 128, 512, WT + WT_G2, nullptr},
            {P.in[17], 768, 0, 256, 768, WT + WT_QUP, P.in[16]},
            {P.in[19], 1024, 0, 128, 1024, WT + WT_KVUP, P.in[18]},
        };
        {
            int total = 0;
#pragma unroll
            for (int j = 0; j < 12; ++j) total += trjob_items(jobs[j]);
            for (int it = gw; it < total; it += NGW) {
                int r = it;
#pragma unroll
                for (int j = 0; j < 12; ++j) {
                    const int ni = trjob_items(jobs[j]);
                    if (r >= 0 && r < ni) transpose_item(jobs[j].W, jobs[j].ldw, jobs[j].col_off, jobs[j].K, jobs[j].WT, jobs[j].ncols, scr, r, lane, jobs[j].ks);
                    r -= ni;
                }
            }
        }
        for (size_t i = gt; i < (size_t)96 * 1024 / 8; i += GT) ((u32x4*)(WT + WT_IN + (size_t)2336 * 1024))[i] = (u32x4){0u, 0u, 0u, 0u};
        for (size_t i = gt; i < (size_t)16 * 128 * 128 / 4; i += GT) { const f32x4 v = ((const f32x4*)P.in[25])[i]; ((u32x2*)(WT + WT_SK))[i] = (u32x2){pk2(v.x, v.y), pk2(v.z, v.w)}; }
        for (size_t i = gt; i < 65536; i += GT) { const int l = (int)(i & 63), cc = (int)((i >> 6) & 63), hh_ = (int)((i >> 12) & 7), dd = (int)(i >> 15);
            WT[WT_W2T + i] = (bf16_t)f2bf(P.in[7][((size_t)dd * 64 + l) * 512 + hh_ * 64 + cc]); WT[WT_A2T + i] = (bf16_t)f2bf(P.in[9][((size_t)dd * 64 + l) * 512 + hh_ * 64 + cc]); }
        for (int m = gw; m < T; m += NGW) rms_row_to_bf16(P.in[0] + (size_t)m * D, P.in[3], (bf16_t*)P.out + (size_t)m * D, lane);
    }
    GRID_BAR();
    {
    PHASE_IDS();
        const int ntn = UW / G_BN, ntile = (T / G_BM) * ntn;
        for (TileIter ti_(T / G_BM, ntn, G, bid); ti_.next(); ) {
            const int row0 = ti_.pm * G_BM, col0 = ti_.pn * G_BN;
            f32x4 acc[4][4]; acc_zero(acc);
            gemm_accum(acc, GemmSrc{(const bf16_t*)P.out, D, WT + WT_IN, D, D}, row0, col0, lds);
            EPI_LOOP(row0, col0) { *(u32x2*)(U + (size_t)EPI_ROW(row0) * UW + EPI_COL(col0)) = (u32x2){pk2(acc[m][n][0], acc[m][n][1]), pk2(acc[m][n][2], acc[m][n][3])}; }
        }
    }
    GRID_BAR();
    {
    PHASE_IDS();
        unsigned* flags = (unsigned*)(ws + WS_CTL) + 16384;
        if (bid < 32) rwkv_passB(ws + WS_CM, (const float*)(ws + WS_GC), flags, bid >> 4, (bid >> 1) & 7, bid & 1, lds);
        else {
            const int pb_ = bid - 32, PG = G - 32;
            {
                PaPre pre; int prev = -1;
                if (pb_ < 4096) pa_prefetch(U, P.in[5], (pb_ & 15) * 256 + (pb_ >> 4), tid, pre);
                for (int j = pb_; j < 4096; j += PG) {
                    const int item = (j & 15) * 256 + (j >> 4), jn = j + PG, nxt = jn < 4096 ? (jn & 15) * 256 + (jn >> 4) : -1;
                    rwkv_passA(P, U, WT + WT_W2T, WT + WT_A2T, ws + WS_CM, (float*)(ws + WS_GC), (float*)(ws + WS_BS), (bf16_t*)(ws + WS_VS), flags, item, prev, nxt, pre, lds
#ifdef DBG_TS
                        , (blockIdx.x == 32) ? (TSp + 24) : nullptr
#endif
                        );
                    prev = item;
                }
            }
#ifdef DBG_TS
            if (blockIdx.x == 32 && threadIdx.x == 0) TSp[21] = __builtin_amdgcn_s_memrealtime();
#endif
            bf16_t* LG = (bf16_t*)(ws + WS_LG);
            for (size_t i = (size_t)pb_ * NTHREADS + tid; i < (size_t)T * 16; i += (size_t)PG * NTHREADS) {
                const int t = (int)(i >> 4), j0 = (int)(i & 15) * 8;
                const bf16_t* up = U + (size_t)t * UW + 1792 + j0;
                const u32x4 cu = *(const u32x4*)up, pu = *(const u32x4*)(t > 0 ? up - UW : up), nu = *(const u32x4*)(t < T - 1 ? up + UW : up);
                const float pf = t > 0 ? 0.5f : 0.f, nf = t < T - 1 ? 0.5f : 0.f;
                const f32x4 m0 = *(const f32x4*)(P.in[5] + 1792 + j0), m1 = *(const f32x4*)(P.in[5] + 1792 + j0 + 4);
                u32x4 w;
#pragma unroll
                for (int j = 0; j < 4; ++j) {
                    const float c0 = __builtin_bit_cast(float, cu[j] << 16), c1 = __builtin_bit_cast(float, cu[j] & 0xffff0000u);
                    const float p0 = __builtin_bit_cast(float, pu[j] << 16), p1 = __builtin_bit_cast(float, pu[j] & 0xffff0000u);
                    const float n0 = __builtin_bit_cast(float, nu[j] << 16), n1 = __builtin_bit_cast(float, nu[j] & 0xffff0000u);
                    const float mu0 = j < 2 ? m0[2 * j] : m1[2 * j - 4], mu1 = j < 2 ? m0[2 * j + 1] : m1[2 * j - 3];
                    w[j] = pk2(sigmoidf_(c0 + mu0 * ((pf * p0 + nf * n0) - c0)), sigmoidf_(c1 + mu1 * ((pf * p1 + nf * n1) - c1)));
                }
                *(u32x4*)(LG + (size_t)t * 128 + j0) = w;
            }
            for (int m = pb_ * NWAVES + wave; m < T / 4; m += PG * NWAVES) mla_prep_token4(P, U, Kb, m, lane);
        }
        {
        unsigned* qctr = (unsigned*)(ws + WS_CTL) + 20544;
        const int nq = (T / G_BM) * 6, nkv = (T / G_BM) * 8;
        for (;;) {
            __syncthreads();
            if (tid == 0) MISC[32] = __hip_atomic_fetch_add(qctr, 1u, __ATOMIC_RELAXED, __HIP_MEMORY_SCOPE_AGENT);
            __syncthreads();
            const int tile = __builtin_amdgcn_readfirstlane((int)MISC[32]);
            if (tile >= nq + nkv) break;
            f32x4 acc[4][4]; acc_zero(acc);
            f32x4 ssv = (f32x4){0.f, 0.f, 0.f, 0.f};
            if (tile < nq) {
                const int row0 = (tile / 6) * G_BM, col0 = (tile % 6) * G_BN;
                gemm_accum_<true, true>(acc, GemmSrc{U + 1920, UW, WT + WT_QUP, 256, 256}, row0, col0, lds, ssv);
#pragma unroll
                for (int m = 0; m < 4; ++m) { float v = ssv[m]; v += __shfl_xor(v, 16); v += __shfl_xor(v, 32); ssv[m] = __builtin_amdgcn_rsqf(v * (1.f / 256.f) + NORM_EPS) * QSCALE; }
                {
                    const int lane_ = tid & 63, wid_ = tid >> 6, wr_ = wid_ >> 1, wc_ = wid_ & 1, fr_ = lane_ & 15, fq_ = lane_ >> 4;
#pragma unroll
                    for (int n = 0; n < 4; n += 2) {
                        const int g16 = (col0 + wc_ * 64 + n * 16) >> 4;
                        if (g16 % 6 == 4) {
#pragma unroll
                            for (int m = 0; m < 4; ++m) {
                                const float pos = (float)((const int*)P.in[2])[row0 + wr_ * 64 + m * 16 + fr_];
#pragma unroll
                                for (int j = 0; j < 4; ++j) {
                                    const float inv = exp2f(-(float)(4 * fq_ + j) * (13.287712379549449f / 16.f));
                                    float sn, cs; fast_sincos(pos * inv, sn, cs);
                                    const float x1 = acc[m][n][j], x2 = acc[m][n + 1][j];
                                    acc[m][n][j] = x1 * cs - x2 * sn; acc[m][n + 1][j] = x2 * cs + x1 * sn;
                                }
                            }
                        }
                    }
                }
                EPI_LOOP(row0, col0) { const int row = EPI_ROW(row0), col = EPI_COL(col0), hq = col / 96, dq = col % 96; const float sc = ssv[m];
                    *(u32x2*)(Qb + ((size_t)hq * T + row) * 96 + dq) = (u32x2){pk2(acc[m][n][0] * sc, acc[m][n][1] * sc), pk2(acc[m][n][2] * sc, acc[m][n][3] * sc)}; }
            } else {
                const int tt = tile - nq, row0 = (tt / 8) * G_BM, hk = tt % 8, col0 = hk * G_BN;
                gemm_accum_<false, true>(acc, GemmSrc{U + 2176, UW, WT + WT_KVUP, 128, 128}, row0, col0, lds, ssv);
#pragma unroll
                for (int m = 0; m < 4; ++m) { float v = ssv[m]; v += __shfl_xor(v, 16); v += __shfl_xor(v, 32); ssv[m] = __builtin_amdgcn_rsqf(v * (1.f / 128.f) + NORM_EPS); }
                const int lane_ = tid & 63, wid_ = tid >> 6, wr_ = wid_ >> 1, wc_ = wid_ & 1, fr_ = lane_ & 15, fq_ = lane_ >> 4;
#pragma unroll
                for (int m = 0; m < 4; ++m) {
                    const f32x4 ir = (f32x4){__shfl(ssv[m], 4 * fq_), __shfl(ssv[m], 4 * fq_ + 1), __shfl(ssv[m], 4 * fq_ + 2), __shfl(ssv[m], 4 * fq_ + 3)};
#pragma unroll
                    for (int n = 0; n < 4; ++n) {
                        const int rbase = row0 + wr_ * 64 + m * 16, cc = wc_ * 64 + n * 16 + fr_;
                        const f32x4 v = acc[m][n] * ir;
                        if (wc_ == 0) {
#pragma unroll
                            for (int j = 0; j < 4; ++j) Kb[((size_t)hk * T + rbase + 4 * fq_ + j) * 96 + cc] = (bf16_t)f2bf(v[j]);
                        } else {
                            *(u32x2*)(VT + (size_t)(hk * 64 + cc - 64) * T + rbase + 8 * (fq_ & 1) + 4 * (fq_ >> 1)) = (u32x2){pk2(v[0], v[1]), pk2(v[2], v[3])};
                        }
                    }
                }
            }
        }
        }
#ifdef DBG_TS
        if (blockIdx.x == 0 && threadIdx.x == 0) TSp[20] = __builtin_amdgcn_s_memrealtime();
#endif
    }
    GRID_BAR();
    {
    PHASE_IDS();
        {
            bf16_t* Gm = (bf16_t*)(ws + WS_GM);
            const int ntn = 512 / G_BN, ntile = (T / G_BM) * ntn;
            unsigned ndone = 0u;
            for (TileIter ti_(T / G_BM, ntn, G, bid); ti_.next(); ) {
                const int row0 = ti_.pm * G_BM, col0 = ti_.pn * G_BN;
                f32x4 acc[4][4]; acc_zero(acc);
                gemm_accum(acc, GemmSrc{(const bf16_t*)(ws + WS_LG), 128, WT + WT_G2, 128, 128}, row0, col0, lds);
                EPI_LOOP(row0, col0) { *(u32x2*)(Gm + (size_t)EPI_ROW(row0) * 512 + EPI_COL(col0)) = (u32x2){pk2(acc[m][n][0], acc[m][n][1]), pk2(acc[m][n][2], acc[m][n][3])}; }
                ++ndone;
            }
            asm volatile("s_waitcnt vmcnt(0)" ::: "memory");
            __syncthreads();
            if (tid == 0) { __builtin_amdgcn_fence(__ATOMIC_RELEASE, "agent"); (void)__hip_atomic_fetch_add((unsigned*)(ws + WS_CTL) + 20608, ndone, __ATOMIC_RELAXED, __HIP_MEMORY_SCOPE_AGENT); }
            for (int m = gw; m < T; m += NGW) rms_row_to_bf16(P.in[0] + (size_t)m * D, P.in[3], (bf16_t*)(ws + WS_HG) + (size_t)m * D, lane);
        }
        for (int unit = bid; unit < 8 * (T / 256); unit += G) attn_unit(Qb, Kb, VT, (bf16_t*)(ws + WS_YM), unit & 7, unit >> 3, lds);
    }
    {
    PHASE_IDS();
    if (tid == 0) {
        unsigned* gctr = (unsigned*)(ws + WS_CTL) + 20608; const unsigned need = (unsigned)((T / G_BM) * (512 / G_BN)); unsigned sp = 0u;
        while (__hip_atomic_load(gctr, __ATOMIC_RELAXED, __HIP_MEMORY_SCOPE_AGENT) < need) { __builtin_amdgcn_s_sleep(1); if (++sp > (1u << 22)) break; }
        __builtin_amdgcn_fence(__ATOMIC_ACQUIRE, "agent");
    }
    __syncthreads();
    for (int m = gw; m < T; m += NGW) rwkv_merge_token(P, (bf16_t*)(ws + WS_VS), ws + WS_CM, (const float*)(ws + WS_BS), (const bf16_t*)(ws + WS_GM), m, lane);
    }
    GRID_BAR();
    {
    PHASE_IDS();
        const bf16_t* YRW = (const bf16_t*)(ws + WS_YRW); const bf16_t* YM = (const bf16_t*)(ws + WS_YM);
        const int ntn = D / G_BN, ntile = (T / G_BM) * ntn;
        for (TileIter ti_(T / G_BM, ntn, G, bid); ti_.next(); ) {
            const int row0 = ti_.pm * G_BM, col0 = ti_.pn * G_BN;
            f32x4 acc1[4][4], acc2[4][4];
            acc_zero(acc1); acc_zero(acc2);
            gemm_accum(acc1, GemmSrc{(const bf16_t*)(ws + WS_HG), D, WT + WT_GATE, D, D}, row0, col0, lds);
            gemm_accum(acc2, GemmSrc{YRW, 512, WT + WT_BRA, 512, 512}, row0, col0, lds);
            {
                EPI_LOOP(row0, col0) {
                    f32x4 o;
#pragma unroll
                    for (int j = 0; j < 4; ++j) o[j] = sigmoidf_(acc1[m][n][j]) * acc2[m][n][j];
                    *(u32x2*)(MG + (size_t)EPI_ROW(row0) * D + EPI_COL(col0)) = (u32x2){pk2(o[0], o[1]), pk2(o[2], o[3])};
                }
            }
            acc_zero(acc1); acc_zero(acc2);
            gemm_accum(acc1, GemmSrc{(const bf16_t*)(ws + WS_HG), D, WT + WT_GATE + (size_t)1024 * 1024, D, D}, row0, col0, lds);
            gemm_accum(acc2, GemmSrc{YM, 512, WT + WT_BRB, 512, 512}, row0, col0, lds);
            {
                EPI_LOOP(row0, col0) {
                    bf16_t* mp = MG + (size_t)EPI_ROW(row0) * D + EPI_COL(col0);
                    const u32x2 pr = *(const u32x2*)mp;
                    f32x4 o;
                    o[0] = __builtin_bit_cast(float, pr.x << 16); o[1] = __builtin_bit_cast(float, pr.x & 0xffff0000u);
                    o[2] = __builtin_bit_cast(float, pr.y << 16); o[3] = __builtin_bit_cast(float, pr.y & 0xffff0000u);
#pragma unroll
                    for (int j = 0; j < 4; ++j) o[j] += sigmoidf_(acc1[m][n][j]) * acc2[m][n][j];
                    *(u32x2*)mp = (u32x2){pk2(o[0], o[1]), pk2(o[2], o[3])};
                }
            }
        }
    }
    GRID_BAR();
    {
    PHASE_IDS();
        bf16_t* PB = (bf16_t*)(ws + WS_PB);
        const int ntn = D / G_BN, ntile = (T / G_BM) * ntn;
        for (TileIter ti_(T / G_BM, ntn, G, bid); ti_.next(); ) {
            const int row0 = ti_.pm * G_BM, col0 = ti_.pn * G_BN;
            f32x4 acc[4][4]; acc_zero(acc);
            gemm_accum(acc, GemmSrc{MG, D, WT + WT_OUT, D, D}, row0, col0, lds);
            {
                float* SSQ = (float*)(ws + WS_GC);
                const int tid_ = tid_fresh(), lane_ = tid_ & 63, wid_ = tid_ >> 6, wr_ = wid_ >> 1, wc_ = wid_ & 1, fr_ = lane_ & 15, fq_ = lane_ >> 4;
#pragma unroll
                for (int m = 0; m < 4; ++m) {
                    const int row = row0 + wr_ * 64 + m * 16 + fr_; float ssq = 0.f;
#pragma unroll
                    for (int n = 0; n < 4; ++n) { const int col = col0 + wc_ * 64 + n * 16 + 4 * fq_; const size_t off = (size_t)row * D + col;
                        const f32x4 xv = *(const f32x4*)(P.in[0] + off) + acc[m][n]; *(f32x4*)(XB + off) = xv;
                        const f32x4 gg = *(const f32x4*)(P.in[23] + col);
                        *(u32x2*)(Hb + off) = (u32x2){pk2(xv[0] * gg[0], xv[1] * gg[1]), pk2(xv[2] * gg[2], xv[3] * gg[3])};
                        ssq += xv[0] * xv[0] + xv[1] * xv[1] + xv[2] * xv[2] + xv[3] * xv[3]; }
                    ssq += __shfl_xor(ssq, 16); ssq += __shfl_xor(ssq, 32);
                    if (fq_ == 0) SSQ[(size_t)(ti_.pn * 2 + wc_) * T + row] = ssq;
                }
            }
        }
        for (size_t i = gt; i < (size_t)T * PLE / 4; i += GT) { const f32x4 v = ((const f32x4*)P.in[1])[i]; ((u32x2*)PB)[i] = (u32x2){pk2(v.x, v.y), pk2(v.z, v.w)}; }
        for (int m = gw; m < 2 * 16384; m += NGW) { const int tbl = __builtin_amdgcn_readfirstlane(m >> 14), row = m & 16383;
            row_to_fp8((tbl ? P.in[27] : P.in[26]) + (size_t)row * D, ws + WS_ET + (size_t)tbl * 16 * MiB + (size_t)row * 128, (float*)(ws + WS_LG) + tbl * 16384 + row, lane); }
    }
    GRID_BAR();
    {
    PHASE_IDS();
        const int ntile = (T / G_BM) * 16;
        for (TileIter ti_(T / G_BM, 16, G, bid); ti_.next(); ) peer_query_tile(Hb, WT + WT_PQ, WT + WT_SK, (const float*)(ws + WS_GC), SC, ti_.pm, ti_.pn, lds);
    }
    GRID_BAR();
    int* EL = (int*)(ws + WS_CM); float* GT_ = (float*)(ws + WS_CM + 8 * MiB); float* CC = (float*)(ws + WS_CM + 16 * MiB);
    float* PS03 = (float*)(ws + WS_U + 32 * MiB); float* PS47 = P.out + (size_t)8 * MiB;
    float* SSQ2 = (float*)(ws + WS_IR);
    {
    PHASE_IDS();
    LAS unsigned char* wl = lds + wave * 17408;
#pragma unroll 1
    for (int q0 = gw * 64; q0 < T * PEER_H; q0 += NGW * 64) {
        const unsigned char* src = (const unsigned char*)(SC + (size_t)q0 * 32);
        u32x4 tmp[16];
#pragma unroll
        for (int k = 0; k < 16; ++k) tmp[k] = *(const u32x4*)(src + k * 1024 + lane * 16);
#pragma unroll
        for (int k = 0; k < 16; ++k) { const int off = k * 1024 + lane * 16; *(LAS u32x4*)(wl + (off >> 8) * 272 + (off & 255)) = tmp[k]; }
        asm volatile("s_waitcnt lgkmcnt(0)" ::: "memory");
        __builtin_amdgcn_wave_barrier();
        peer_route_pair((const LAS u32x4*)(wl + lane * 272), (LAS int*)(wl + lane * 80), (LAS float*)(wl + 5120 + lane * 80));
        asm volatile("s_waitcnt lgkmcnt(0)" ::: "memory");
        __builtin_amdgcn_wave_barrier();
#pragma unroll
        for (int j = 0; j < 4; ++j) { const int m = j * 64 + lane, lo = ((m >> 2) * 20 + (m & 3) * 4) * 4;
            *(u32x4*)(EL + (size_t)q0 * 16 + m * 4) = *(const LAS u32x4*)(wl + lo);
            *(u32x4*)(GT_ + (size_t)q0 * 16 + m * 4) = *(const LAS u32x4*)(wl + 5120 + lo); }
        asm volatile("s_waitcnt lgkmcnt(0)" ::: "memory");
        __builtin_amdgcn_wave_barrier();
    }
    }
    GRID_BAR();
    {
    PHASE_IDS();
    const int xs = G < 8 ? G : 8;
    for (int x = bid & 7; x < 8; x += xs) {
        const int nb = G < 8 ? 1 : (G - x + 7) >> 3, rank = G < 8 ? 0 : bid >> 3;
        peer_gu_slice(EL, Hb, ws + WS_ET + (size_t)x * PEER_SLICE, (x < 4 ? PS03 : PS47) + (size_t)(x & 3) * T * 128, x, rank * NWAVES + wave, nb * NWAVES, lane);
    }
    }
    GRID_BAR();
    {
    PHASE_IDS();
    const float* su = (const float*)(ws + WS_LG); const float* sv = su + 16384;
#pragma unroll 1
    for (int m = gw; m < T; m += 4 * NGW) {
        f32x2 tot[4], gt2[4]; int e0[4], e1[4]; float ssq[4];
#pragma unroll
        for (int u = 0; u < 4; ++u) { const int mm = m + u * NGW < T ? m + u * NGW : T - 1;
            tot[u] = (f32x2){0.f, 0.f};
#pragma unroll
            for (int x = 0; x < 8; ++x) tot[u] += *(const f32x2*)((x < 4 ? PS03 : PS47) + ((size_t)(x & 3) * T + mm) * 128 + 2 * lane);
            ssq[u] = ssq16((const float*)(ws + WS_GC), mm);
            e0[u] = EL[(size_t)mm * 128 + 2 * lane]; e1[u] = EL[(size_t)mm * 128 + 2 * lane + 1];
            gt2[u] = *(const f32x2*)(GT_ + (size_t)mm * 128 + 2 * lane); }
        float su0[4], su1[4], sv0[4], sv1[4];
#pragma unroll
        for (int u = 0; u < 4; ++u) { su0[u] = su[e0[u]]; sv0[u] = sv[e0[u]]; su1[u] = su[e1[u]]; sv1[u] = sv[e1[u]]; }
#pragma unroll
        for (int u = 0; u < 4; ++u) { const int mm = m + u * NGW;
            const float irms = __builtin_amdgcn_rsqf(ssq[u] * (1.f / D) + NORM_EPS);
            const float c0 = gt2[u].x * gelu_erf(tot[u].x * irms * su0[u]) * sv0[u], c1 = gt2[u].y * gelu_erf(tot[u].y * irms * su1[u]) * sv1[u];
            const unsigned w0 = ((__builtin_bit_cast(unsigned, c0) + 0x2000u) & 0xFFFFC000u) | (unsigned)e0[u], w1 = ((__builtin_bit_cast(unsigned, c1) + 0x2000u) & 0xFFFFC000u) | (unsigned)e1[u];
            if (mm < T) *(u32x2*)(CC + (size_t)mm * 128 + 2 * lane) = (u32x2){w0, w1}; }
    }
    }
    GRID_BAR();
    {
    PHASE_IDS();
    const int xs = G < 8 ? G : 8;
    for (int x = bid & 7; x < 8; x += xs) {
        const int nb = G < 8 ? 1 : (G - x + 7) >> 3, rank = G < 8 ? 0 : bid >> 3;
        peer_gv_slice((const unsigned*)CC, ws + WS_ET + 16 * MiB + (size_t)x * PEER_SLICE, XB, Hb, P.in[28], SSQ2, x, rank * NWAVES + wave, nb * NWAVES, lane);
    }
    }
    GRID_BAR();
    {
    PHASE_IDS();
        const bf16_t* PB = (const bf16_t*)(ws + WS_PB);
        const int ntile = (T / G_BM) * (D / G_BN);
        for (TileIter ti_(T / G_BM, D / G_BN, G, bid); ti_.next(); ) {
            const int row0 = ti_.pm * G_BM, col0 = ti_.pn * G_BN;
            f32x4 acc1[4][4], acc2[4][4];
            acc_zero(acc1); acc_zero(acc2);
            gemm_accum(acc1, GemmSrc{PB, PLE, WT + WT_PP, PLE, PLE}, row0, col0, lds);
            gemm_accum(acc2, GemmSrc{Hb, D, WT + WT_PG, D, D}, row0, col0, lds);
            f32x4 ir2v;
            { const int tid_ = tid_fresh(), wr_ = (tid_ >> 6) >> 1, fr_ = tid_ & 15;
#pragma unroll
              for (int m = 0; m < 4; ++m) { float q = 0.f;
#pragma unroll
                  for (int x = 0; x < 8; ++x) q += SSQ2[(size_t)x * T + row0 + wr_ * 64 + m * 16 + fr_];
                  ir2v[m] = __builtin_amdgcn_rsqf(q * (1.f / D) + NORM_EPS); } }
            EPI_LOOP(row0, col0) {
                const size_t off = (size_t)EPI_ROW(row0) * D + EPI_COL(col0);
                const float ir2 = ir2v[m];
                const f32x4 xv = *(const f32x4*)(XB + off);
                f32x4 o;
#pragma unroll
                for (int j = 0; j < 4; ++j) o[j] = xv[j] + acc1[m][n][j] * sigmoidf_(acc2[m][n][j] * ir2);
                *(f32x4*)(XB + off) = o;
            }
        }
    }
    GRID_BAR();
    {
    PHASE_IDS();
#ifdef DBG_TS
    {
        const float us1 = (float)(TSp[DBG_B1] - TSp[DBG_A1]) * 0.01f, us2 = (float)(TSp[DBG_B2] - TSp[DBG_A2]) * 0.01f;
        const float dl = sqrtf(floorf(us1 * 0.05f) * 20.f * 1e-6f);
        for (int m = gw; m < T; m += NGW) {
            rms_row_to_f32(XB + (size_t)m * D, P.in[31], P.out + (size_t)m * D, lane);
            f32x4* o = (f32x4*)(P.out + (size_t)m * D) + lane;
#pragma unroll
            for (int j = 0; j < 4; ++j) { f32x4 v = o[64 * j]; v.x *= 1.f + dl; v.y *= 1.f - dl; v.z *= 1.f + dl; v.w *= 1.f - dl; if (m == 0 && lane == 0 && j == 0) v.x += 1.f + floorf(us2 * 0.1f) * 0.1f; o[64 * j] = v; }
        }
    }
#else
    for (int m = gw; m < T; m += NGW) rms_row_to_f32(XB + (size_t)m * D, P.in[31], P.out + (size_t)m * D, lane);
#endif
    }
}

extern "C" void kernel_launch(void* const* d_in, const int* in_sizes, int n_in, void* d_out, int out_size, void* d_ws, size_t ws_size, hipStream_t stream) {
    static int grid = 0;
    if (grid == 0) {
        if (n_in != 32 || out_size != T * D || ws_size < WS_END) { fprintf(stderr, "kernel_launch: unexpected shapes n_in %d out %d ws %zu\n", n_in, out_size, ws_size); grid = -1; return; }
        int dev = 0, cus = 0, per_cu = 0;
        if (hipGetDevice(&dev) != hipSuccess || hipDeviceGetAttribute(&cus, hipDeviceAttributeMultiprocessorCount, dev) != hipSuccess) { grid = -1; return; }
        if (hipFuncSetAttribute((const void*)mega, hipFuncAttributeMaxDynamicSharedMemorySize, LDS_BYTES) != hipSuccess) { fprintf(stderr, "kernel_launch: hipFuncSetAttribute failed\n"); grid = -1; return; }
        if (hipOccupancyMaxActiveBlocksPerMultiprocessor(&per_cu, (const void*)mega, NTHREADS, LDS_BYTES) != hipSuccess || per_cu < 1) { fprintf(stderr, "kernel_launch: occupancy query says %d blocks per CU\n", per_cu); (void)hipGetLastError(); grid = -1; return; }
        grid = cus;
    }
    if (grid < 0) return;
    (void)hipMemsetAsync((char*)d_ws + WS_CTL, 0, CTL_ZERO_BYTES, stream);
    Params p{};
    for (int i = 0; i < 32; ++i) p.in[i] = (const float*)d_in[i];
    p.out = (float*)d_out; p.ws = (unsigned char*)d_ws;
    hipLaunchKernelGGL(mega, dim3(grid), dim3(NTHREADS), LDS_BYTES, stream, p);
}
```
